# Optimizing an MI355X kernel written in HIP

```python
import jax, jax.numpy as jnp
from jax import lax
import numpy as np

D_MODEL = 2048
BATCH = 2
SEQ = 8192
DEPTH = 1

ATT_HEADS = 16
ATT_KV_HEADS = 2
ATT_HEAD_DIM = 64
ATT_WIDTH = ATT_HEADS * ATT_HEAD_DIM
ATT_KV_WIDTH = ATT_KV_HEADS * ATT_HEAD_DIM
WINDOW = 128
ATT_BLOCK = 128
ROPE_DIM = ATT_HEAD_DIM // 4
ROPE_THETA = 500000.0
M_HEADS = 4
M_QK_DIM = 128
M_V_DIM = 256
M_QK_WIDTH = M_HEADS * M_QK_DIM
M_WIDTH = M_HEADS * M_V_DIM
M_CHUNK = 64
CONV_WIDTH = 4
D_FF = 5632
NORM_EPS = 1e-6
NEG_INF = -1e30
N_MOD = 9
PROJ_SIZES = (ATT_WIDTH, ATT_KV_WIDTH, ATT_KV_WIDTH,
              2 * M_QK_WIDTH, M_WIDTH,
              M_HEADS, M_HEADS, M_WIDTH,
              2 * D_MODEL)
PROJ_OUT = sum(PROJ_SIZES)

kernel_name = "hybrid_swa_mlstm_macaron_adaln"


def _split_cols(t, sizes):
    idx = np.cumsum(sizes)[:-1].tolist()
    return jnp.split(t, idx, axis=-1)


def _rmsnorm(x, g):
    x32 = x.astype(jnp.float32)
    y = x32 * lax.rsqrt(jnp.mean(x32 * x32, axis=-1, keepdims=True) + NORM_EPS)
    return y.astype(x.dtype) * g


def _modulate(x, shift, scale):
    return x * (1 + scale) + shift


def _swiglu(x, w_in, w_out):
    a, b = jnp.split(x @ w_in, 2, axis=-1)
    return (jax.nn.silu(a) * b) @ w_out


def _partial_rope(x, positions):
    half = ROPE_DIM // 2
    inv_freq = jnp.power(ROPE_THETA, -jnp.arange(half, dtype=jnp.float32) * 2.0 / ROPE_DIM)
    ang = positions.astype(jnp.float32)[..., None] * inv_freq
    cos, sin = jnp.cos(ang)[:, :, None, :], jnp.sin(ang)[:, :, None, :]
    xr = x[..., :ROPE_DIM].astype(jnp.float32)
    x1, x2 = xr[..., :half], xr[..., half:]
    rot = jnp.concatenate([x1 * cos - x2 * sin, x2 * cos + x1 * sin], axis=-1)
    return jnp.concatenate([rot.astype(x.dtype), x[..., ROPE_DIM:]], axis=-1)


def _sliding_window_attention(q, k, v, sinks):
    B, T, Hq, hd = q.shape
    nb = T // ATT_BLOCK
    G = Hq // ATT_KV_HEADS
    qb = q.reshape(B, nb, ATT_BLOCK, ATT_KV_HEADS, G, hd)

    def band(t):
        tp = jnp.pad(t, ((0, 0), (ATT_BLOCK, 0), (0, 0), (0, 0)))
        prev = tp[:, :T].reshape(B, nb, ATT_BLOCK, ATT_KV_HEADS, hd)
        cur = t.reshape(B, nb, ATT_BLOCK, ATT_KV_HEADS, hd)
        return jnp.concatenate([prev, cur], axis=2)

    kb, vb = band(k), band(v)
    s = jnp.einsum('bnqhgd,bnkhd->bnhgqk', qb, kb,
                   preferred_element_type=jnp.float32) * (hd ** -0.5)
    qi = jnp.arange(ATT_BLOCK)[:, None] + ATT_BLOCK
    kj = jnp.arange(2 * ATT_BLOCK)[None, :]
    band_ok = (kj <= qi) & (kj > qi - WINDOW)
    blk_ok = (jnp.arange(nb)[:, None, None] > 0) | (kj[None] >= ATT_BLOCK)
    mask = band_ok[None] & blk_ok
    s = jnp.where(mask[None, :, None, None], s, NEG_INF)
    sink = sinks.astype(jnp.float32).reshape(1, 1, ATT_KV_HEADS, G, 1, 1)
    m = jnp.maximum(jnp.max(s, axis=-1, keepdims=True), sink)
    p = jnp.exp(s - m)
    denom = jnp.sum(p, axis=-1, keepdims=True) + jnp.exp(sink - m)
    o = jnp.einsum('bnhgqk,bnkhd->bnqhgd', (p / denom).astype(v.dtype), vb)
    return o.reshape(B, T, Hq * hd)


def _causal_conv(x, w, b):
    C = x.shape[-1]
    y = lax.conv_general_dilated(x, w[:, None, :].astype(x.dtype), window_strides=(1,),
                                 padding=((CONV_WIDTH - 1, 0),),
                                 dimension_numbers=('NWC', 'WIO', 'NWC'),
                                 feature_group_count=C)
    return y + b


def _mlstm_chunkwise(q, k, v, i_pre, f_pre):
    B, T, H, dk = q.shape
    dv = v.shape[-1]
    L = M_CHUNK
    nc = T // L
    f32 = jnp.float32

    def chunks(t):
        return jnp.moveaxis(t.astype(f32).reshape(B, nc, L, H, -1), 3, 1)

    qc = chunks(q)
    kc = chunks(k) * (dk ** -0.5)
    vc = chunks(v)
    ig = jnp.moveaxis(i_pre.astype(f32).reshape(B, nc, L, H), 3, 1)
    logf = jax.nn.log_sigmoid(jnp.moveaxis(f_pre.astype(f32).reshape(B, nc, L, H), 3, 1))
    bcum = jnp.cumsum(logf, axis=-1)
    b_last = bcum[..., -1]
    g = b_last[..., None] - bcum + ig
    g_max = jnp.max(g, axis=-1)
    w = jnp.exp(g - g_max[..., None])
    C_loc = jnp.einsum('bhcl,bhcld,bhcle->bhcde', w, kc, vc)
    n_loc = jnp.einsum('bhcl,bhcld->bhcd', w, kc)

    def step(carry, inp):
        C, n, m = carry
        Cl, nl, gm, bl = inp
        m_new = jnp.maximum(bl + m, gm)
        a = jnp.exp(bl + m - m_new)
        s = jnp.exp(gm - m_new)
        C_new = a[..., None, None] * C + s[..., None, None] * Cl
        n_new = a[..., None] * n + s[..., None] * nl
        return (C_new, n_new, m_new), (C, n, m)

    init = (jnp.zeros((B, H, dk, dv), f32), jnp.zeros((B, H, dk), f32),
            jnp.full((B, H), NEG_INF, f32))
    xs = (jnp.moveaxis(C_loc, 2, 0), jnp.moveaxis(n_loc, 2, 0),
          jnp.moveaxis(g_max, 2, 0), jnp.moveaxis(b_last, 2, 0))
    _, (C_in, n_in, m_in) = lax.scan(step, init, xs)
    C_in = jnp.moveaxis(C_in, 0, 2)
    n_in = jnp.moveaxis(n_in, 0, 2)
    m_in = jnp.moveaxis(m_in, 0, 2)

    a_log = bcum + m_in[..., None]
    D = bcum[..., :, None] - bcum[..., None, :] + ig[..., None, :]
    causal = jnp.tril(jnp.ones((L, L), dtype=bool))
    D = jnp.where(causal, D, NEG_INF)
    m_t = jnp.maximum(a_log, jnp.max(D, axis=-1))
    inter = jnp.exp(a_log - m_t)
    qk = jnp.einsum('bhctd,bhcsd->bhcts', qc, kc) * jnp.exp(D - m_t[..., None])
    num = (inter[..., None] * jnp.einsum('bhctd,bhcde->bhcte', qc, C_in)
           + jnp.einsum('bhcts,bhcse->bhcte', qk, vc))
    den = inter * jnp.einsum('bhctd,bhcd->bhct', qc, n_in) + jnp.sum(qk, axis=-1)
    h = num / jnp.maximum(jnp.abs(den), jnp.exp(-m_t))[..., None]
    return jnp.moveaxis(h, 1, 3).reshape(B, T, H * dv).astype(v.dtype)


def _head_rmsnorm(h, g):
    B, T, _ = h.shape
    return _rmsnorm(h.reshape(B, T, M_HEADS, M_V_DIM), 1).reshape(B, T, M_WIDTH) * g


def _hybrid_mixer(u, positions, w_in, conv_w, conv_b, b_igate, b_fgate, sinks,
                  mlstm_norm_g, w_att_up, w_mlstm_up, w_out):
    B, T, _ = u.shape
    proj = u @ w_in
    aq, ak, av, mqk, mv, mi, mf, mo, gates = _split_cols(proj, PROJ_SIZES)
    q = _partial_rope(aq.reshape(B, T, ATT_HEADS, ATT_HEAD_DIM), positions)
    k = _partial_rope(ak.reshape(B, T, ATT_KV_HEADS, ATT_HEAD_DIM), positions)
    v = av.reshape(B, T, ATT_KV_HEADS, ATT_HEAD_DIM)
    y_att = _sliding_window_attention(q, k, v, sinks) @ w_att_up
    mqk = jax.nn.silu(_causal_conv(mqk, conv_w, conv_b))
    mq, mk = jnp.split(mqk, 2, axis=-1)
    hm = _mlstm_chunkwise(mq.reshape(B, T, M_HEADS, M_QK_DIM),
                          mk.reshape(B, T, M_HEADS, M_QK_DIM),
                          mv.reshape(B, T, M_HEADS, M_V_DIM),
                          mi + b_igate, mf + b_fgate)
    hm = _head_rmsnorm(hm, mlstm_norm_g) * jax.nn.sigmoid(mo)
    y_m = hm @ w_mlstm_up
    g_att, g_m = jnp.split(jax.nn.sigmoid(gates), 2, axis=-1)
    return (g_att * y_att + g_m * y_m) @ w_out


def setup_inputs(seed: int = 0) -> dict:
    key = jax.random.key(seed)
    ks = jax.random.split(key, 24)
    f32 = jnp.float32
    D = D_MODEL

    def nrm(k, shape, scale):
        return jax.random.normal(k, shape, f32) * scale

    x = nrm(ks[0], (BATCH, SEQ, D), 1.0)
    c = nrm(ks[1], (BATCH, D), 1.0)
    offset = jax.random.randint(ks[2], (BATCH, 1), 0, 4096, dtype=jnp.int32)
    positions = (offset + jnp.arange(SEQ, dtype=jnp.int32)[None, :]).astype(jnp.int32)
    return {
        'x': x,
        'c': c,
        'positions': positions,
        'w_ada': nrm(ks[3], (DEPTH, D, N_MOD * D), 0.5 * D ** -0.5),
        'b_ada': nrm(ks[4], (DEPTH, N_MOD * D), 0.02),
        'norm1_g': 1.0 + nrm(ks[5], (DEPTH, D), 0.02),
        'ffn1_w_in': nrm(ks[6], (DEPTH, D, 2 * D_FF), D ** -0.5),
        'ffn1_w_out': nrm(ks[7], (DEPTH, D_FF, D), D_FF ** -0.5),
        'norm2_g': 1.0 + nrm(ks[8], (DEPTH, D), 0.02),
        'w_in': nrm(ks[9], (DEPTH, D, PROJ_OUT), D ** -0.5),
        'conv_w': nrm(ks[10], (DEPTH, CONV_WIDTH, 2 * M_QK_WIDTH), CONV_WIDTH ** -0.5),
        'conv_b': nrm(ks[11], (DEPTH, 2 * M_QK_WIDTH), 0.02),
        'b_igate': nrm(ks[12], (DEPTH, M_HEADS), 0.1),
        'b_fgate': jnp.linspace(3.0, 6.0, M_HEADS, dtype=f32)[None, :] + nrm(ks[13], (DEPTH, M_HEADS), 0.1),
        'sinks': nrm(ks[14], (DEPTH, ATT_HEADS), 1.0),
        'mlstm_norm_g': 1.0 + nrm(ks[15], (DEPTH, M_WIDTH), 0.02),
        'w_att_up': nrm(ks[16], (DEPTH, ATT_WIDTH, D), ATT_WIDTH ** -0.5),
        'w_mlstm_up': nrm(ks[17], (DEPTH, M_WIDTH, D), M_WIDTH ** -0.5),
        'w_out': nrm(ks[18], (DEPTH, D, D), D ** -0.5),
        'norm3_g': 1.0 + nrm(ks[19], (DEPTH, D), 0.02),
        'ffn2_w_in': nrm(ks[20], (DEPTH, D, 2 * D_FF), D ** -0.5),
        'ffn2_w_out': nrm(ks[21], (DEPTH, D_FF, D), D_FF ** -0.5),
        'final_g': 1.0 + nrm(ks[22], (D,), 0.02),
    }


def reference(x, c, positions, w_ada, b_ada, norm1_g, ffn1_w_in, ffn1_w_out, norm2_g,
              w_in, conv_w, conv_b, b_igate, b_fgate, sinks, mlstm_norm_g, w_att_up,
              w_mlstm_up, w_out, norm3_g, ffn2_w_in, ffn2_w_out, final_g):
    h = x
    cond = jax.nn.silu(c)
    for l in range(DEPTH):
        mod = cond @ w_ada[l] + b_ada[l]
        sh1, sc1, gt1, sh2, sc2, gt2, sh3, sc3, gt3 = [m[:, None, :] for m in jnp.split(mod, N_MOD, axis=-1)]
        u = _modulate(_rmsnorm(h, norm1_g[l]), sh1, sc1)
        h = h + 0.5 * gt1 * _swiglu(u, ffn1_w_in[l], ffn1_w_out[l])
        u = _modulate(_rmsnorm(h, norm2_g[l]), sh2, sc2)
        h = h + gt2 * _hybrid_mixer(u, positions, w_in[l], conv_w[l], conv_b[l], b_igate[l],
                                    b_fgate[l], sinks[l], mlstm_norm_g[l], w_att_up[l],
                                    w_mlstm_up[l], w_out[l])
        u = _modulate(_rmsnorm(h, norm3_g[l]), sh3, sc3)
        h = h + 0.5 * gt3 * _swiglu(u, ffn2_w_in[l], ffn2_w_out[l])
    return _rmsnorm(h, final_g)
```

```cpp
#include <hip/hip_runtime.h>
#include <hip/hip_cooperative_groups.h>
#include <cstdio>
#include <cstdint>
namespace cg = cooperative_groups;

#ifndef MK_MULTI
#define MK_MULTI 1
#endif

#define LAS __attribute__((address_space(3)))
typedef unsigned short bf16_t;
typedef short bf16x8 __attribute__((ext_vector_type(8)));
typedef float f32x4 __attribute__((ext_vector_type(4)));
typedef float f32x2 __attribute__((ext_vector_type(2)));
typedef unsigned u32x4 __attribute__((ext_vector_type(4)));
typedef unsigned u32x2 __attribute__((ext_vector_type(2)));

constexpr int M_ = 16384, D_ = 2048, T_ = 8192, DFF = 5632, NMOD = 18432, PROJ_OUT = 8456;
constexpr int PP = 8448;
constexpr int PC_Q = 0, PC_K = 1024, PC_V = 1152, PC_MQK = 1280, PC_MV = 2304, PC_MO = 3328, PC_G = 4352;
constexpr float EPS = 1e-6f;
constexpr size_t MiB = 1u << 20;
constexpr size_t WS_MOD = 0, MOD_BYTES = 2 * NMOD * 4;
constexpr size_t WS_ROPE = 1 * MiB, WS_GIF = 2 * MiB, WS_SCAL = 2 * MiB + 512 * 1024;
constexpr size_t WS_WIN = 4 * MiB, WS_WATT = 37 * MiB, WS_WML = 41 * MiB, WS_WOUT = 45 * MiB;
constexpr size_t WS_U = 53 * MiB;
constexpr size_t WS_R = 117 * MiB;
constexpr size_t WS_WFIN = WS_R, WS_WFOUT = WS_R + 44 * MiB, WS_ACT = WS_R + 66 * MiB;
constexpr size_t WS_P = WS_R, WS_CBUF = WS_R + 264 * MiB;
constexpr size_t WS_END = WS_CBUF + (size_t)1024 * 257 * 128 * 4;
constexpr int LDS_BYTES = 147456;

namespace pg8 {
constexpr int BM = 256, BK = 64, HALF = 128, HTB = HALF * BK * 2, STAGE_BYTES = 8 * HTB, NXCD = 8, WGM = 8;
__host__ __device__ __forceinline__ int lds_byte(int r, int c) { const int st = (r >> 4) * 2 + (c >> 5), rr = r & 15, cc = c & 31, ob = rr * 64 + cc * 2; return st * 1024 + (ob ^ (((ob >> 9) & 1) << 5)); }
__host__ __device__ __forceinline__ void stage_rc(int b, int& R, int& C) { const int st = b / 1024, sb = b % 1024, swz = sb ^ (((sb >> 9) & 1) << 5); R = (st >> 1) * 16 + swz / 64; C = (st & 1) * 32 + (swz % 64) / 2; }
__host__ __device__ __forceinline__ int perm32(int rho) { const int n = rho >> 4, i = rho & 15; return 8 * (i >> 2) + 4 * n + (i & 3); }
struct Unit { int pm, pn; };
struct Gemm { const bf16_t* A; const bf16_t* Bt; int M, N, K, lda; };
struct StaticOrder {
    int nM, nN, nwg, G, c;
    __host__ __device__ void init(int M, int N, int G_, int c_) { nM = M / BM; nN = N / BM; nwg = nM * nN; G = G_; c = c_; }
    __host__ __device__ bool next(int i, Unit& u) const {
        const long L = (long)i * G + c; if (L >= nwg) return false;
        int wgid = (int)L; { const int q = nwg / NXCD, r = nwg % NXCD, xcd = wgid % NXCD, off = wgid / NXCD; wgid = (xcd < r ? xcd * (q + 1) : r * (q + 1) + (xcd - r) * q) + off; }
        const int nig = WGM * nN, gid = wgid / nig, fm = gid * WGM, gsz = (nM - fm) < WGM ? (nM - fm) : WGM;
        u.pm = fm + ((wgid % nig) % gsz); u.pn = (wgid % nig) / gsz; return true;
    }
};
__device__ __forceinline__ unsigned cvt_pk_bf16(float lo, float hi) { unsigned r; asm volatile("v_cvt_pk_bf16_f32 %0, %1, %2" : "=v"(r) : "v"(lo), "v"(hi)); return r; }

template <class Epi>
__device__ __forceinline__ void gemm_phase(LAS unsigned char* lds, const Gemm g, const StaticOrder& S, const Epi& E) {
    const int tid = threadIdx.x, wid = __builtin_amdgcn_readfirstlane(tid >> 6), lane = tid & 63, wr = wid >> 2, wc = wid & 3, fr = lane & 15, fq = lane >> 4;
    const int K = g.K, nt = K / BK, lda = g.lda;
    unsigned voffA[2], voffB[2];
#pragma unroll
    for (int i = 0; i < 2; ++i) { int R, C; stage_rc(tid * 16 + i * 8192, R, C); const int Rb = (R & ~31) + perm32(R & 31);
        voffA[i] = (unsigned)(R * lda + C) * 2u; voffB[i] = (unsigned)(Rb * K + C) * 2u; }
    const size_t kstep = (size_t)(BK * 2);
    const size_t hstepA = (size_t)HALF * lda * 2, hstepB = (size_t)HALF * K * 2;
    const size_t tstepA = 2 * hstepA, tstepB = 2 * hstepB;
    const unsigned ldsw = (unsigned)wid * 1024u;
    const int aoff = lds_byte(wr * 64 + fr, fq * 8), boff = lds_byte(wc * 32 + fr, fq * 8);
#define PG8_SA(b, h) (((b) * 2 + (h)) * HTB)
#define PG8_SB(b, h) ((4 + (b) * 2 + (h)) * HTB)
#define PG8_STAGE(bufoff, gbase, voff) do { _Pragma("unroll") for (int _i = 0; _i < 2; ++_i) \
        __builtin_amdgcn_global_load_lds((const unsigned*)((const char*)(gbase) + (voff)[_i]), (LAS unsigned*)(lds + (bufoff) + ldsw + _i * 8192), 16, 0, 0); } while (0)
#define PG8_LDA(dst, b, h) do { _Pragma("unroll") for (int m = 0; m < 4; ++m) _Pragma("unroll") for (int k = 0; k < 2; ++k) dst[m][k] = *(const LAS bf16x8*)(lds + PG8_SA(b, h) + aoff + m * 2048 + k * 1024); } while (0)
#define PG8_LDB(dst, b, h) do { _Pragma("unroll") for (int n = 0; n < 2; ++n) _Pragma("unroll") for (int k = 0; k < 2; ++k) dst[n][k] = *(const LAS bf16x8*)(lds + PG8_SB(b, h) + boff + n * 2048 + k * 1024); } while (0)
#define PG8_MMA(ai, bj, At, Bt) do { __builtin_amdgcn_s_setprio(1); _Pragma("unroll") for (int m = 0; m < 4; ++m) _Pragma("unroll") for (int n = 0; n < 2; ++n) _Pragma("unroll") for (int k = 0; k < 2; ++k) \
        acc[ai][bj][m][n] = __builtin_amdgcn_mfma_f32_16x16x32_bf16(Bt[n][k], At[m][k], acc[ai][bj][m][n], 0, 0, 0); __builtin_amdgcn_s_setprio(0); } while (0)
#define PG8_WAIT_V(n) asm volatile("s_waitcnt vmcnt(" #n ")" ::: "memory")
#define PG8_WAIT_L(n) asm volatile("s_waitcnt lgkmcnt(" #n ")" ::: "memory")
#define PG8_BAR __builtin_amdgcn_s_barrier()
#define PG8_SCHED __builtin_amdgcn_sched_barrier(0)
    Unit cur, nxt; int ui = 0;
    if (!S.next(0, cur)) return;
    f32x4 acc[2][2][4][2];
#pragma unroll
    for (int a = 0; a < 2; ++a)
#pragma unroll
        for (int b = 0; b < 2; ++b)
#pragma unroll
            for (int m = 0; m < 4; ++m)
#pragma unroll
                for (int n = 0; n < 2; ++n) acc[a][b][m][n] = (f32x4){0.f, 0.f, 0.f, 0.f};
    bf16x8 At[4][2], B0[2][2], B1[2][2];
    const char* cA = (const char*)g.A + (size_t)cur.pm * tstepA; const char* cB = (const char*)g.Bt + (size_t)cur.pn * tstepB;
    PG8_STAGE(PG8_SB(0, 0), cB, voffB); PG8_STAGE(PG8_SB(0, 1), cB + hstepB, voffB); PG8_STAGE(PG8_SA(0, 0), cA, voffA); PG8_STAGE(PG8_SA(0, 1), cA + hstepA, voffA);
    if (wr == 1) PG8_BAR;
    PG8_WAIT_V(2); PG8_BAR;
    PG8_STAGE(PG8_SB(1, 0), cB + kstep, voffB); PG8_STAGE(PG8_SA(1, 0), cA + kstep, voffA); PG8_STAGE(PG8_SB(1, 1), cB + hstepB + kstep, voffB);
    PG8_WAIT_V(6); PG8_BAR;
    for (;;) {
        const bool has_next = S.next(ui + 1, nxt);
        const char* nA = has_next ? (const char*)g.A + (size_t)nxt.pm * tstepA : cA; const char* nB = has_next ? (const char*)g.Bt + (size_t)nxt.pn * tstepB : cB;
        for (int t = 0; t < nt; t += 2) {
            const bool last = (t == nt - 2);
            const char* a1 = cA + (size_t)(t + 1) * kstep;
            const char* a2 = last ? nA : cA + (size_t)(t + 2) * kstep; const char* b2 = last ? nB : cB + (size_t)(t + 2) * kstep;
            const char* a3 = a2 + kstep; const char* b3 = b2 + kstep;
            PG8_LDB(B0, 0, 0); PG8_LDB(B1, 0, 1); PG8_SCHED; PG8_LDA(At, 0, 0); PG8_STAGE(PG8_SA(1, 1), a1 + hstepA, voffA);
            PG8_WAIT_V(8); PG8_WAIT_L(0); PG8_BAR; PG8_MMA(0, 0, At, B0); PG8_MMA(0, 1, At, B1); PG8_BAR; PG8_SCHED;
            PG8_LDA(At, 0, 1); PG8_STAGE(PG8_SB(0, 0), b2, voffB); PG8_STAGE(PG8_SB(0, 1), b2 + hstepB, voffB); PG8_STAGE(PG8_SA(0, 0), a2, voffA);
            PG8_WAIT_V(8); PG8_WAIT_L(0); PG8_BAR; PG8_MMA(1, 0, At, B0); PG8_MMA(1, 1, At, B1); PG8_BAR; PG8_SCHED;
            PG8_LDB(B0, 1, 0); PG8_LDB(B1, 1, 1); PG8_SCHED; PG8_LDA(At, 1, 0); PG8_STAGE(PG8_SA(0, 1), a2 + hstepA, voffA);
            PG8_WAIT_V(8); PG8_WAIT_L(0); PG8_BAR; PG8_MMA(0, 0, At, B0); PG8_MMA(0, 1, At, B1); PG8_BAR; PG8_SCHED;
            PG8_LDA(At, 1, 1); PG8_STAGE(PG8_SB(1, 0), b3, voffB); PG8_STAGE(PG8_SB(1, 1), b3 + hstepB, voffB); PG8_STAGE(PG8_SA(1, 0), a3, voffA);
            PG8_WAIT_V(8); PG8_WAIT_L(0); PG8_BAR; PG8_MMA(1, 0, At, B0); PG8_MMA(1, 1, At, B1); PG8_BAR; PG8_SCHED;
        }
        if (wr == 0) PG8_BAR;
        E(acc, cur, wr, wc, fr, fq);
        if (!has_next) break;
#pragma unroll
        for (int a = 0; a < 2; ++a)
#pragma unroll
            for (int b = 0; b < 2; ++b)
#pragma unroll
                for (int m = 0; m < 4; ++m)
#pragma unroll
                    for (int n = 0; n < 2; ++n) acc[a][b][m][n] = (f32x4){0.f, 0.f, 0.f, 0.f};
        cur = nxt; cA = nA; cB = nB; ++ui;
        if (wr == 1) PG8_BAR;
    }
    PG8_WAIT_V(0);
    PG8_BAR;
#undef PG8_SA
#undef PG8_SB
#undef PG8_STAGE
#undef PG8_LDA
#undef PG8_LDB
#undef PG8_MMA
#undef PG8_WAIT_V
#undef PG8_WAIT_L
#undef PG8_BAR
#undef PG8_SCHED
}
}
using pg8::cvt_pk_bf16;
using pg8::Unit;

__device__ __forceinline__ float bf2f(unsigned short h) { return __uint_as_float((unsigned)h << 16); }
__device__ __forceinline__ float bflo(unsigned w) { return __uint_as_float(w << 16); }
__device__ __forceinline__ float bfhi(unsigned w) { return __uint_as_float(w & 0xffff0000u); }
__device__ __forceinline__ unsigned short f2bf(float f) { return (unsigned short)(cvt_pk_bf16(f, 0.f) & 0xffffu); }
__device__ __forceinline__ float sigm(float x) { return __builtin_amdgcn_rcpf(1.f + __expf(-x)); }
__device__ __forceinline__ float wave_sum(float v) {
#pragma unroll
    for (int o = 1; o < 64; o <<= 1) v += __shfl_xor(v, o);
    return v;
}
__device__ __forceinline__ float wave_max(float v) {
#pragma unroll
    for (int o = 1; o < 64; o <<= 1) v = fmaxf(v, __shfl_xor(v, o));
    return v;
}
__device__ __forceinline__ float log_sigmoid(float x) { return fminf(x, 0.f) - log1pf(expf(-fabsf(x))); }
__device__ __forceinline__ bf16x8 pack8(f32x4 a, f32x4 b) {
    u32x4 w; w.x = cvt_pk_bf16(a[0], a[1]); w.y = cvt_pk_bf16(a[2], a[3]); w.z = cvt_pk_bf16(b[0], b[1]); w.w = cvt_pk_bf16(b[2], b[3]);
    return __builtin_bit_cast(bf16x8, w);
}
__device__ __forceinline__ int kperm32(int kl) { return 8 * ((kl & 15) >> 2) + (kl & 3) + 4 * (kl >> 4); }

struct EpiSwiglu {
    bf16_t* O;
    __device__ __forceinline__ void operator()(const f32x4 (&acc)[2][2][4][2], const Unit& u, int wr, int wc, int fr, int fq) const {
        const int row0 = u.pm * 256 + wr * 64 + fr, col0 = u.pn * 128 + wc * 32 + 8 * fq;
#pragma unroll
        for (int ai = 0; ai < 2; ++ai)
#pragma unroll
            for (int m = 0; m < 4; ++m) {
                bf16_t* rowp = O + (size_t)(row0 + ai * 128 + m * 16) * DFF + col0;
                float v[8];
#pragma unroll
                for (int n = 0; n < 2; ++n)
#pragma unroll
                    for (int e = 0; e < 4; ++e) { const float a = acc[ai][0][m][n][e], b = acc[ai][1][m][n][e]; v[n * 4 + e] = a * sigm(a) * b; }
                u32x4 w; w.x = cvt_pk_bf16(v[0], v[1]); w.y = cvt_pk_bf16(v[2], v[3]); w.z = cvt_pk_bf16(v[4], v[5]); w.w = cvt_pk_bf16(v[6], v[7]);
                *(u32x4*)rowp = w;
            }
    }
};
struct EpiResid {
    const float* base; float* out; const float* gate; float scale;
    __device__ __forceinline__ void operator()(const f32x4 (&acc)[2][2][4][2], const Unit& u, int wr, int wc, int fr, int fq) const {
        const int row0 = u.pm * 256 + wr * 64 + fr, col0 = u.pn * 256 + wc * 32 + 8 * fq;
        const float* gp = gate + (size_t)(u.pm >> 5) * NMOD + col0;
        f32x4 gv[2][2];
#pragma unroll
        for (int bj = 0; bj < 2; ++bj)
#pragma unroll
            for (int n = 0; n < 2; ++n) gv[bj][n] = *(const f32x4*)(gp + bj * 128 + 4 * n) * scale;
#pragma unroll
        for (int ai = 0; ai < 2; ++ai)
#pragma unroll
            for (int m = 0; m < 4; ++m) {
                const size_t off = (size_t)(row0 + ai * 128 + m * 16) * D_ + col0;
#pragma unroll
                for (int bj = 0; bj < 2; ++bj)
#pragma unroll
                    for (int n = 0; n < 2; ++n) { const f32x4 bs = *(const f32x4*)(base + off + bj * 128 + 4 * n); *(f32x4*)(out + off + bj * 128 + 4 * n) = bs + gv[bj][n] * acc[ai][bj][m][n]; }
            }
    }
};
struct EpiProj {
    bf16_t* P; const float* rope;
    __device__ __forceinline__ void operator()(const f32x4 (&acc)[2][2][4][2], const Unit& u, int wr, int wc, int fr, int fq) const {
        const int row0 = u.pm * 256 + wr * 64 + fr, col0 = u.pn * 256 + wc * 32 + 8 * fq;
        const bool sig = u.pn >= 13;
        const bool ropelane = ((wc & 1) == 0) && (fq < 2) && (u.pn <= 4);
#pragma unroll
        for (int ai = 0; ai < 2; ++ai)
#pragma unroll
            for (int m = 0; m < 4; ++m) {
                const int row = row0 + ai * 128 + m * 16;
                f32x4 cs = {1.f, 1.f, 1.f, 1.f}, sn = {0.f, 0.f, 0.f, 0.f};
                if (ropelane) { cs = *(const f32x4*)(rope + (size_t)row * 16 + fq * 4); sn = *(const f32x4*)(rope + (size_t)row * 16 + 8 + fq * 4); }
#pragma unroll
                for (int bj = 0; bj < 2; ++bj) {
                    f32x4 v0 = acc[ai][bj][m][0], v1 = acc[ai][bj][m][1];
                    if (ropelane && (u.pn < 4 || bj == 0)) { const f32x4 x1 = v0, x2 = v1; v0 = x1 * cs - x2 * sn; v1 = x2 * cs + x1 * sn; }
                    if (sig) {
#pragma unroll
                        for (int e = 0; e < 4; ++e) { v0[e] = sigm(v0[e]); v1[e] = sigm(v1[e]); }
                    }
                    u32x4 w; w.x = cvt_pk_bf16(v0[0], v0[1]); w.y = cvt_pk_bf16(v0[2], v0[3]); w.z = cvt_pk_bf16(v1[0], v1[1]); w.w = cvt_pk_bf16(v1[2], v1[3]);
                    *(u32x4*)(P + (size_t)row * PP + col0 + bj * 128) = w;
                }
            }
    }
};
struct EpiMerge {
    bf16_t* P; int first;
    __device__ __forceinline__ void operator()(const f32x4 (&acc)[2][2][4][2], const Unit& u, int wr, int wc, int fr, int fq) const {
        const int row0 = u.pm * 256 + wr * 64 + fr, col0 = u.pn * 256 + wc * 32 + 8 * fq;
#pragma unroll
        for (int ai = 0; ai < 2; ++ai)
#pragma unroll
            for (int m = 0; m < 4; ++m)
#pragma unroll
                for (int bj = 0; bj < 2; ++bj) {
                    bf16_t* zp = P + (size_t)(row0 + ai * 128 + m * 16) * PP + PC_G + col0 + bj * 128;
                    const u32x4 z8 = *(const u32x4*)zp;
                    u32x4 g8 = z8; if (!first) g8 = *(const u32x4*)(zp + 2048);
                    const f32x4 a0 = acc[ai][bj][m][0], a1 = acc[ai][bj][m][1];
                    float o[8];
                    o[0] = bflo(g8.x) * a0[0]; o[1] = bfhi(g8.x) * a0[1]; o[2] = bflo(g8.y) * a0[2]; o[3] = bfhi(g8.y) * a0[3];
                    o[4] = bflo(g8.z) * a1[0]; o[5] = bfhi(g8.z) * a1[1]; o[6] = bflo(g8.w) * a1[2]; o[7] = bfhi(g8.w) * a1[3];
                    if (!first) { o[0] += bflo(z8.x); o[1] += bfhi(z8.x); o[2] += bflo(z8.y); o[3] += bfhi(z8.y); o[4] += bflo(z8.z); o[5] += bfhi(z8.z); o[6] += bflo(z8.w); o[7] += bfhi(z8.w); }
                    u32x4 w; w.x = cvt_pk_bf16(o[0], o[1]); w.y = cvt_pk_bf16(o[2], o[3]); w.z = cvt_pk_bf16(o[4], o[5]); w.w = cvt_pk_bf16(o[6], o[7]);
                    *(u32x4*)zp = w;
                }
    }
};

struct Args {
    const float* x; const float* c; const int* pos; const float* w_ada; const float* b_ada; const float* norm1_g;
    const float* f1_in; const float* f1_out; const float* norm2_g; const float* w_in; const float* conv_w; const float* conv_b;
    const float* b_ig; const float* b_fg; const float* sinks; const float* mnorm_g; const float* w_att; const float* w_ml;
    const float* w_out; const float* norm3_g; const float* f2_in; const float* f2_out; const float* final_g;
    float* out; unsigned char* ws; int ph_lo, ph_hi;
};

template <int KIND> __device__ __forceinline__ int srccol(int n) {
    if (KIND == 0) return n;
    if (KIND == 1) { const int pn = n >> 8, bj = (n >> 7) & 1, i = n & 127; return bj * DFF + pn * 128 + i; }
    if (n < PC_V) { const int d = n & 63; if (d < 16) { const int g = d >> 2; const int dd = (g == 1) ? d + 4 : (g == 2) ? d - 4 : d; return (n & ~63) + dd; } return n; }
    if (n < PC_MO) return n;
    return n + 8;
}
template <int KIND> __device__ __forceinline__ void transpose_item(const float* W, int K, int N, bf16_t* WT, LAS float* scr, int item, int lane, int nblk) {
    const int kb = item / nblk, nb = item % nblk, k0 = 64 * kb, n0 = 32 * nb;
    const int sc = srccol<KIND>(n0 + (lane & 31));
#pragma unroll 8
    for (int i = 0; i < 32; ++i) { const int kk = 2 * i + (lane >> 5); scr[kk * 33 + (lane & 31)] = W[(size_t)(k0 + kk) * N + sc]; }
    asm volatile("s_waitcnt lgkmcnt(0)" ::: "memory");
    const int c = lane & 7;
#pragma unroll
    for (int j = 0; j < 4; ++j) { const int n = (lane >> 3) + 8 * j; const LAS float* s = scr + (8 * c) * 33 + n;
        u32x4 o; o.x = cvt_pk_bf16(s[0 * 33], s[1 * 33]); o.y = cvt_pk_bf16(s[2 * 33], s[3 * 33]); o.z = cvt_pk_bf16(s[4 * 33], s[5 * 33]); o.w = cvt_pk_bf16(s[6 * 33], s[7 * 33]);
        *(u32x4*)(WT + (size_t)(n0 + n) * K + k0 + 8 * c) = o; }
    asm volatile("s_waitcnt lgkmcnt(0)" ::: "memory");
}
template <int KIND> __device__ __forceinline__ void transpose_all(const float* W, int K, int N, int Nout, bf16_t* WT, LAS float* scr, int gw, int ngw, int lane) {
    const int nblk = Nout / 32, items = (K / 64) * nblk;
    for (int it = gw; it < items; it += ngw) transpose_item<KIND>(W, K, N, WT, scr, it, lane, nblk);
}

template <bool GATES> __device__ __forceinline__ void norm_phase(const float* hin, const float* g, const float* mod, int sh_off, int sc_off, bf16_t* uout,
                                                                 float* gif, const float* w_in, LAS unsigned char* lds, int tid, int wave, int lane) {
    LAS float* wgT = (LAS float*)lds;
    if (GATES) {
        for (int idx = tid; idx < 2048 * 8; idx += 512) { const int k = idx >> 3, j = idx & 7; wgT[j * 2048 + k] = w_in[(size_t)k * PROJ_OUT + 3328 + j]; }
        __syncthreads();
    }
    const int gw = blockIdx.x * 8 + wave, ngw = gridDim.x * 8;
    for (int row = gw; row < M_; row += ngw) {
        const int b = row >> 13;
        const f32x4* xr = (const f32x4*)(hin + (size_t)row * D_) + lane;
        f32x4 v[8]; float ss = 0.f;
#pragma unroll
        for (int j = 0; j < 8; ++j) { v[j] = xr[64 * j]; ss += (v[j][0] * v[j][0] + v[j][1] * v[j][1]) + (v[j][2] * v[j][2] + v[j][3] * v[j][3]); }
        const float rstd = 1.0f / sqrtf(wave_sum(ss) * (1.0f / D_) + EPS);
        float ga[8];
#pragma unroll
        for (int i = 0; i < 8; ++i) ga[i] = 0.f;
#pragma unroll
        for (int j = 0; j < 8; ++j) {
            const int col = 256 * j + 4 * lane;
            const f32x4 g4 = *(const f32x4*)(g + col), sc4 = *(const f32x4*)(mod + (size_t)b * NMOD + sc_off + col), sh4 = *(const f32x4*)(mod + (size_t)b * NMOD + sh_off + col);
            const f32x4 y = (v[j] * rstd) * g4 * (sc4 + 1.0f) + sh4;
            u32x2 w; w.x = cvt_pk_bf16(y[0], y[1]); w.y = cvt_pk_bf16(y[2], y[3]);
            *(u32x2*)(uout + (size_t)row * D_ + col) = w;
            if (GATES) {
#pragma unroll
                for (int i = 0; i < 8; ++i) { const f32x4 w4 = *(const LAS f32x4*)(wgT + i * 2048 + col); ga[i] += (y[0] * w4[0] + y[1] * w4[1]) + (y[2] * w4[2] + y[3] * w4[3]); }
            }
        }
        if (GATES) {
#pragma unroll
            for (int i = 0; i < 8; ++i) ga[i] = wave_sum(ga[i]);
            if (lane == 0) { *(f32x4*)(gif + (size_t)row * 8) = (f32x4){ga[0], ga[1], ga[2], ga[3]}; *(f32x4*)(gif + (size_t)row * 8 + 4) = (f32x4){ga[4], ga[5], ga[6], ga[7]}; }
        }
    }
    if (GATES) __syncthreads();
}

__device__ __forceinline__ void attn_item(int item, bf16_t* P, const float* sinks, LAS unsigned char* lds, int tid, int wave, int lane) {
    const int kvh = item & 1, nb = (item >> 1) & 63, b = item >> 7;
    const int r0 = b * T_ + nb * 128;
    LAS bf16_t* Ksh = (LAS bf16_t*)lds;
    LAS bf16_t* VT = (LAS bf16_t*)(lds + 36864);
#pragma unroll
    for (int i = 0; i < 4; ++i) {
        const int chunk = tid + 512 * i, key = chunk >> 3, c8 = chunk & 7;
        const bool valid = (nb > 0) || (key >= 128);
        u32x4 kv = {0u, 0u, 0u, 0u}, vv = {0u, 0u, 0u, 0u};
        if (valid) { const bf16_t* rp = P + (size_t)(r0 - 128 + key) * PP; kv = *(const u32x4*)(rp + PC_K + kvh * 64 + c8 * 8); vv = *(const u32x4*)(rp + PC_V + kvh * 64 + c8 * 8); }
        *(LAS u32x4*)(Ksh + key * 72 + c8 * 8) = kv;
        const int pos = (key & ~31) + kperm32(key & 31);
        LAS bf16_t* vp = VT + (c8 * 8) * 264 + pos;
        vp[0 * 264] = (bf16_t)(vv.x & 0xffff); vp[1 * 264] = (bf16_t)(vv.x >> 16); vp[2 * 264] = (bf16_t)(vv.y & 0xffff); vp[3 * 264] = (bf16_t)(vv.y >> 16);
        vp[4 * 264] = (bf16_t)(vv.z & 0xffff); vp[5 * 264] = (bf16_t)(vv.z >> 16); vp[6 * 264] = (bf16_t)(vv.w & 0xffff); vp[7 * 264] = (bf16_t)(vv.w >> 16);
    }
    __syncthreads();
    const int h = kvh * 8 + wave, fr = lane & 15, fq = lane >> 4;
    const float sink = sinks[h];
    for (int qg = 0; qg < 8; ++qg) {
        const int qrow = r0 + qg * 16 + fr;
        bf16_t* qp = P + (size_t)qrow * PP + h * 64;
        const bf16x8 bq0 = *(const bf16x8*)(qp + 8 * fq), bq1 = *(const bf16x8*)(qp + 32 + 8 * fq);
        const int t0e = qg & ~1;
        f32x4 s[10];
#pragma unroll
        for (int tt = 0; tt < 10; ++tt) {
            const int t = min(t0e + tt, 15);
            const LAS bf16_t* kp = Ksh + (t * 16 + fr) * 72 + 8 * fq;
            const bf16x8 a0 = *(const LAS bf16x8*)kp, a1 = *(const LAS bf16x8*)(kp + 32);
            f32x4 z = {0.f, 0.f, 0.f, 0.f};
            z = __builtin_amdgcn_mfma_f32_16x16x32_bf16(a0, bq0, z, 0, 0, 0);
            s[tt] = __builtin_amdgcn_mfma_f32_16x16x32_bf16(a1, bq1, z, 0, 0, 0);
        }
        const int qi = 128 + qg * 16 + fr;
        float mx = -1e30f;
#pragma unroll
        for (int tt = 0; tt < 10; ++tt)
#pragma unroll
            for (int r = 0; r < 4; ++r) {
                const int kj = (t0e + tt) * 16 + 4 * fq + r;
                const bool ok = (kj <= qi) && (kj > qi - 128) && ((nb > 0) || (kj >= 128));
                const float sv = ok ? s[tt][r] * 0.125f : -1e30f;
                s[tt][r] = sv; mx = fmaxf(mx, sv);
            }
        mx = fmaxf(mx, __shfl_xor(mx, 16)); mx = fmaxf(mx, __shfl_xor(mx, 32)); mx = fmaxf(mx, sink);
        float sum = 0.f;
#pragma unroll
        for (int tt = 0; tt < 10; ++tt)
#pragma unroll
            for (int r = 0; r < 4; ++r) { const float p = __expf(s[tt][r] - mx); s[tt][r] = p; sum += p; }
        sum += __shfl_xor(sum, 16); sum += __shfl_xor(sum, 32);
        const float inv = 1.0f / (sum + __expf(sink - mx));
        bf16x8 bp[5];
#pragma unroll
        for (int g = 0; g < 5; ++g) bp[g] = pack8(s[2 * g], s[2 * g + 1]);
#pragma unroll
        for (int dt = 0; dt < 4; ++dt) {
            f32x4 o = {0.f, 0.f, 0.f, 0.f};
#pragma unroll
            for (int g = 0; g < 5; ++g) {
                const int grp = min((t0e >> 1) + g, 7);
                const bf16x8 a = *(const LAS bf16x8*)(VT + (dt * 16 + fr) * 264 + grp * 32 + 8 * fq);
                o = __builtin_amdgcn_mfma_f32_16x16x32_bf16(a, bp[g], o, 0, 0, 0);
            }
            u32x2 w; w.x = cvt_pk_bf16(o[0] * inv, o[1] * inv); w.y = cvt_pk_bf16(o[2] * inv, o[3] * inv);
            *(u32x2*)(qp + dt * 16 + 4 * fq) = w;
        }
    }
    __syncthreads();
}

__device__ __forceinline__ void m1_item(int item, const bf16_t* P, bf16_t* QK, const float* gif, const float* conv_w, const float* conv_b, const float* b_ig, const float* b_fg,
                                        float* Cbuf, float* scal, LAS unsigned char* lds, int tid, int wave, int lane) {
    const int c = item & 127, h = (item >> 7) & 3, b = item >> 9;
    const int r0 = b * T_ + c * 64;
    LAS bf16_t* VT = (LAS bf16_t*)lds;
    LAS bf16_t* KT = (LAS bf16_t*)(lds + 39168);
    LAS float* wl = (LAS float*)(lds + 57600);
    if (wave == 0) {
        const int row = r0 + lane;
        const float fpre = gif[(size_t)row * 8 + 4 + h] + b_fg[h], ipre = gif[(size_t)row * 8 + h] + b_ig[h];
        float bc = log_sigmoid(fpre);
#pragma unroll
        for (int o = 1; o < 64; o <<= 1) { const float t = __shfl_up(bc, o); if (lane >= o) bc += t; }
        const float blast = __shfl(bc, 63);
        const float gg = blast - bc + ipre;
        const float gmax = wave_max(gg);
        wl[lane] = expf(gg - gmax);
        if (lane == 0) { scal[item * 4 + 0] = gmax; scal[item * 4 + 1] = blast; }
    }
    for (int idx = tid; idx < 16 * 72; idx += 512) VT[256 * 72 + idx] = (idx < 64) ? (bf16_t)0x3F80 : (bf16_t)0;
    __syncthreads();
#pragma unroll
    for (int i = 0; i < 4; ++i) {
        const int task = tid + 512 * i, tl = task & 63, ch8 = task >> 6, qk = ch8 >> 4, j0 = (ch8 & 15) * 8;
        const int chan = qk * 512 + h * 128 + j0;
        float a[8];
        { const f32x4 b0 = *(const f32x4*)(conv_b + chan), b1 = *(const f32x4*)(conv_b + chan + 4); a[0] = b0[0]; a[1] = b0[1]; a[2] = b0[2]; a[3] = b0[3]; a[4] = b1[0]; a[5] = b1[1]; a[6] = b1[2]; a[7] = b1[3]; }
#pragma unroll
        for (int kk = 0; kk < 4; ++kk) {
            const int ts = c * 64 + tl - 3 + kk;
            if (ts >= 0) {
                const u32x4 x8 = *(const u32x4*)(P + (size_t)(b * T_ + ts) * PP + PC_MQK + chan);
                const f32x4 w0 = *(const f32x4*)(conv_w + kk * 1024 + chan), w1 = *(const f32x4*)(conv_w + kk * 1024 + chan + 4);
                a[0] += w0[0] * bflo(x8.x); a[1] += w0[1] * bfhi(x8.x); a[2] += w0[2] * bflo(x8.y); a[3] += w0[3] * bfhi(x8.y);
                a[4] += w1[0] * bflo(x8.z); a[5] += w1[1] * bfhi(x8.z); a[6] += w1[2] * bflo(x8.w); a[7] += w1[3] * bfhi(x8.w);
            }
        }
        const float ksc = qk ? 0.08838834764831845f : 1.0f;
#pragma unroll
        for (int e = 0; e < 8; ++e) a[e] = a[e] * sigm(a[e]) * ksc;
        u32x4 w; w.x = cvt_pk_bf16(a[0], a[1]); w.y = cvt_pk_bf16(a[2], a[3]); w.z = cvt_pk_bf16(a[4], a[5]); w.w = cvt_pk_bf16(a[6], a[7]);
        *(u32x4*)(QK + (size_t)(r0 + tl) * 1024 + chan) = w;
        if (qk) {
            const float wt = wl[tl];
#pragma unroll
            for (int e = 0; e < 8; ++e) KT[(j0 + e) * 72 + tl] = f2bf(a[e] * wt);
        }
    }
#pragma unroll
    for (int i = 0; i < 4; ++i) {
        const int task = tid + 512 * i, tl = task & 63, ce = task >> 6;
        const u32x4 vv = *(const u32x4*)(P + (size_t)(r0 + tl) * PP + PC_MV + h * 256 + ce * 8);
        LAS bf16_t* vp = VT + (ce * 8) * 72 + tl;
        vp[0 * 72] = (bf16_t)(vv.x & 0xffff); vp[1 * 72] = (bf16_t)(vv.x >> 16); vp[2 * 72] = (bf16_t)(vv.y & 0xffff); vp[3 * 72] = (bf16_t)(vv.y >> 16);
        vp[4 * 72] = (bf16_t)(vv.z & 0xffff); vp[5 * 72] = (bf16_t)(vv.z >> 16); vp[6 * 72] = (bf16_t)(vv.w & 0xffff); vp[7 * 72] = (bf16_t)(vv.w >> 16);
    }
    __syncthreads();
    const int fr = lane & 15, fq = lane >> 4;
    float* Cit = Cbuf + (size_t)item * 257 * 128;
#pragma unroll
    for (int et2 = 0; et2 < 2; ++et2) {
        const int et = 2 * wave + et2;
        const bf16x8 a0 = *(const LAS bf16x8*)(VT + (et * 16 + fr) * 72 + 8 * fq), a1 = *(const LAS bf16x8*)(VT + (et * 16 + fr) * 72 + 32 + 8 * fq);
#pragma unroll
        for (int dt = 0; dt < 8; ++dt) {
            const bf16x8 b0 = *(const LAS bf16x8*)(KT + (dt * 16 + fr) * 72 + 8 * fq), b1 = *(const LAS bf16x8*)(KT + (dt * 16 + fr) * 72 + 32 + 8 * fq);
            f32x4 z = {0.f, 0.f, 0.f, 0.f};
            z = __builtin_amdgcn_mfma_f32_16x16x32_bf16(a0, b0, z, 0, 0, 0);
            z = __builtin_amdgcn_mfma_f32_16x16x32_bf16(a1, b1, z, 0, 0, 0);
#pragma unroll
            for (int r = 0; r < 4; ++r) Cit[(size_t)(et * 16 + 4 * fq + r) * 128 + dt * 16 + fr] = z[r];
        }
    }
    if (wave == 0) {
        const bf16x8 a0 = *(const LAS bf16x8*)(VT + (256 + fr) * 72 + 8 * fq), a1 = *(const LAS bf16x8*)(VT + (256 + fr) * 72 + 32 + 8 * fq);
#pragma unroll
        for (int dt = 0; dt < 8; ++dt) {
            const bf16x8 b0 = *(const LAS bf16x8*)(KT + (dt * 16 + fr) * 72 + 8 * fq), b1 = *(const LAS bf16x8*)(KT + (dt * 16 + fr) * 72 + 32 + 8 * fq);
            f32x4 z = {0.f, 0.f, 0.f, 0.f};
            z = __builtin_amdgcn_mfma_f32_16x16x32_bf16(a0, b0, z, 0, 0, 0);
            z = __builtin_amdgcn_mfma_f32_16x16x32_bf16(a1, b1, z, 0, 0, 0);
            if (fq == 0) Cit[(size_t)256 * 128 + dt * 16 + fr] = z[0];
        }
    }
    __syncthreads();
}

__device__ __forceinline__ void m2_scan(float* Cbuf, float* scal, int gtid, int gthreads) {
    constexpr int PER_BH = 257 * 32, TOTAL = 8 * PER_BH;
    constexpr size_t CSTRIDE = (size_t)257 * 128;
    for (int w = gtid; w < TOTAL; w += gthreads) {
        const int bh = w / PER_BH, rem = w % PER_BH, e = rem >> 5, d4 = (rem & 31) * 4;
        float* ptr = Cbuf + ((size_t)bh * 128 * 257 + e) * 128 + d4;
        const bool lead = (rem == 0);
        f32x4 C = {0.f, 0.f, 0.f, 0.f}; float m = -1e30f;
        for (int c0 = 0; c0 < 128; c0 += 8) {
            f32x4 cl[8]; float gm[8], bl[8];
#pragma unroll
            for (int u = 0; u < 8; ++u) { cl[u] = *(const f32x4*)(ptr + (size_t)(c0 + u) * CSTRIDE); gm[u] = scal[(bh * 128 + c0 + u) * 4]; bl[u] = scal[(bh * 128 + c0 + u) * 4 + 1]; }
#pragma unroll
            for (int u = 0; u < 8; ++u) {
                *(f32x4*)(ptr + (size_t)(c0 + u) * CSTRIDE) = C;
                if (lead) scal[(bh * 128 + c0 + u) * 4 + 2] = m;
                const float mn = fmaxf(bl[u] + m, gm[u]);
                const float a = expf(bl[u] + m - mn), s = expf(gm[u] - mn);
                C = C * a + cl[u] * s; m = mn;
            }
        }
    }
}

__device__ __forceinline__ void m3_item(int item, bf16_t* P, const bf16_t* QK, const float* gif, const float* b_ig, const float* b_fg, const float* Cbuf, const float* scal,
                                        const float* norm_g, LAS unsigned char* lds, int tid, int wave, int lane) {
    const int c = item & 127, h = (item >> 7) & 3, b = item >> 9;
    const int r0 = b * T_ + c * 64;
    LAS bf16_t* VT = (LAS bf16_t*)lds;
    LAS float* tb = (LAS float*)(lds + 36864);
    LAS float* red = tb + 256;
    if (wave == 0) {
        const int row = r0 + lane;
        const float fpre = gif[(size_t)row * 8 + 4 + h] + b_fg[h], ipre = gif[(size_t)row * 8 + h] + b_ig[h];
        float bc = log_sigmoid(fpre);
#pragma unroll
        for (int o = 1; o < 64; o <<= 1) { const float t = __shfl_up(bc, o); if (lane >= o) bc += t; }
        const float gs = ipre - bc;
        float mxs = gs;
#pragma unroll
        for (int o = 1; o < 64; o <<= 1) { const float t = __shfl_up(mxs, o); if (lane >= o) mxs = fmaxf(mxs, t); }
        const float m_in = scal[item * 4 + 2];
        const float alog = bc + m_in;
        const float mt = fmaxf(alog, bc + mxs);
        tb[lane] = bc; tb[64 + lane] = gs; tb[128 + lane] = mt; tb[192 + lane] = expf(alog - mt);
    }
#pragma unroll
    for (int i = 0; i < 4; ++i) {
        const int task = tid + 512 * i, tl = task & 63, ce = task >> 6;
        const u32x4 vv = *(const u32x4*)(P + (size_t)(r0 + tl) * PP + PC_MV + h * 256 + ce * 8);
        const int pos = (tl & 32) + kperm32(tl & 31);
        LAS bf16_t* vp = VT + (ce * 8) * 72 + pos;
        vp[0 * 72] = (bf16_t)(vv.x & 0xffff); vp[1 * 72] = (bf16_t)(vv.x >> 16); vp[2 * 72] = (bf16_t)(vv.y & 0xffff); vp[3 * 72] = (bf16_t)(vv.y >> 16);
        vp[4 * 72] = (bf16_t)(vv.z & 0xffff); vp[5 * 72] = (bf16_t)(vv.z >> 16); vp[6 * 72] = (bf16_t)(vv.w & 0xffff); vp[7 * 72] = (bf16_t)(vv.w >> 16);
    }
    __syncthreads();
    const int fr = lane & 15, fq = lane >> 4, tt = wave & 3, eh = wave >> 2;
    const int t = tt * 16 + fr;
    const bf16_t* qp = QK + (size_t)(r0 + t) * 1024 + h * 128 + 8 * fq;
    bf16x8 bq[4];
#pragma unroll
    for (int ks = 0; ks < 4; ++ks) bq[ks] = *(const bf16x8*)(qp + ks * 32);
    f32x4 sacc[4];
#pragma unroll
    for (int st = 0; st < 4; ++st) {
        const bf16_t* kp = QK + (size_t)(r0 + st * 16 + fr) * 1024 + 512 + h * 128 + 8 * fq;
        f32x4 z = {0.f, 0.f, 0.f, 0.f};
#pragma unroll
        for (int ks = 0; ks < 4; ++ks) z = __builtin_amdgcn_mfma_f32_16x16x32_bf16(*(const bf16x8*)(kp + ks * 32), bq[ks], z, 0, 0, 0);
        sacc[st] = z;
    }
    const float bc_t = tb[t], mt_t = tb[128 + t], inter_t = tb[192 + t];
    float dsum = 0.f;
#pragma unroll
    for (int st = 0; st < 4; ++st)
#pragma unroll
        for (int r = 0; r < 4; ++r) {
            const int s = st * 16 + 4 * fq + r;
            const float wgt = (s <= t) ? __expf(bc_t + tb[64 + s] - mt_t) : 0.f;
            const float qk = sacc[st][r] * wgt; sacc[st][r] = qk; dsum += qk;
        }
    dsum += __shfl_xor(dsum, 16); dsum += __shfl_xor(dsum, 32);
    bf16x8 bp[2];
    bp[0] = pack8(sacc[0], sacc[1]); bp[1] = pack8(sacc[2], sacc[3]);
    const float* Cin = Cbuf + (size_t)item * 257 * 128;
    f32x4 acc[8];
#pragma unroll
    for (int et = 0; et < 8; ++et) {
        const float* cp = Cin + (size_t)((eh * 8 + et) * 16 + fr) * 128 + 8 * fq;
        f32x4 z = {0.f, 0.f, 0.f, 0.f};
#pragma unroll
        for (int ks = 0; ks < 4; ++ks) { const f32x4 f0 = *(const f32x4*)(cp + ks * 32), f1 = *(const f32x4*)(cp + ks * 32 + 4); z = __builtin_amdgcn_mfma_f32_16x16x32_bf16(pack8(f0, f1), bq[ks], z, 0, 0, 0); }
        acc[et] = z;
    }
    float qn;
    {
        const float* np = Cin + (size_t)256 * 128 + 8 * fq;
        f32x4 z = {0.f, 0.f, 0.f, 0.f};
#pragma unroll
        for (int ks = 0; ks < 4; ++ks) { const f32x4 f0 = *(const f32x4*)(np + ks * 32), f1 = *(const f32x4*)(np + ks * 32 + 4); z = __builtin_amdgcn_mfma_f32_16x16x32_bf16(pack8(f0, f1), bq[ks], z, 0, 0, 0); }
        qn = z[0];
    }
#pragma unroll
    for (int et = 0; et < 8; ++et) {
        f32x4 z = acc[et] * inter_t;
#pragma unroll
        for (int g = 0; g < 2; ++g) z = __builtin_amdgcn_mfma_f32_16x16x32_bf16(*(const LAS bf16x8*)(VT + ((eh * 8 + et) * 16 + fr) * 72 + g * 32 + 8 * fq), bp[g], z, 0, 0, 0);
        acc[et] = z;
    }
    const float den = inter_t * qn + dsum;
    const float inv = 1.0f / fmaxf(fabsf(den), expf(-mt_t));
    float ss = 0.f;
#pragma unroll
    for (int et = 0; et < 8; ++et) { acc[et] = acc[et] * inv; ss += (acc[et][0] * acc[et][0] + acc[et][1] * acc[et][1]) + (acc[et][2] * acc[et][2] + acc[et][3] * acc[et][3]); }
    ss += __shfl_xor(ss, 16); ss += __shfl_xor(ss, 32);
    if (fq == 0) red[eh * 64 + t] = ss;
    __syncthreads();
    const float rstd = 1.0f / sqrtf((red[t] + red[64 + t]) * (1.0f / 256.0f) + EPS);
    bf16_t* prow = P + (size_t)(r0 + t) * PP;
#pragma unroll
    for (int et = 0; et < 8; ++et) {
        const int e0 = h * 256 + (eh * 8 + et) * 16 + 4 * fq;
        const f32x4 gn = *(const f32x4*)(norm_g + e0);
        const u32x2 mo = *(const u32x2*)(prow + PC_MO + e0);
        const f32x4 o = acc[et] * rstd * gn;
        u32x2 w; w.x = cvt_pk_bf16(o[0] * bflo(mo.x), o[1] * bfhi(mo.x)); w.y = cvt_pk_bf16(o[2] * bflo(mo.y), o[3] * bfhi(mo.y));
        *(u32x2*)(prow + PC_MV + e0) = w;
    }
    __syncthreads();
}

constexpr int N_PHASES = 15;
__global__ void __launch_bounds__(512, 2) fwd_kernel(Args a) {
    extern __shared__ __attribute__((aligned(16))) unsigned char lds_raw[];
    LAS unsigned char* lds = (LAS unsigned char*)lds_raw;
    const int tid = threadIdx.x, lane = tid & 63, wave = __builtin_amdgcn_readfirstlane(tid >> 6);
    const int G = gridDim.x;
    unsigned char* ws = a.ws;
    float* mod = (float*)(ws + WS_MOD); float* rope = (float*)(ws + WS_ROPE); float* gif = (float*)(ws + WS_GIF); float* scal = (float*)(ws + WS_SCAL);
    bf16_t* WinT = (bf16_t*)(ws + WS_WIN); bf16_t* WattT = (bf16_t*)(ws + WS_WATT); bf16_t* WmlT = (bf16_t*)(ws + WS_WML); bf16_t* WoutT = (bf16_t*)(ws + WS_WOUT);
    bf16_t* U = (bf16_t*)(ws + WS_U); bf16_t* QK = U;
    bf16_t* WfinT = (bf16_t*)(ws + WS_WFIN); bf16_t* WfoutT = (bf16_t*)(ws + WS_WFOUT); bf16_t* ACT = (bf16_t*)(ws + WS_ACT);
    bf16_t* P = (bf16_t*)(ws + WS_P); float* Cbuf = (float*)(ws + WS_CBUF);
    float* H = a.out;
    const int lo = a.ph_lo, hi = a.ph_hi;
    const int gw = blockIdx.x * 8 + wave, ngw = G * 8;
#define IN(k) (lo <= (k) && (k) < hi)
#if MK_MULTI
#define SEAM(k) do {} while (0)
#else
#define SEAM(k) do { if (IN(k) && IN((k) + 1)) { __threadfence(); cg::this_grid().sync(); } } while (0)
#endif
    if (IN(0)) {
        LAS float* scr = (LAS float*)(lds + wave * 16384);
        transpose_all<1>(a.f1_in, D_, 2 * DFF, 2 * DFF, WfinT, scr, gw, ngw, lane);
        transpose_all<0>(a.f1_out, DFF, D_, D_, WfoutT, scr, gw, ngw, lane);
        transpose_all<2>(a.w_in, D_, PROJ_OUT, PP, WinT, scr, gw, ngw, lane);
        transpose_all<0>(a.w_att, 1024, D_, D_, WattT, scr, gw, ngw, lane);
        transpose_all<0>(a.w_ml, 1024, D_, D_, WmlT, scr, gw, ngw, lane);
        transpose_all<0>(a.w_out, D_, D_, D_, WoutT, scr, gw, ngw, lane);
        for (int it = gw; it < 72 * 32; it += ngw) {
            const int cgp = it % 72, kc = it / 72, col = cgp * 256 + 4 * lane;
            f32x4 s0 = {0.f, 0.f, 0.f, 0.f}, s1 = {0.f, 0.f, 0.f, 0.f};
#pragma unroll 8
            for (int kk = 0; kk < 64; ++kk) {
                const int k = kc * 64 + kk;
                const float c0 = a.c[k], c1 = a.c[D_ + k];
                const float e0 = c0 * sigm(c0), e1 = c1 * sigm(c1);
                const f32x4 w4 = *(const f32x4*)(a.w_ada + (size_t)k * NMOD + col);
                s0 += w4 * e0; s1 += w4 * e1;
            }
            if (kc == 0) { const f32x4 bb = *(const f32x4*)(a.b_ada + col); s0 += bb; s1 += bb; }
#pragma unroll
            for (int e = 0; e < 4; ++e) { atomicAdd(mod + col + e, s0[e]); atomicAdd(mod + NMOD + col + e, s1[e]); }
        }
        for (int i = blockIdx.x * 512 + tid; i < M_ * 8; i += G * 512) {
            const int row = i >> 3, j = i & 7;
            const float invf = (j == 0) ? 1.0f : (j == 1) ? 0.19392274f : (j == 2) ? 0.03760603f : (j == 3) ? 0.0072926646f : (j == 4) ? 0.0014142136f : (j == 5) ? 0.0002742482f : (j == 6) ? 5.3182957e-05f : 1.0313385e-05f;
            const float ang = (float)a.pos[row] * invf;
            double f = (double)ang * 0.15915494309189535; f -= rint(f);
            rope[(size_t)row * 16 + j] = __builtin_amdgcn_cosf((float)f);
            rope[(size_t)row * 16 + 8 + j] = __builtin_amdgcn_sinf((float)f);
        }
        __syncthreads();
    }
    SEAM(0);
    if (IN(1)) norm_phase<false>(a.x, a.norm1_g, mod, 0, 2048, U, nullptr, nullptr, lds, tid, wave, lane);
    SEAM(1);
    if (IN(2)) { pg8::Gemm g{U, WfinT, M_, 2 * DFF, D_, D_}; pg8::StaticOrder S; S.init(M_, 2 * DFF, G, (int)blockIdx.x); EpiSwiglu E{ACT}; pg8::gemm_phase(lds, g, S, E); }
    SEAM(2);
    if (IN(3)) { pg8::Gemm g{ACT, WfoutT, M_, D_, DFF, DFF}; pg8::StaticOrder S; S.init(M_, D_, G, (int)blockIdx.x); EpiResid E{a.x, H, mod + 4096, 0.5f}; pg8::gemm_phase(lds, g, S, E); }
    SEAM(3);
    if (IN(4)) norm_phase<true>(H, a.norm2_g, mod, 6144, 8192, U, gif, a.w_in, lds, tid, wave, lane);
    SEAM(4);
    if (IN(5)) { pg8::Gemm g{U, WinT, M_, PP, D_, D_}; pg8::StaticOrder S; S.init(M_, PP, G, (int)blockIdx.x); EpiProj E{P, rope}; pg8::gemm_phase(lds, g, S, E); }
    SEAM(5);
    if (IN(6)) {
        for (int it = blockIdx.x; it < 256; it += G) attn_item(it, P, a.sinks, lds, tid, wave, lane);
        for (int it = blockIdx.x; it < 1024; it += G) m1_item(it, P, QK, gif, a.conv_w, a.conv_b, a.b_ig, a.b_fg, Cbuf, scal, lds, tid, wave, lane);
    }
    SEAM(6);
    if (IN(7)) m2_scan(Cbuf, scal, blockIdx.x * 512 + tid, G * 512);
    SEAM(7);
    if (IN(8)) for (int it = blockIdx.x; it < 1024; it += G) m3_item(it, P, QK, gif, a.b_ig, a.b_fg, Cbuf, scal, a.mnorm_g, lds, tid, wave, lane);
    SEAM(8);
    if (IN(9)) {
        { pg8::Gemm g{P + PC_Q, WattT, M_, D_, 1024, PP}; pg8::StaticOrder S; S.init(M_, D_, G, (int)blockIdx.x); EpiMerge E{P, 1}; pg8::gemm_phase(lds, g, S, E); }
        { pg8::Gemm g{P + PC_MV, WmlT, M_, D_, 1024, PP}; pg8::StaticOrder S; S.init(M_, D_, G, (int)blockIdx.x); EpiMerge E{P, 0}; pg8::gemm_phase(lds, g, S, E); }
    }
    SEAM(9);
    if (IN(10)) { pg8::Gemm g{P + PC_G, WoutT, M_, D_, D_, PP}; pg8::StaticOrder S; S.init(M_, D_, G, (int)blockIdx.x); EpiResid E{H, H, mod + 10240, 1.0f}; pg8::gemm_phase(lds, g, S, E); }
    SEAM(10);
    if (IN(11)) {
        LAS float* scr = (LAS float*)(lds + wave * 16384);
        transpose_all<1>(a.f2_in, D_, 2 * DFF, 2 * DFF, WfinT, scr, gw, ngw, lane);
        transpose_all<0>(a.f2_out, DFF, D_, D_, WfoutT, scr, gw, ngw, lane);
        norm_phase<false>(H, a.norm3_g, mod, 12288, 14336, U, nullptr, nullptr, lds, tid, wave, lane);
    }
    SEAM(11);
    if (IN(12)) { pg8::Gemm g{U, WfinT, M_, 2 * DFF, D_, D_}; pg8::StaticOrder S; S.init(M_, 2 * DFF, G, (int)blockIdx.x); EpiSwiglu E{ACT}; pg8::gemm_phase(lds, g, S, E); }
    SEAM(12);
    if (IN(13)) { pg8::Gemm g{ACT, WfoutT, M_, D_, DFF, DFF}; pg8::StaticOrder S; S.init(M_, D_, G, (int)blockIdx.x); EpiResid E{H, H, mod + 16384, 0.5f}; pg8::gemm_phase(lds, g, S, E); }
    SEAM(13);
    if (IN(14)) {
        for (int row = gw; row < M_; row += ngw) {
            f32x4* xr = (f32x4*)(H + (size_t)row * D_) + lane;
            f32x4 v[8]; float ss = 0.f;
#pragma unroll
            for (int j = 0; j < 8; ++j) { v[j] = xr[64 * j]; ss += (v[j][0] * v[j][0] + v[j][1] * v[j][1]) + (v[j][2] * v[j][2] + v[j][3] * v[j][3]); }
            const float rstd = 1.0f / sqrtf(wave_sum(ss) * (1.0f / D_) + EPS);
#pragma unroll
            for (int j = 0; j < 8; ++j) { const f32x4 g4 = *(const f32x4*)(a.final_g + 256 * j + 4 * lane); xr[64 * j] = (v[j] * rstd) * g4; }
        }
    }
#undef IN
#undef SEAM
}

extern "C" void kernel_launch(void* const* d_in, const int* in_sizes, int n_in, void* d_out, int out_size, void* d_ws, size_t ws_size, hipStream_t stream) {
    static int grid = 0;
    if (grid == 0) {
        if (n_in != 23 || out_size != M_ * D_ || ws_size < WS_END) { fprintf(stderr, "kernel_launch: unexpected shapes (n_in %d, out %d, ws %zu < %zu)\n", n_in, out_size, ws_size, (size_t)WS_END); grid = -1; return; }
        int dev = 0, cus = 0, per_cu = 0;
        (void)hipGetDevice(&dev);
        (void)hipDeviceGetAttribute(&cus, hipDeviceAttributeMultiprocessorCount, dev);
        (void)hipFuncSetAttribute((const void*)fwd_kernel, hipFuncAttributeMaxDynamicSharedMemorySize, LDS_BYTES);
        (void)hipOccupancyMaxActiveBlocksPerMultiprocessor(&per_cu, (const void*)fwd_kernel, 512, LDS_BYTES);
        if (per_cu < 1) per_cu = 1;
        (void)hipGetLastError();
        grid = cus * per_cu;
    }
    if (grid < 0) return;
    (void)hipMemsetAsync((char*)d_ws + WS_MOD, 0, MOD_BYTES, stream);
    Args a{};
    a.x = (const float*)d_in[0]; a.c = (const float*)d_in[1]; a.pos = (const int*)d_in[2]; a.w_ada = (const float*)d_in[3]; a.b_ada = (const float*)d_in[4];
    a.norm1_g = (const float*)d_in[5]; a.f1_in = (const float*)d_in[6]; a.f1_out = (const float*)d_in[7]; a.norm2_g = (const float*)d_in[8]; a.w_in = (const float*)d_in[9];
    a.conv_w = (const float*)d_in[10]; a.conv_b = (const float*)d_in[11]; a.b_ig = (const float*)d_in[12]; a.b_fg = (const float*)d_in[13]; a.sinks = (const float*)d_in[14];
    a.mnorm_g = (const float*)d_in[15]; a.w_att = (const float*)d_in[16]; a.w_ml = (const float*)d_in[17]; a.w_out = (const float*)d_in[18]; a.norm3_g = (const float*)d_in[19];
    a.f2_in = (const float*)d_in[20]; a.f2_out = (const float*)d_in[21]; a.final_g = (const float*)d_in[22];
    a.out = (float*)d_out; a.ws = (unsigned char*)d_ws;
#if MK_MULTI
    for (int p = 0; p < N_PHASES; ++p) { a.ph_lo = p; a.ph_hi = p + 1; hipLaunchKernelGGL(fwd_kernel, dim3(grid), dim3(512), LDS_BYTES, stream, a); }
#else
    a.ph_lo = 0; a.ph_hi = N_PHASES;
    void* args[] = {&a};
    hipError_t e = hipLaunchCooperativeKernel((const void*)fwd_kernel, dim3(grid), dim3(512), args, LDS_BYTES, stream);
    if (e != hipSuccess) fprintf(stderr, "cooperative launch failed: %s (grid %d)\n", hipGetErrorString(e), grid);
#endif
}
```

```cpp
#include <hip/hip_runtime.h>
#include <hip/hip_cooperative_groups.h>
#include <cstdio>
#include <cstdint>
namespace cg = cooperative_groups;

#ifndef MK_MULTI
#define MK_MULTI 0
#endif

#define LAS __attribute__((address_space(3)))
typedef unsigned short bf16_t;
typedef short bf16x8 __attribute__((ext_vector_type(8)));
typedef float f32x4 __attribute__((ext_vector_type(4)));
typedef float f32x2 __attribute__((ext_vector_type(2)));
typedef unsigned u32x4 __attribute__((ext_vector_type(4)));
typedef unsigned u32x2 __attribute__((ext_vector_type(2)));

constexpr int M_ = 16384, D_ = 2048, T_ = 8192, DFF = 5632, NMOD = 18432, PROJ_OUT = 8456;
constexpr int PP = 8448;
constexpr int PC_Q = 0, PC_K = 1024, PC_V = 1152, PC_MQK = 1280, PC_MV = 2304, PC_MO = 3328, PC_G = 4352;
constexpr float EPS = 1e-6f;
constexpr size_t MiB = 1u << 20;
constexpr size_t WS_MOD = 0, MOD_BYTES = 2 * NMOD * 4;
constexpr size_t WS_ROPE = 1 * MiB, WS_GIF = 2 * MiB, WS_SCAL = 2 * MiB + 512 * 1024;
constexpr size_t WS_WIN = 4 * MiB, WS_WATT = 37 * MiB, WS_WML = 41 * MiB, WS_WOUT = 45 * MiB;
constexpr size_t WS_U = 53 * MiB;
constexpr size_t WS_R = 117 * MiB;
constexpr size_t WS_WFIN = WS_R, WS_WFOUT = WS_R + 44 * MiB, WS_ACT = WS_R + 66 * MiB;
constexpr size_t WS_P = WS_R, WS_CBUF = WS_R + 264 * MiB;
constexpr size_t WS_END = WS_CBUF + (size_t)1024 * 257 * 128 * 4;
constexpr int LDS_BYTES = 147456;

namespace pg8 {
constexpr int BM = 256, BK = 64, HALF = 128, HTB = HALF * BK * 2, STAGE_BYTES = 8 * HTB, NXCD = 8, WGM = 8;
__host__ __device__ __forceinline__ int lds_byte(int r, int c) { const int st = (r >> 4) * 2 + (c >> 5), rr = r & 15, cc = c & 31, ob = rr * 64 + cc * 2; return st * 1024 + (ob ^ (((ob >> 9) & 1) << 5)); }
__host__ __device__ __forceinline__ void stage_rc(int b, int& R, int& C) { const int st = b / 1024, sb = b % 1024, swz = sb ^ (((sb >> 9) & 1) << 5); R = (st >> 1) * 16 + swz / 64; C = (st & 1) * 32 + (swz % 64) / 2; }
__host__ __device__ __forceinline__ int perm32(int rho) { const int n = rho >> 4, i = rho & 15; return 8 * (i >> 2) + 4 * n + (i & 3); }
struct Unit { int pm, pn; };
struct Gemm { const bf16_t* A; const bf16_t* Bt; int M, N, K, lda; };
struct StaticOrder {
    int nM, nN, nwg, G, c;
    __host__ __device__ void init(int M, int N, int G_, int c_) { nM = M / BM; nN = N / BM; nwg = nM * nN; G = G_; c = c_; }
    __host__ __device__ bool next(int i, Unit& u) const {
        const long L = (long)i * G + c; if (L >= nwg) return false;
        int wgid = (int)L; { const int q = nwg / NXCD, r = nwg % NXCD, xcd = wgid % NXCD, off = wgid / NXCD; wgid = (xcd < r ? xcd * (q + 1) : r * (q + 1) + (xcd - r) * q) + off; }
        const int nig = WGM * nN, gid = wgid / nig, fm = gid * WGM, gsz = (nM - fm) < WGM ? (nM - fm) : WGM;
        u.pm = fm + ((wgid % nig) % gsz); u.pn = (wgid % nig) / gsz; return true;
    }
};
__device__ __forceinline__ unsigned cvt_pk_bf16(float lo, float hi) { unsigned r; asm volatile("v_cvt_pk_bf16_f32 %0, %1, %2" : "=v"(r) : "v"(lo), "v"(hi)); return r; }

template <class Epi>
__device__ __forceinline__ void gemm_phase(LAS unsigned char* lds, const Gemm g, const StaticOrder& S, const Epi& E) {
    const int tid = threadIdx.x, wid = __builtin_amdgcn_readfirstlane(tid >> 6), lane = tid & 63, wr = wid >> 2, wc = wid & 3, fr = lane & 15, fq = lane >> 4;
    const int K = g.K, nt = K / BK, lda = g.lda;
    unsigned voffA[2], voffB[2];
#pragma unroll
    for (int i = 0; i < 2; ++i) { int R, C; stage_rc(tid * 16 + i * 8192, R, C); const int Rb = (R & ~31) + perm32(R & 31);
        voffA[i] = (unsigned)(R * lda + C) * 2u; voffB[i] = (unsigned)(Rb * K + C) * 2u; }
    const size_t kstep = (size_t)(BK * 2);
    const size_t hstepA = (size_t)HALF * lda * 2, hstepB = (size_t)HALF * K * 2;
    const size_t tstepA = 2 * hstepA, tstepB = 2 * hstepB;
    const unsigned ldsw = (unsigned)wid * 1024u;
    const int aoff = lds_byte(wr * 64 + fr, fq * 8), boff = lds_byte(wc * 32 + fr, fq * 8);
#define PG8_SA(b, h) (((b) * 2 + (h)) * HTB)
#define PG8_SB(b, h) ((4 + (b) * 2 + (h)) * HTB)
#define PG8_STAGE(bufoff, gbase, voff) do { _Pragma("unroll") for (int _i = 0; _i < 2; ++_i) \
        __builtin_amdgcn_global_load_lds((const unsigned*)((const char*)(gbase) + (voff)[_i]), (LAS unsigned*)(lds + (bufoff) + ldsw + _i * 8192), 16, 0, 0); } while (0)
#define PG8_LDA(dst, b, h) do { _Pragma("unroll") for (int m = 0; m < 4; ++m) _Pragma("unroll") for (int k = 0; k < 2; ++k) dst[m][k] = *(const LAS bf16x8*)(lds + PG8_SA(b, h) + aoff + m * 2048 + k * 1024); } while (0)
#define PG8_LDB(dst, b, h) do { _Pragma("unroll") for (int n = 0; n < 2; ++n) _Pragma("unroll") for (int k = 0; k < 2; ++k) dst[n][k] = *(const LAS bf16x8*)(lds + PG8_SB(b, h) + boff + n * 2048 + k * 1024); } while (0)
#define PG8_MMA(ai, bj, At, Bt) do { __builtin_amdgcn_s_setprio(1); _Pragma("unroll") for (int m = 0; m < 4; ++m) _Pragma("unroll") for (int n = 0; n < 2; ++n) _Pragma("unroll") for (int k = 0; k < 2; ++k) \
        acc[ai][bj][m][n] = __builtin_amdgcn_mfma_f32_16x16x32_bf16(Bt[n][k], At[m][k], acc[ai][bj][m][n], 0, 0, 0); __builtin_amdgcn_s_setprio(0); } while (0)
#define PG8_WAIT_V(n) asm volatile("s_waitcnt vmcnt(" #n ")" ::: "memory")
#define PG8_WAIT_L(n) asm volatile("s_waitcnt lgkmcnt(" #n ")" ::: "memory")
#define PG8_BAR __builtin_amdgcn_s_barrier()
#define PG8_SCHED __builtin_amdgcn_sched_barrier(0)
    Unit cur, nxt; int ui = 0;
    if (!S.next(0, cur)) return;
    f32x4 acc[2][2][4][2];
#pragma unroll
    for (int a = 0; a < 2; ++a)
#pragma unroll
        for (int b = 0; b < 2; ++b)
#pragma unroll
            for (int m = 0; m < 4; ++m)
#pragma unroll
                for (int n = 0; n < 2; ++n) acc[a][b][m][n] = (f32x4){0.f, 0.f, 0.f, 0.f};
    bf16x8 At[4][2], B0[2][2], B1[2][2];
    const char* cA = (const char*)g.A + (size_t)cur.pm * tstepA; const char* cB = (const char*)g.Bt + (size_t)cur.pn * tstepB;
    PG8_STAGE(PG8_SB(0, 0), cB, voffB); PG8_STAGE(PG8_SB(0, 1), cB + hstepB, voffB); PG8_STAGE(PG8_SA(0, 0), cA, voffA); PG8_STAGE(PG8_SA(0, 1), cA + hstepA, voffA);
    if (wr == 1) PG8_BAR;
    PG8_WAIT_V(2); PG8_BAR;
    PG8_STAGE(PG8_SB(1, 0), cB + kstep, voffB); PG8_STAGE(PG8_SA(1, 0), cA + kstep, voffA); PG8_STAGE(PG8_SB(1, 1), cB + hstepB + kstep, voffB);
    PG8_WAIT_V(6); PG8_BAR;
    for (;;) {
        const bool has_next = S.next(ui + 1, nxt);
        const char* nA = has_next ? (const char*)g.A + (size_t)nxt.pm * tstepA : cA; const char* nB = has_next ? (const char*)g.Bt + (size_t)nxt.pn * tstepB : cB;
        for (int t = 0; t < nt; t += 2) {
            const bool last = (t == nt - 2);
            const char* a1 = cA + (size_t)(t + 1) * kstep;
            const char* a2 = last ? nA : cA + (size_t)(t + 2) * kstep; const char* b2 = last ? nB : cB + (size_t)(t + 2) * kstep;
            const char* a3 = a2 + kstep; const char* b3 = b2 + kstep;
            PG8_LDB(B0, 0, 0); PG8_LDB(B1, 0, 1); PG8_SCHED; PG8_LDA(At, 0, 0); PG8_STAGE(PG8_SA(1, 1), a1 + hstepA, voffA);
            PG8_WAIT_V(8); PG8_WAIT_L(0); PG8_BAR; PG8_MMA(0, 0, At, B0); PG8_MMA(0, 1, At, B1); PG8_BAR; PG8_SCHED;
            PG8_LDA(At, 0, 1); PG8_STAGE(PG8_SB(0, 0), b2, voffB); PG8_STAGE(PG8_SB(0, 1), b2 + hstepB, voffB); PG8_STAGE(PG8_SA(0, 0), a2, voffA);
            PG8_WAIT_V(8); PG8_WAIT_L(0); PG8_BAR; PG8_MMA(1, 0, At, B0); PG8_MMA(1, 1, At, B1); PG8_BAR; PG8_SCHED;
            PG8_LDB(B0, 1, 0); PG8_LDB(B1, 1, 1); PG8_SCHED; PG8_LDA(At, 1, 0); PG8_STAGE(PG8_SA(0, 1), a2 + hstepA, voffA);
            PG8_WAIT_V(8); PG8_WAIT_L(0); PG8_BAR; PG8_MMA(0, 0, At, B0); PG8_MMA(0, 1, At, B1); PG8_BAR; PG8_SCHED;
            PG8_LDA(At, 1, 1); PG8_STAGE(PG8_SB(1, 0), b3, voffB); PG8_STAGE(PG8_SB(1, 1), b3 + hstepB, voffB); PG8_STAGE(PG8_SA(1, 0), a3, voffA);
            PG8_WAIT_V(8); PG8_WAIT_L(0); PG8_BAR; PG8_MMA(1, 0, At, B0); PG8_MMA(1, 1, At, B1); PG8_BAR; PG8_SCHED;
        }
        if (wr == 0) PG8_BAR;
        E(acc, cur, wr, wc, fr, fq);
        if (!has_next) break;
#pragma unroll
        for (int a = 0; a < 2; ++a)
#pragma unroll
            for (int b = 0; b < 2; ++b)
#pragma unroll
                for (int m = 0; m < 4; ++m)
#pragma unroll
                    for (int n = 0; n < 2; ++n) acc[a][b][m][n] = (f32x4){0.f, 0.f, 0.f, 0.f};
        cur = nxt; cA = nA; cB = nB; ++ui;
        if (wr == 1) PG8_BAR;
    }
    PG8_WAIT_V(0);
    PG8_BAR;
#undef PG8_SA
#undef PG8_SB
#undef PG8_STAGE
#undef PG8_LDA
#undef PG8_LDB
#undef PG8_MMA
#undef PG8_WAIT_V
#undef PG8_WAIT_L
#undef PG8_BAR
#undef PG8_SCHED
}
}
using pg8::cvt_pk_bf16;
using pg8::Unit;

__device__ __forceinline__ float bf2f(unsigned short h) { return __uint_as_float((unsigned)h << 16); }
__device__ __forceinline__ float bflo(unsigned w) { return __uint_as_float(w << 16); }
__device__ __forceinline__ float bfhi(unsigned w) { return __uint_as_float(w & 0xffff0000u); }
__device__ __forceinline__ unsigned short f2bf(float f) { return (unsigned short)(cvt_pk_bf16(f, 0.f) & 0xffffu); }
__device__ __forceinline__ float sigm(float x) { return __builtin_amdgcn_rcpf(1.f + __expf(-x)); }
__device__ __forceinline__ float wave_sum(float v) {
#pragma unroll
    for (int o = 1; o < 64; o <<= 1) v += __shfl_xor(v, o);
    return v;
}
__device__ __forceinline__ float wave_max(float v) {
#pragma unroll
    for (int o = 1; o < 64; o <<= 1) v = fmaxf(v, __shfl_xor(v, o));
    return v;
}
__device__ __forceinline__ float log_sigmoid(float x) { return fminf(x, 0.f) - log1pf(expf(-fabsf(x))); }
__device__ __forceinline__ bf16x8 pack8(f32x4 a, f32x4 b) {
    u32x4 w; w.x = cvt_pk_bf16(a[0], a[1]); w.y = cvt_pk_bf16(a[2], a[3]); w.z = cvt_pk_bf16(b[0], b[1]); w.w = cvt_pk_bf16(b[2], b[3]);
    return __builtin_bit_cast(bf16x8, w);
}
__device__ __forceinline__ int kperm32(int kl) { return 8 * ((kl & 15) >> 2) + (kl & 3) + 4 * (kl >> 4); }

struct EpiSwiglu {
    bf16_t* O;
    __device__ __forceinline__ void operator()(const f32x4 (&acc)[2][2][4][2], const Unit& u, int wr, int wc, int fr, int fq) const {
        const int row0 = u.pm * 256 + wr * 64 + fr, col0 = u.pn * 128 + wc * 32 + 8 * fq;
#pragma unroll
        for (int ai = 0; ai < 2; ++ai)
#pragma unroll
            for (int m = 0; m < 4; ++m) {
                bf16_t* rowp = O + (size_t)(row0 + ai * 128 + m * 16) * DFF + col0;
                float v[8];
#pragma unroll
                for (int n = 0; n < 2; ++n)
#pragma unroll
                    for (int e = 0; e < 4; ++e) { const float a = acc[ai][0][m][n][e], b = acc[ai][1][m][n][e]; v[n * 4 + e] = a * sigm(a) * b; }
                u32x4 w; w.x = cvt_pk_bf16(v[0], v[1]); w.y = cvt_pk_bf16(v[2], v[3]); w.z = cvt_pk_bf16(v[4], v[5]); w.w = cvt_pk_bf16(v[6], v[7]);
                *(u32x4*)rowp = w;
            }
    }
};
struct EpiResid {
    const float* base; float* out; const float* gate; float scale;
    __device__ __forceinline__ void operator()(const f32x4 (&acc)[2][2][4][2], const Unit& u, int wr, int wc, int fr, int fq) const {
        const int row0 = u.pm * 256 + wr * 64 + fr, col0 = u.pn * 256 + wc * 32 + 8 * fq;
        const float* gp = gate + (size_t)(u.pm >> 5) * NMOD + col0;
        f32x4 gv[2][2];
#pragma unroll
        for (int bj = 0; bj < 2; ++bj)
#pragma unroll
            for (int n = 0; n < 2; ++n) gv[bj][n] = *(const f32x4*)(gp + bj * 128 + 4 * n) * scale;
#pragma unroll
        for (int ai = 0; ai < 2; ++ai)
#pragma unroll
            for (int m = 0; m < 4; ++m) {
                const size_t off = (size_t)(row0 + ai * 128 + m * 16) * D_ + col0;
#pragma unroll
                for (int bj = 0; bj < 2; ++bj)
#pragma unroll
                    for (int n = 0; n < 2; ++n) { const f32x4 bs = *(const f32x4*)(base + off + bj * 128 + 4 * n); *(f32x4*)(out + off + bj * 128 + 4 * n) = bs + gv[bj][n] * acc[ai][bj][m][n]; }
            }
    }
};
struct EpiProj {
    bf16_t* P; const float* rope;
    __device__ __forceinline__ void operator()(const f32x4 (&acc)[2][2][4][2], const Unit& u, int wr, int wc, int fr, int fq) const {
        const int row0 = u.pm * 256 + wr * 64 + fr, col0 = u.pn * 256 + wc * 32 + 8 * fq;
        const bool sig = u.pn >= 13;
        const bool ropelane = ((wc & 1) == 0) && (fq < 2) && (u.pn <= 4);
#pragma unroll
        for (int ai = 0; ai < 2; ++ai)
#pragma unroll
            for (int m = 0; m < 4; ++m) {
                const int row = row0 + ai * 128 + m * 16;
                f32x4 cs = {1.f, 1.f, 1.f, 1.f}, sn = {0.f, 0.f, 0.f, 0.f};
                if (ropelane) { cs = *(const f32x4*)(rope + (size_t)row * 16 + fq * 4); sn = *(const f32x4*)(rope + (size_t)row * 16 + 8 + fq * 4); }
#pragma unroll
                for (int bj = 0; bj < 2; ++bj) {
                    f32x4 v0 = acc[ai][bj][m][0], v1 = acc[ai][bj][m][1];
                    if (ropelane && (u.pn < 4 || bj == 0)) { const f32x4 x1 = v0, x2 = v1; v0 = x1 * cs - x2 * sn; v1 = x2 * cs + x1 * sn; }
                    if (sig) {
#pragma unroll
                        for (int e = 0; e < 4; ++e) { v0[e] = sigm(v0[e]); v1[e] = sigm(v1[e]); }
                    }
                    u32x4 w; w.x = cvt_pk_bf16(v0[0], v0[1]); w.y = cvt_pk_bf16(v0[2], v0[3]); w.z = cvt_pk_bf16(v1[0], v1[1]); w.w = cvt_pk_bf16(v1[2], v1[3]);
                    *(u32x4*)(P + (size_t)row * PP + col0 + bj * 128) = w;
                }
            }
    }
};
struct EpiMerge {
    bf16_t* P; int first;
    __device__ __forceinline__ void operator()(const f32x4 (&acc)[2][2][4][2], const Unit& u, int wr, int wc, int fr, int fq) const {
        const int row0 = u.pm * 256 + wr * 64 + fr, col0 = u.pn * 256 + wc * 32 + 8 * fq;
#pragma unroll
        for (int ai = 0; ai < 2; ++ai)
#pragma unroll
            for (int m = 0; m < 4; ++m)
#pragma unroll
                for (int bj = 0; bj < 2; ++bj) {
                    bf16_t* zp = P + (size_t)(row0 + ai * 128 + m * 16) * PP + PC_G + col0 + bj * 128;
                    const u32x4 z8 = *(const u32x4*)zp;
                    u32x4 g8 = z8; if (!first) g8 = *(const u32x4*)(zp + 2048);
                    const f32x4 a0 = acc[ai][bj][m][0], a1 = acc[ai][bj][m][1];
                    float o[8];
                    o[0] = bflo(g8.x) * a0[0]; o[1] = bfhi(g8.x) * a0[1]; o[2] = bflo(g8.y) * a0[2]; o[3] = bfhi(g8.y) * a0[3];
                    o[4] = bflo(g8.z) * a1[0]; o[5] = bfhi(g8.z) * a1[1]; o[6] = bflo(g8.w) * a1[2]; o[7] = bfhi(g8.w) * a1[3];
                    if (!first) { o[0] += bflo(z8.x); o[1] += bfhi(z8.x); o[2] += bflo(z8.y); o[3] += bfhi(z8.y); o[4] += bflo(z8.z); o[5] += bfhi(z8.z); o[6] += bflo(z8.w); o[7] += bfhi(z8.w); }
                    u32x4 w; w.x = cvt_pk_bf16(o[0], o[1]); w.y = cvt_pk_bf16(o[2], o[3]); w.z = cvt_pk_bf16(o[4], o[5]); w.w = cvt_pk_bf16(o[6], o[7]);
                    *(u32x4*)zp = w;
                }
    }
};

struct Args {
    const float* x; const float* c; const int* pos; const float* w_ada; const float* b_ada; const float* norm1_g;
    const float* f1_in; const float* f1_out; const float* norm2_g; const float* w_in; const float* conv_w; const float* conv_b;
    const float* b_ig; const float* b_fg; const float* sinks; const float* mnorm_g; const float* w_att; const float* w_ml;
    const float* w_out; const float* norm3_g; const float* f2_in; const float* f2_out; const float* final_g;
    float* out; unsigned char* ws; int ph_lo, ph_hi;
};

template <int KIND> __device__ __forceinline__ int srccol(int n) {
    if (KIND == 0) return n;
    if (KIND == 1) { const int pn = n >> 8, bj = (n >> 7) & 1, i = n & 127; return bj * DFF + pn * 128 + i; }
    if (n < PC_V) { const int d = n & 63; if (d < 16) { const int g = d >> 2; const int dd = (g == 1) ? d + 4 : (g == 2) ? d - 4 : d; return (n & ~63) + dd; } return n; }
    if (n < PC_MO) return n;
    return n + 8;
}
template <int KIND> __device__ __forceinline__ void transpose_item(const float* W, int K, int N, bf16_t* WT, LAS float* scr, int item, int lane, int nblk) {
    const int kb = item / nblk, nb = item % nblk, k0 = 64 * kb, n0 = 32 * nb;
    const int sc = srccol<KIND>(n0 + (lane & 31));
#pragma unroll 8
    for (int i = 0; i < 32; ++i) { const int kk = 2 * i + (lane >> 5); scr[kk * 33 + (lane & 31)] = W[(size_t)(k0 + kk) * N + sc]; }
    asm volatile("s_waitcnt lgkmcnt(0)" ::: "memory");
    const int c = lane & 7;
#pragma unroll
    for (int j = 0; j < 4; ++j) { const int n = (lane >> 3) + 8 * j; const LAS float* s = scr + (8 * c) * 33 + n;
        u32x4 o; o.x = cvt_pk_bf16(s[0 * 33], s[1 * 33]); o.y = cvt_pk_bf16(s[2 * 33], s[3 * 33]); o.z = cvt_pk_bf16(s[4 * 33], s[5 * 33]); o.w = cvt_pk_bf16(s[6 * 33], s[7 * 33]);
        *(u32x4*)(WT + (size_t)(n0 + n) * K + k0 + 8 * c) = o; }
    asm volatile("s_waitcnt lgkmcnt(0)" ::: "memory");
}
template <int KIND> __device__ __forceinline__ void transpose_all(const float* W, int K, int N, int Nout, bf16_t* WT, LAS float* scr, int gw, int ngw, int lane) {
    const int nblk = Nout / 32, items = (K / 64) * nblk;
    for (int it = gw; it < items; it += ngw) transpose_item<KIND>(W, K, N, WT, scr, it, lane, nblk);
}

template <bool GATES> __device__ __forceinline__ void norm_phase(const float* hin, const float* g, const float* mod, int sh_off, int sc_off, bf16_t* uout,
                                                                 float* gif, const float* w_in, LAS unsigned char* lds, int tid, int wave, int lane) {
    LAS float* wgT = (LAS float*)lds;
    if (GATES) {
        for (int idx = tid; idx < 2048 * 8; idx += 512) { const int k = idx >> 3, j = idx & 7; wgT[j * 2048 + k] = w_in[(size_t)k * PROJ_OUT + 3328 + j]; }
        __syncthreads();
    }
    const int gw = blockIdx.x * 8 + wave, ngw = gridDim.x * 8;
    for (int row = gw; row < M_; row += ngw) {
        const int b = row >> 13;
        const f32x4* xr = (const f32x4*)(hin + (size_t)row * D_) + lane;
        f32x4 v[8]; float ss = 0.f;
#pragma unroll
        for (int j = 0; j < 8; ++j) { v[j] = xr[64 * j]; ss += (v[j][0] * v[j][0] + v[j][1] * v[j][1]) + (v[j][2] * v[j][2] + v[j][3] * v[j][3]); }
        const float rstd = 1.0f / sqrtf(wave_sum(ss) * (1.0f / D_) + EPS);
        float ga[8];
#pragma unroll
        for (int i = 0; i < 8; ++i) ga[i] = 0.f;
#pragma unroll
        for (int j = 0; j < 8; ++j) {
            const int col = 256 * j + 4 * lane;
            const f32x4 g4 = *(const f32x4*)(g + col), sc4 = *(const f32x4*)(mod + (size_t)b * NMOD + sc_off + col), sh4 = *(const f32x4*)(mod + (size_t)b * NMOD + sh_off + col);
            const f32x4 y = (v[j] * rstd) * g4 * (sc4 + 1.0f) + sh4;
            u32x2 w; w.x = cvt_pk_bf16(y[0], y[1]); w.y = cvt_pk_bf16(y[2], y[3]);
            *(u32x2*)(uout + (size_t)row * D_ + col) = w;
            if (GATES) {
#pragma unroll
                for (int i = 0; i < 8; ++i) { const f32x4 w4 = *(const LAS f32x4*)(wgT + i * 2048 + col); ga[i] += (y[0] * w4[0] + y[1] * w4[1]) + (y[2] * w4[2] + y[3] * w4[3]); }
            }
        }
        if (GATES) {
#pragma unroll
            for (int i = 0; i < 8; ++i) ga[i] = wave_sum(ga[i]);
            if (lane == 0) { *(f32x4*)(gif + (size_t)row * 8) = (f32x4){ga[0], ga[1], ga[2], ga[3]}; *(f32x4*)(gif + (size_t)row * 8 + 4) = (f32x4){ga[4], ga[5], ga[6], ga[7]}; }
        }
    }
    if (GATES) __syncthreads();
}

__device__ __forceinline__ void attn_item(int item, bf16_t* P, const float* sinks, LAS unsigned char* lds, int tid, int wave, int lane) {
    const int kvh = item & 1, nb = (item >> 1) & 63, b = item >> 7;
    const int r0 = b * T_ + nb * 128;
    LAS bf16_t* Ksh = (LAS bf16_t*)lds;
    LAS bf16_t* VT = (LAS bf16_t*)(lds + 36864);
#pragma unroll
    for (int i = 0; i < 4; ++i) {
        const int chunk = tid + 512 * i, key = chunk >> 3, c8 = chunk & 7;
        const bool valid = (nb > 0) || (key >= 128);
        u32x4 kv = {0u, 0u, 0u, 0u}, vv = {0u, 0u, 0u, 0u};
        if (valid) { const bf16_t* rp = P + (size_t)(r0 - 128 + key) * PP; kv = *(const u32x4*)(rp + PC_K + kvh * 64 + c8 * 8); vv = *(const u32x4*)(rp + PC_V + kvh * 64 + c8 * 8); }
        *(LAS u32x4*)(Ksh + key * 72 + c8 * 8) = kv;
        const int pos = (key & ~31) + kperm32(key & 31);
        LAS bf16_t* vp = VT + (c8 * 8) * 264 + pos;
        vp[0 * 264] = (bf16_t)(vv.x & 0xffff); vp[1 * 264] = (bf16_t)(vv.x >> 16); vp[2 * 264] = (bf16_t)(vv.y & 0xffff); vp[3 * 264] = (bf16_t)(vv.y >> 16);
        vp[4 * 264] = (bf16_t)(vv.z & 0xffff); vp[5 * 264] = (bf16_t)(vv.z >> 16); vp[6 * 264] = (bf16_t)(vv.w & 0xffff); vp[7 * 264] = (bf16_t)(vv.w >> 16);
    }
    __syncthreads();
    const int h = kvh * 8 + wave, fr = lane & 15, fq = lane >> 4;
    const float sink = sinks[h];
    for (int qg = 0; qg < 8; ++qg) {
        const int qrow = r0 + qg * 16 + fr;
        bf16_t* qp = P + (size_t)qrow * PP + h * 64;
        const bf16x8 bq0 = *(const bf16x8*)(qp + 8 * fq), bq1 = *(const bf16x8*)(qp + 32 + 8 * fq);
        const int t0e = qg & ~1;
        f32x4 s[10];
#pragma unroll
        for (int tt = 0; tt < 10; ++tt) {
            const int t = min(t0e + tt, 15);
            const LAS bf16_t* kp = Ksh + (t * 16 + fr) * 72 + 8 * fq;
            const bf16x8 a0 = *(const LAS bf16x8*)kp, a1 = *(const LAS bf16x8*)(kp + 32);
            f32x4 z = {0.f, 0.f, 0.f, 0.f};
            z = __builtin_amdgcn_mfma_f32_16x16x32_bf16(a0, bq0, z, 0, 0, 0);
            s[tt] = __builtin_amdgcn_mfma_f32_16x16x32_bf16(a1, bq1, z, 0, 0, 0);
        }
        const int qi = 128 + qg * 16 + fr;
        float mx = -1e30f;
#pragma unroll
        for (int tt = 0; tt < 10; ++tt)
#pragma unroll
            for (int r = 0; r < 4; ++r) {
                const int kj = (t0e + tt) * 16 + 4 * fq + r;
                const bool ok = (kj <= qi) && (kj > qi - 128) && ((nb > 0) || (kj >= 128));
                const float sv = ok ? s[tt][r] * 0.125f : -1e30f;
                s[tt][r] = sv; mx = fmaxf(mx, sv);
            }
        mx = fmaxf(mx, __shfl_xor(mx, 16)); mx = fmaxf(mx, __shfl_xor(mx, 32)); mx = fmaxf(mx, sink);
        float sum = 0.f;
#pragma unroll
        for (int tt = 0; tt < 10; ++tt)
#pragma unroll
            for (int r = 0; r < 4; ++r) { const float p = __expf(s[tt][r] - mx); s[tt][r] = p; sum += p; }
        sum += __shfl_xor(sum, 16); sum += __shfl_xor(sum, 32);
        const float inv = 1.0f / (sum + __expf(sink - mx));
        bf16x8 bp[5];
#pragma unroll
        for (int g = 0; g < 5; ++g) bp[g] = pack8(s[2 * g], s[2 * g + 1]);
#pragma unroll
        for (int dt = 0; dt < 4; ++dt) {
            f32x4 o = {0.f, 0.f, 0.f, 0.f};
#pragma unroll
            for (int g = 0; g < 5; ++g) {
                const int grp = min((t0e >> 1) + g, 7);
                const bf16x8 a = *(const LAS bf16x8*)(VT + (dt * 16 + fr) * 264 + grp * 32 + 8 * fq);
                o = __builtin_amdgcn_mfma_f32_16x16x32_bf16(a, bp[g], o, 0, 0, 0);
            }
            u32x2 w; w.x = cvt_pk_bf16(o[0] * inv, o[1] * inv); w.y = cvt_pk_bf16(o[2] * inv, o[3] * inv);
            *(u32x2*)(qp + dt * 16 + 4 * fq) = w;
        }
    }
    __syncthreads();
}

__device__ __forceinline__ void m1_item(int item, const bf16_t* P, bf16_t* QK, const float* gif, const float* conv_w, const float* conv_b, const float* b_ig, const float* b_fg,
                                        float* Cbuf, float* scal, LAS unsigned char* lds, int tid, int wave, int lane) {
    const int c = item & 127, h = (item >> 7) & 3, b = item >> 9;
    const int r0 = b * T_ + c * 64;
    LAS bf16_t* VT = (LAS bf16_t*)lds;
    LAS bf16_t* KT = (LAS bf16_t*)(lds + 39168);
    LAS float* wl = (LAS float*)(lds + 57600);
    if (wave == 0) {
        const int row = r0 + lane;
        const float fpre = gif[(size_t)row * 8 + 4 + h] + b_fg[h], ipre = gif[(size_t)row * 8 + h] + b_ig[h];
        float bc = log_sigmoid(fpre);
#pragma unroll
        for (int o = 1; o < 64; o <<= 1) { const float t = __shfl_up(bc, o); if (lane >= o) bc += t; }
        const float blast = __shfl(bc, 63);
        const float gg = blast - bc + ipre;
        const float gmax = wave_max(gg);
        wl[lane] = expf(gg - gmax);
        if (lane == 0) { scal[item * 4 + 0] = gmax; scal[item * 4 + 1] = blast; }
    }
    for (int idx = tid; idx < 16 * 72; idx += 512) VT[256 * 72 + idx] = (idx < 64) ? (bf16_t)0x3F80 : (bf16_t)0;
    __syncthreads();
#pragma unroll
    for (int i = 0; i < 4; ++i) {
        const int task = tid + 512 * i, tl = task & 63, ch8 = task >> 6, qk = ch8 >> 4, j0 = (ch8 & 15) * 8;
        const int chan = qk * 512 + h * 128 + j0;
        float a[8];
        { const f32x4 b0 = *(const f32x4*)(conv_b + chan), b1 = *(const f32x4*)(conv_b + chan + 4); a[0] = b0[0]; a[1] = b0[1]; a[2] = b0[2]; a[3] = b0[3]; a[4] = b1[0]; a[5] = b1[1]; a[6] = b1[2]; a[7] = b1[3]; }
#pragma unroll
        for (int kk = 0; kk < 4; ++kk) {
            const int ts = c * 64 + tl - 3 + kk;
            if (ts >= 0) {
                const u32x4 x8 = *(const u32x4*)(P + (size_t)(b * T_ + ts) * PP + PC_MQK + chan);
                const f32x4 w0 = *(const f32x4*)(conv_w + kk * 1024 + chan), w1 = *(const f32x4*)(conv_w + kk * 1024 + chan + 4);
                a[0] += w0[0] * bflo(x8.x); a[1] += w0[1] * bfhi(x8.x); a[2] += w0[2] * bflo(x8.y); a[3] += w0[3] * bfhi(x8.y);
                a[4] += w1[0] * bflo(x8.z); a[5] += w1[1] * bfhi(x8.z); a[6] += w1[2] * bflo(x8.w); a[7] += w1[3] * bfhi(x8.w);
            }
        }
        const float ksc = qk ? 0.08838834764831845f : 1.0f;
#pragma unroll
        for (int e = 0; e < 8; ++e) a[e] = a[e] * sigm(a[e]) * ksc;
        u32x4 w; w.x = cvt_pk_bf16(a[0], a[1]); w.y = cvt_pk_bf16(a[2], a[3]); w.z = cvt_pk_bf16(a[4], a[5]); w.w = cvt_pk_bf16(a[6], a[7]);
        *(u32x4*)(QK + (size_t)(r0 + tl) * 1024 + chan) = w;
        if (qk) {
            const float wt = wl[tl];
#pragma unroll
            for (int e = 0; e < 8; ++e) KT[(j0 + e) * 72 + tl] = f2bf(a[e] * wt);
        }
    }
#pragma unroll
    for (int i = 0; i < 4; ++i) {
        const int task = tid + 512 * i, tl = task & 63, ce = task >> 6;
        const u32x4 vv = *(const u32x4*)(P + (size_t)(r0 + tl) * PP + PC_MV + h * 256 + ce * 8);
        LAS bf16_t* vp = VT + (ce * 8) * 72 + tl;
        vp[0 * 72] = (bf16_t)(vv.x & 0xffff); vp[1 * 72] = (bf16_t)(vv.x >> 16); vp[2 * 72] = (bf16_t)(vv.y & 0xffff); vp[3 * 72] = (bf16_t)(vv.y >> 16);
        vp[4 * 72] = (bf16_t)(vv.z & 0xffff); vp[5 * 72] = (bf16_t)(vv.z >> 16); vp[6 * 72] = (bf16_t)(vv.w & 0xffff); vp[7 * 72] = (bf16_t)(vv.w >> 16);
    }
    __syncthreads();
    const int fr = lane & 15, fq = lane >> 4;
    float* Cit = Cbuf + (size_t)item * 257 * 128;
#pragma unroll
    for (int et2 = 0; et2 < 2; ++et2) {
        const int et = 2 * wave + et2;
        const bf16x8 a0 = *(const LAS bf16x8*)(VT + (et * 16 + fr) * 72 + 8 * fq), a1 = *(const LAS bf16x8*)(VT + (et * 16 + fr) * 72 + 32 + 8 * fq);
#pragma unroll
        for (int dt = 0; dt < 8; ++dt) {
            const bf16x8 b0 = *(const LAS bf16x8*)(KT + (dt * 16 + fr) * 72 + 8 * fq), b1 = *(const LAS bf16x8*)(KT + (dt * 16 + fr) * 72 + 32 + 8 * fq);
            f32x4 z = {0.f, 0.f, 0.f, 0.f};
            z = __builtin_amdgcn_mfma_f32_16x16x32_bf16(a0, b0, z, 0, 0, 0);
            z = __builtin_amdgcn_mfma_f32_16x16x32_bf16(a1, b1, z, 0, 0, 0);
#pragma unroll
            for (int r = 0; r < 4; ++r) Cit[(size_t)(et * 16 + 4 * fq + r) * 128 + dt * 16 + fr] = z[r];
        }
    }
    if (wave == 0) {
        const bf16x8 a0 = *(const LAS bf16x8*)(VT + (256 + fr) * 72 + 8 * fq), a1 = *(const LAS bf16x8*)(VT + (256 + fr) * 72 + 32 + 8 * fq);
#pragma unroll
        for (int dt = 0; dt < 8; ++dt) {
            const bf16x8 b0 = *(const LAS bf16x8*)(KT + (dt * 16 + fr) * 72 + 8 * fq), b1 = *(const LAS bf16x8*)(KT + (dt * 16 + fr) * 72 + 32 + 8 * fq);
            f32x4 z = {0.f, 0.f, 0.f, 0.f};
            z = __builtin_amdgcn_mfma_f32_16x16x32_bf16(a0, b0, z, 0, 0, 0);
            z = __builtin_amdgcn_mfma_f32_16x16x32_bf16(a1, b1, z, 0, 0, 0);
            if (fq == 0) Cit[(size_t)256 * 128 + dt * 16 + fr] = z[0];
        }
    }
    __syncthreads();
}

__device__ __forceinline__ void m2_scan(float* Cbuf, float* scal, int gtid, int gthreads) {
    constexpr int PER_BH = 257 * 32, TOTAL = 8 * PER_BH;
    constexpr size_t CSTRIDE = (size_t)257 * 128;
    for (int w = gtid; w < TOTAL; w += gthreads) {
        const int bh = w / PER_BH, rem = w % PER_BH, e = rem >> 5, d4 = (rem & 31) * 4;
        float* ptr = Cbuf + ((size_t)bh * 128 * 257 + e) * 128 + d4;
        const bool lead = (rem == 0);
        f32x4 C = {0.f, 0.f, 0.f, 0.f}; float m = -1e30f;
        for (int c0 = 0; c0 < 128; c0 += 8) {
            f32x4 cl[8]; float gm[8], bl[8];
#pragma unroll
            for (int u = 0; u < 8; ++u) { cl[u] = *(const f32x4*)(ptr + (size_t)(c0 + u) * CSTRIDE); gm[u] = scal[(bh * 128 + c0 + u) * 4]; bl[u] = scal[(bh * 128 + c0 + u) * 4 + 1]; }
#pragma unroll
            for (int u = 0; u < 8; ++u) {
                *(f32x4*)(ptr + (size_t)(c0 + u) * CSTRIDE) = C;
                if (lead) scal[(bh * 128 + c0 + u) * 4 + 2] = m;
                const float mn = fmaxf(bl[u] + m, gm[u]);
                const float a = expf(bl[u] + m - mn), s = expf(gm[u] - mn);
                C = C * a + cl[u] * s; m = mn;
            }
        }
    }
}

__device__ __forceinline__ void m3_item(int item, bf16_t* P, const bf16_t* QK, const float* gif, const float* b_ig, const float* b_fg, const float* Cbuf, const float* scal,
                                        const float* norm_g, LAS unsigned char* lds, int tid, int wave, int lane) {
    const int c = item & 127, h = (item >> 7) & 3, b = item >> 9;
    const int r0 = b * T_ + c * 64;
    LAS bf16_t* VT = (LAS bf16_t*)lds;
    LAS float* tb = (LAS float*)(lds + 36864);
    LAS float* red = tb + 256;
    if (wave == 0) {
        const int row = r0 + lane;
        const float fpre = gif[(size_t)row * 8 + 4 + h] + b_fg[h], ipre = gif[(size_t)row * 8 + h] + b_ig[h];
        float bc = log_sigmoid(fpre);
#pragma unroll
        for (int o = 1; o < 64; o <<= 1) { const float t = __shfl_up(bc, o); if (lane >= o) bc += t; }
        const float gs = ipre - bc;
        float mxs = gs;
#pragma unroll
        for (int o = 1; o < 64; o <<= 1) { const float t = __shfl_up(mxs, o); if (lane >= o) mxs = fmaxf(mxs, t); }
        const float m_in = scal[item * 4 + 2];
        const float alog = bc + m_in;
        const float mt = fmaxf(alog, bc + mxs);
        tb[lane] = bc; tb[64 + lane] = gs; tb[128 + lane] = mt; tb[192 + lane] = expf(alog - mt);
    }
#pragma unroll
    for (int i = 0; i < 4; ++i) {
        const int task = tid + 512 * i, tl = task & 63, ce = task >> 6;
        const u32x4 vv = *(const u32x4*)(P + (size_t)(r0 + tl) * PP + PC_MV + h * 256 + ce * 8);
        const int pos = (tl & 32) + kperm32(tl & 31);
        LAS bf16_t* vp = VT + (ce * 8) * 72 + pos;
        vp[0 * 72] = (bf16_t)(vv.x & 0xffff); vp[1 * 72] = (bf16_t)(vv.x >> 16); vp[2 * 72] = (bf16_t)(vv.y & 0xffff); vp[3 * 72] = (bf16_t)(vv.y >> 16);
        vp[4 * 72] = (bf16_t)(vv.z & 0xffff); vp[5 * 72] = (bf16_t)(vv.z >> 16); vp[6 * 72] = (bf16_t)(vv.w & 0xffff); vp[7 * 72] = (bf16_t)(vv.w >> 16);
    }
    __syncthreads();
    const int fr = lane & 15, fq = lane >> 4, tt = wave & 3, eh = wave >> 2;
    const int t = tt * 16 + fr;
    const bf16_t* qp = QK + (size_t)(r0 + t) * 1024 + h * 128 + 8 * fq;
    bf16x8 bq[4];
#pragma unroll
    for (int ks = 0; ks < 4; ++ks) bq[ks] = *(const bf16x8*)(qp + ks * 32);
    f32x4 sacc[4];
#pragma unroll
    for (int st = 0; st < 4; ++st) {
        const bf16_t* kp = QK + (size_t)(r0 + st * 16 + fr) * 1024 + 512 + h * 128 + 8 * fq;
        f32x4 z = {0.f, 0.f, 0.f, 0.f};
#pragma unroll
        for (int ks = 0; ks < 4; ++ks) z = __builtin_amdgcn_mfma_f32_16x16x32_bf16(*(const bf16x8*)(kp + ks * 32), bq[ks], z, 0, 0, 0);
        sacc[st] = z;
    }
    const float bc_t = tb[t], mt_t = tb[128 + t], inter_t = tb[192 + t];
    float dsum = 0.f;
#pragma unroll
    for (int st = 0; st < 4; ++st)
#pragma unroll
        for (int r = 0; r < 4; ++r) {
            const int s = st * 16 + 4 * fq + r;
            const float wgt = (s <= t) ? __expf(bc_t + tb[64 + s] - mt_t) : 0.f;
            const float qk = sacc[st][r] * wgt; sacc[st][r] = qk; dsum += qk;
        }
    dsum += __shfl_xor(dsum, 16); dsum += __shfl_xor(dsum, 32);
    bf16x8 bp[2];
    bp[0] = pack8(sacc[0], sacc[1]); bp[1] = pack8(sacc[2], sacc[3]);
    const float* Cin = Cbuf + (size_t)item * 257 * 128;
    f32x4 acc[8];
#pragma unroll
    for (int et = 0; et < 8; ++et) {
        const float* cp = Cin + (size_t)((eh * 8 + et) * 16 + fr) * 128 + 8 * fq;
        f32x4 z = {0.f, 0.f, 0.f, 0.f};
#pragma unroll
        for (int ks = 0; ks < 4; ++ks) { const f32x4 f0 = *(const f32x4*)(cp + ks * 32), f1 = *(const f32x4*)(cp + ks * 32 + 4); z = __builtin_amdgcn_mfma_f32_16x16x32_bf16(pack8(f0, f1), bq[ks], z, 0, 0, 0); }
        acc[et] = z;
    }
    float qn;
    {
        const float* np = Cin + (size_t)256 * 128 + 8 * fq;
        f32x4 z = {0.f, 0.f, 0.f, 0.f};
#pragma unroll
        for (int ks = 0; ks < 4; ++ks) { const f32x4 f0 = *(const f32x4*)(np + ks * 32), f1 = *(const f32x4*)(np + ks * 32 + 4); z = __builtin_amdgcn_mfma_f32_16x16x32_bf16(pack8(f0, f1), bq[ks], z, 0, 0, 0); }
        qn = z[0];
    }
#pragma unroll
    for (int et = 0; et < 8; ++et) {
        f32x4 z = acc[et] * inter_t;
#pragma unroll
        for (int g = 0; g < 2; ++g) z = __builtin_amdgcn_mfma_f32_16x16x32_bf16(*(const LAS bf16x8*)(VT + ((eh * 8 + et) * 16 + fr) * 72 + g * 32 + 8 * fq), bp[g], z, 0, 0, 0);
        acc[et] = z;
    }
    const float den = inter_t * qn + dsum;
    const float inv = 1.0f / fmaxf(fabsf(den), expf(-mt_t));
    float ss = 0.f;
#pragma unroll
    for (int et = 0; et < 8; ++et) { acc[et] = acc[et] * inv; ss += (acc[et][0] * acc[et][0] + acc[et][1] * acc[et][1]) + (acc[et][2] * acc[et][2] + acc[et][3] * acc[et][3]); }
    ss += __shfl_xor(ss, 16); ss += __shfl_xor(ss, 32);
    if (fq == 0) red[eh * 64 + t] = ss;
    __syncthreads();
    const float rstd = 1.0f / sqrtf((red[t] + red[64 + t]) * (1.0f / 256.0f) + EPS);
    bf16_t* prow = P + (size_t)(r0 + t) * PP;
#pragma unroll
    for (int et = 0; et < 8; ++et) {
        const int e0 = h * 256 + (eh * 8 + et) * 16 + 4 * fq;
        const f32x4 gn = *(const f32x4*)(norm_g + e0);
        const u32x2 mo = *(const u32x2*)(prow + PC_MO + e0);
        const f32x4 o = acc[et] * rstd * gn;
        u32x2 w; w.x = cvt_pk_bf16(o[0] * bflo(mo.x), o[1] * bfhi(mo.x)); w.y = cvt_pk_bf16(o[2] * bflo(mo.y), o[3] * bfhi(mo.y));
        *(u32x2*)(prow + PC_MV + e0) = w;
    }
    __syncthreads();
}

constexpr int N_PHASES = 15;
__global__ void __launch_bounds__(512, 2) fwd_kernel(Args a) {
    extern __shared__ __attribute__((aligned(16))) unsigned char lds_raw[];
    LAS unsigned char* lds = (LAS unsigned char*)lds_raw;
    const int tid = threadIdx.x, lane = tid & 63, wave = __builtin_amdgcn_readfirstlane(tid >> 6);
    const int G = gridDim.x;
    unsigned char* ws = a.ws;
    float* mod = (float*)(ws + WS_MOD); float* rope = (float*)(ws + WS_ROPE); float* gif = (float*)(ws + WS_GIF); float* scal = (float*)(ws + WS_SCAL);
    bf16_t* WinT = (bf16_t*)(ws + WS_WIN); bf16_t* WattT = (bf16_t*)(ws + WS_WATT); bf16_t* WmlT = (bf16_t*)(ws + WS_WML); bf16_t* WoutT = (bf16_t*)(ws + WS_WOUT);
    bf16_t* U = (bf16_t*)(ws + WS_U); bf16_t* QK = U;
    bf16_t* WfinT = (bf16_t*)(ws + WS_WFIN); bf16_t* WfoutT = (bf16_t*)(ws + WS_WFOUT); bf16_t* ACT = (bf16_t*)(ws + WS_ACT);
    bf16_t* P = (bf16_t*)(ws + WS_P); float* Cbuf = (float*)(ws + WS_CBUF);
    float* H = a.out;
    const int lo = a.ph_lo, hi = a.ph_hi;
    const int gw = blockIdx.x * 8 + wave, ngw = G * 8;
#define IN(k) (lo <= (k) && (k) < hi)
#if MK_MULTI
#define SEAM(k) do {} while (0)
#else
#define SEAM(k) do { if (IN(k) && IN((k) + 1)) { __threadfence(); cg::this_grid().sync(); } } while (0)
#endif
    if (IN(0)) {
        LAS float* scr = (LAS float*)(lds + wave * 16384);
        transpose_all<1>(a.f1_in, D_, 2 * DFF, 2 * DFF, WfinT, scr, gw, ngw, lane);
        transpose_all<0>(a.f1_out, DFF, D_, D_, WfoutT, scr, gw, ngw, lane);
        transpose_all<2>(a.w_in, D_, PROJ_OUT, PP, WinT, scr, gw, ngw, lane);
        transpose_all<0>(a.w_att, 1024, D_, D_, WattT, scr, gw, ngw, lane);
        transpose_all<0>(a.w_ml, 1024, D_, D_, WmlT, scr, gw, ngw, lane);
        transpose_all<0>(a.w_out, D_, D_, D_, WoutT, scr, gw, ngw, lane);
        for (int it = gw; it < 72 * 32; it += ngw) {
            const int cgp = it % 72, kc = it / 72, col = cgp * 256 + 4 * lane;
            f32x4 s0 = {0.f, 0.f, 0.f, 0.f}, s1 = {0.f, 0.f, 0.f, 0.f};
#pragma unroll 8
            for (int kk = 0; kk < 64; ++kk) {
                const int k = kc * 64 + kk;
                const float c0 = a.c[k], c1 = a.c[D_ + k];
                const float e0 = c0 * sigm(c0), e1 = c1 * sigm(c1);
                const f32x4 w4 = *(const f32x4*)(a.w_ada + (size_t)k * NMOD + col);
                s0 += w4 * e0; s1 += w4 * e1;
            }
            if (kc == 0) { const f32x4 bb = *(const f32x4*)(a.b_ada + col); s0 += bb; s1 += bb; }
#pragma unroll
            for (int e = 0; e < 4; ++e) { atomicAdd(mod + col + e, s0[e]); atomicAdd(mod + NMOD + col + e, s1[e]); }
        }
        for (int i = blockIdx.x * 512 + tid; i < M_ * 8; i += G * 512) {
            const int row = i >> 3, j = i & 7;
            const float invf = (j == 0) ? 1.0f : (j == 1) ? 0.19392274f : (j == 2) ? 0.03760603f : (j == 3) ? 0.0072926646f : (j == 4) ? 0.0014142136f : (j == 5) ? 0.0002742482f : (j == 6) ? 5.3182957e-05f : 1.0313385e-05f;
            const float ang = (float)a.pos[row] * invf;
            double f = (double)ang * 0.15915494309189535; f -= rint(f);
            rope[(size_t)row * 16 + j] = __builtin_amdgcn_cosf((float)f);
            rope[(size_t)row * 16 + 8 + j] = __builtin_amdgcn_sinf((float)f);
        }
        __syncthreads();
    }
    SEAM(0);
    if (IN(1)) norm_phase<false>(a.x, a.norm1_g, mod, 0, 2048, U, nullptr, nullptr, lds, tid, wave, lane);
    SEAM(1);
    if (IN(2)) { pg8::Gemm g{U, WfinT, M_, 2 * DFF, D_, D_}; pg8::StaticOrder S; S.init(M_, 2 * DFF, G, (int)blockIdx.x); EpiSwiglu E{ACT}; pg8::gemm_phase(lds, g, S, E); }
    SEAM(2);
    if (IN(3)) { pg8::Gemm g{ACT, WfoutT, M_, D_, DFF, DFF}; pg8::StaticOrder S; S.init(M_, D_, G, (int)blockIdx.x); EpiResid E{a.x, H, mod + 4096, 0.5f}; pg8::gemm_phase(lds, g, S, E); }
    SEAM(3);
    if (IN(4)) norm_phase<true>(H, a.norm2_g, mod, 6144, 8192, U, gif, a.w_in, lds, tid, wave, lane);
    SEAM(4);
    if (IN(5)) { pg8::Gemm g{U, WinT, M_, PP, D_, D_}; pg8::StaticOrder S; S.init(M_, PP, G, (int)blockIdx.x); EpiProj E{P, rope}; pg8::gemm_phase(lds, g, S, E); }
    SEAM(5);
    if (IN(6)) {
        for (int it = blockIdx.x; it < 256; it += G) attn_item(it, P, a.sinks, lds, tid, wave, lane);
        for (int it = blockIdx.x; it < 1024; it += G) m1_item(it, P, QK, gif, a.conv_w, a.conv_b, a.b_ig, a.b_fg, Cbuf, scal, lds, tid, wave, lane);
    }
    SEAM(6);
    if (IN(7)) m2_scan(Cbuf, scal, blockIdx.x * 512 + tid, G * 512);
    SEAM(7);
    if (IN(8)) for (int it = blockIdx.x; it < 1024; it += G) m3_item(it, P, QK, gif, a.b_ig, a.b_fg, Cbuf, scal, a.mnorm_g, lds, tid, wave, lane);
    SEAM(8);
    if (IN(9)) {
        { pg8::Gemm g{P + PC_Q, WattT, M_, D_, 1024, PP}; pg8::StaticOrder S; S.init(M_, D_, G, (int)blockIdx.x); EpiMerge E{P, 1}; pg8::gemm_phase(lds, g, S, E); }
        { pg8::Gemm g{P + PC_MV, WmlT, M_, D_, 1024, PP}; pg8::StaticOrder S; S.init(M_, D_, G, (int)blockIdx.x); EpiMerge E{P, 0}; pg8::gemm_phase(lds, g, S, E); }
    }
    SEAM(9);
    if (IN(10)) { pg8::Gemm g{P + PC_G, WoutT, M_, D_, D_, PP}; pg8::StaticOrder S; S.init(M_, D_, G, (int)blockIdx.x); EpiResid E{H, H, mod + 10240, 1.0f}; pg8::gemm_phase(lds, g, S, E); }
    SEAM(10);
    if (IN(11)) {
        LAS float* scr = (LAS float*)(lds + wave * 16384);
        transpose_all<1>(a.f2_in, D_, 2 * DFF, 2 * DFF, WfinT, scr, gw, ngw, lane);
        transpose_all<0>(a.f2_out, DFF, D_, D_, WfoutT, scr, gw, ngw, lane);
        norm_phase<false>(H, a.norm3_g, mod, 12288, 14336, U, nullptr, nullptr, lds, tid, wave, lane);
    }
    SEAM(11);
    if (IN(12)) { pg8::Gemm g{U, WfinT, M_, 2 * DFF, D_, D_}; pg8::StaticOrder S; S.init(M_, 2 * DFF, G, (int)blockIdx.x); EpiSwiglu E{ACT}; pg8::gemm_phase(lds, g, S, E); }
    SEAM(12);
    if (IN(13)) { pg8::Gemm g{ACT, WfoutT, M_, D_, DFF, DFF}; pg8::StaticOrder S; S.init(M_, D_, G, (int)blockIdx.x); EpiResid E{H, H, mod + 16384, 0.5f}; pg8::gemm_phase(lds, g, S, E); }
    SEAM(13);
    if (IN(14)) {
        for (int row = gw; row < M_; row += ngw) {
            f32x4* xr = (f32x4*)(H + (size_t)row * D_) + lane;
            f32x4 v[8]; float ss = 0.f;
#pragma unroll
            for (int j = 0; j < 8; ++j) { v[j] = xr[64 * j]; ss += (v[j][0] * v[j][0] + v[j][1] * v[j][1]) + (v[j][2] * v[j][2] + v[j][3] * v[j][3]); }
            const float rstd = 1.0f / sqrtf(wave_sum(ss) * (1.0f / D_) + EPS);
#pragma unroll
            for (int j = 0; j < 8; ++j) { const f32x4 g4 = *(const f32x4*)(a.final_g + 256 * j + 4 * lane); xr[64 * j] = (v[j] * rstd) * g4; }
        }
    }
#undef IN
#undef SEAM
}

extern "C" void kernel_launch(void* const* d_in, const int* in_sizes, int n_in, void* d_out, int out_size, void* d_ws, size_t ws_size, hipStream_t stream) {
    static int grid = 0;
    if (grid == 0) {
        if (n_in != 23 || out_size != M_ * D_ || ws_size < WS_END) { fprintf(stderr, "kernel_launch: unexpected shapes (n_in %d, out %d, ws %zu < %zu)\n", n_in, out_size, ws_size, (size_t)WS_END); grid = -1; return; }
        int dev = 0, cus = 0, per_cu = 0;
        (void)hipGetDevice(&dev);
        (void)hipDeviceGetAttribute(&cus, hipDeviceAttributeMultiprocessorCount, dev);
        (void)hipFuncSetAttribute((const void*)fwd_kernel, hipFuncAttributeMaxDynamicSharedMemorySize, LDS_BYTES);
        (void)hipOccupancyMaxActiveBlocksPerMultiprocessor(&per_cu, (const void*)fwd_kernel, 512, LDS_BYTES);
        if (per_cu < 1) per_cu = 1;
        (void)hipGetLastError();
        grid = cus * per_cu;
    }
    if (grid < 0) return;
    (void)hipMemsetAsync((char*)d_ws + WS_MOD, 0, MOD_BYTES, stream);
    Args a{};
    a.x = (const float*)d_in[0]; a.c = (const float*)d_in[1]; a.pos = (const int*)d_in[2]; a.w_ada = (const float*)d_in[3]; a.b_ada = (const float*)d_in[4];
    a.norm1_g = (const float*)d_in[5]; a.f1_in = (const float*)d_in[6]; a.f1_out = (const float*)d_in[7]; a.norm2_g = (const float*)d_in[8]; a.w_in = (const float*)d_in[9];
    a.conv_w = (const float*)d_in[10]; a.conv_b = (const float*)d_in[11]; a.b_ig = (const float*)d_in[12]; a.b_fg = (const float*)d_in[13]; a.sinks = (const float*)d_in[14];
    a.mnorm_g = (const float*)d_in[15]; a.w_att = (const float*)d_in[16]; a.w_ml = (const float*)d_in[17]; a.w_out = (const float*)d_in[18]; a.norm3_g = (const float*)d_in[19];
    a.f2_in = (const float*)d_in[20]; a.f2_out = (const float*)d_in[21]; a.final_g = (const float*)d_in[22];
    a.out = (float*)d_out; a.ws = (unsigned char*)d_ws;
#if MK_MULTI
    for (int p = 0; p < N_PHASES; ++p) { a.ph_lo = p; a.ph_hi = p + 1; hipLaunchKernelGGL(fwd_kernel, dim3(grid), dim3(512), LDS_BYTES, stream, a); }
#else
    a.ph_lo = 0; a.ph_hi = N_PHASES;
    void* args[] = {&a};
    hipError_t e = hipLaunchCooperativeKernel((const void*)fwd_kernel, dim3(grid), dim3(512), args, LDS_BYTES, stream);
    if (e != hipSuccess) fprintf(stderr, "cooperative launch failed: %s (grid %d)\n", hipGetErrorString(e), grid);
#endif
}
```

```cpp
#include <hip/hip_runtime.h>
#include <hip/hip_cooperative_groups.h>
#include <cstdio>
#include <cstdint>
namespace cg = cooperative_groups;

#ifndef MK_MULTI
#define MK_MULTI 0
#endif

#define LAS __attribute__((address_space(3)))
typedef unsigned short bf16_t;
typedef short bf16x8 __attribute__((ext_vector_type(8)));
typedef float f32x4 __attribute__((ext_vector_type(4)));
typedef float f32x2 __attribute__((ext_vector_type(2)));
typedef unsigned u32x4 __attribute__((ext_vector_type(4)));
typedef unsigned u32x2 __attribute__((ext_vector_type(2)));

constexpr int M_ = 16384, D_ = 2048, T_ = 8192, DFF = 5632, NMOD = 18432, PROJ_OUT = 8456;
constexpr int PP = 8448;
constexpr int PC_Q = 0, PC_K = 1024, PC_V = 1152, PC_MQK = 1280, PC_MV = 2304, PC_MO = 3328, PC_G = 4352;
constexpr float EPS = 1e-6f;
constexpr size_t MiB = 1u << 20;
constexpr size_t WS_MOD = 0, MOD_BYTES = 2 * NMOD * 4, WS_BAR = 192 * 1024, CTL_ZERO_BYTES = 256 * 1024;
constexpr size_t WS_ROPE = 1 * MiB, WS_GIF = 2 * MiB, WS_SCAL = 2 * MiB + 512 * 1024;
constexpr size_t WS_WIN = 4 * MiB, WS_WATT = 37 * MiB, WS_WML = 41 * MiB, WS_WOUT = 45 * MiB;
constexpr size_t WS_U = 53 * MiB;
constexpr size_t WS_R = 117 * MiB;
constexpr size_t WS_WFIN = WS_R, WS_WFOUT = WS_R + 44 * MiB, WS_ACT = WS_R + 66 * MiB;
constexpr size_t WS_P = WS_R, WS_CBUF = WS_R + 264 * MiB;
constexpr size_t WS_END = WS_CBUF + (size_t)1024 * 257 * 128 * 4;
constexpr int LDS_BYTES = 147456;

namespace pg8 {
constexpr int BM = 256, BK = 64, HALF = 128, HTB = HALF * BK * 2, STAGE_BYTES = 8 * HTB, NXCD = 8, WGM = 8;
__host__ __device__ __forceinline__ int lds_byte(int r, int c) { const int st = (r >> 4) * 2 + (c >> 5), rr = r & 15, cc = c & 31, ob = rr * 64 + cc * 2; return st * 1024 + (ob ^ (((ob >> 9) & 1) << 5)); }
__host__ __device__ __forceinline__ void stage_rc(int b, int& R, int& C) { const int st = b / 1024, sb = b % 1024, swz = sb ^ (((sb >> 9) & 1) << 5); R = (st >> 1) * 16 + swz / 64; C = (st & 1) * 32 + (swz % 64) / 2; }
__host__ __device__ __forceinline__ int perm32(int rho) { const int n = rho >> 4, i = rho & 15; return 8 * (i >> 2) + 4 * n + (i & 3); }
struct Unit { int pm, pn; };
struct Gemm { const bf16_t* A; const bf16_t* Bt; int M, N, K, lda; };
struct StaticOrder {
    int nM, nN, nwg, G, c;
    __host__ __device__ void init(int M, int N, int G_, int c_) { nM = M / BM; nN = N / BM; nwg = nM * nN; G = G_; c = c_; }
    __host__ __device__ bool next(int i, Unit& u) const {
        const long L = (long)i * G + c; if (L >= nwg) return false;
        int wgid = (int)L; { const int q = nwg / NXCD, r = nwg % NXCD, xcd = wgid % NXCD, off = wgid / NXCD; wgid = (xcd < r ? xcd * (q + 1) : r * (q + 1) + (xcd - r) * q) + off; }
        const int nig = WGM * nN, gid = wgid / nig, fm = gid * WGM, gsz = (nM - fm) < WGM ? (nM - fm) : WGM;
        u.pm = fm + ((wgid % nig) % gsz); u.pn = (wgid % nig) / gsz; return true;
    }
};
__device__ __forceinline__ unsigned cvt_pk_bf16(float lo, float hi) { unsigned r; asm volatile("v_cvt_pk_bf16_f32 %0, %1, %2" : "=v"(r) : "v"(lo), "v"(hi)); return r; }

template <class Epi>
__device__ __forceinline__ void gemm_phase(LAS unsigned char* lds, const Gemm g, const StaticOrder& S, const Epi& E) {
    const int tid = threadIdx.x, wid = __builtin_amdgcn_readfirstlane(tid >> 6), lane = tid & 63, wr = wid >> 2, wc = wid & 3, fr = lane & 15, fq = lane >> 4;
    const int K = g.K, nt = K / BK, lda = g.lda;
    unsigned voffA[2], voffB[2];
#pragma unroll
    for (int i = 0; i < 2; ++i) { int R, C; stage_rc(tid * 16 + i * 8192, R, C); const int Rb = (R & ~31) + perm32(R & 31);
        voffA[i] = (unsigned)(R * lda + C) * 2u; voffB[i] = (unsigned)(Rb * K + C) * 2u; }
    const size_t kstep = (size_t)(BK * 2);
    const size_t hstepA = (size_t)HALF * lda * 2, hstepB = (size_t)HALF * K * 2;
    const size_t tstepA = 2 * hstepA, tstepB = 2 * hstepB;
    const unsigned ldsw = (unsigned)wid * 1024u;
    const int aoff = lds_byte(wr * 64 + fr, fq * 8), boff = lds_byte(wc * 32 + fr, fq * 8);
#define PG8_SA(b, h) (((b) * 2 + (h)) * HTB)
#define PG8_SB(b, h) ((4 + (b) * 2 + (h)) * HTB)
#define PG8_STAGE(bufoff, gbase, voff) do { _Pragma("unroll") for (int _i = 0; _i < 2; ++_i) \
        __builtin_amdgcn_global_load_lds((const unsigned*)((const char*)(gbase) + (voff)[_i]), (LAS unsigned*)(lds + (bufoff) + ldsw + _i * 8192), 16, 0, 0); } while (0)
#define PG8_LDA(dst, b, h) do { _Pragma("unroll") for (int m = 0; m < 4; ++m) _Pragma("unroll") for (int k = 0; k < 2; ++k) dst[m][k] = *(const LAS bf16x8*)(lds + PG8_SA(b, h) + aoff + m * 2048 + k * 1024); } while (0)
#define PG8_LDB(dst, b, h) do { _Pragma("unroll") for (int n = 0; n < 2; ++n) _Pragma("unroll") for (int k = 0; k < 2; ++k) dst[n][k] = *(const LAS bf16x8*)(lds + PG8_SB(b, h) + boff + n * 2048 + k * 1024); } while (0)
#define PG8_MMA(ai, bj, At, Bt) do { __builtin_amdgcn_s_setprio(1); _Pragma("unroll") for (int m = 0; m < 4; ++m) _Pragma("unroll") for (int n = 0; n < 2; ++n) _Pragma("unroll") for (int k = 0; k < 2; ++k) \
        acc[ai][bj][m][n] = __builtin_amdgcn_mfma_f32_16x16x32_bf16(Bt[n][k], At[m][k], acc[ai][bj][m][n], 0, 0, 0); __builtin_amdgcn_s_setprio(0); } while (0)
#define PG8_WAIT_V(n) asm volatile("s_waitcnt vmcnt(" #n ")" ::: "memory")
#define PG8_WAIT_L(n) asm volatile("s_waitcnt lgkmcnt(" #n ")" ::: "memory")
#define PG8_BAR __builtin_amdgcn_s_barrier()
#define PG8_SCHED __builtin_amdgcn_sched_barrier(0)
    Unit cur, nxt; int ui = 0;
    if (!S.next(0, cur)) return;
    f32x4 acc[2][2][4][2];
#pragma unroll
    for (int a = 0; a < 2; ++a)
#pragma unroll
        for (int b = 0; b < 2; ++b)
#pragma unroll
            for (int m = 0; m < 4; ++m)
#pragma unroll
                for (int n = 0; n < 2; ++n) acc[a][b][m][n] = (f32x4){0.f, 0.f, 0.f, 0.f};
    bf16x8 At[4][2], B0[2][2], B1[2][2];
    const char* cA = (const char*)g.A + (size_t)cur.pm * tstepA; const char* cB = (const char*)g.Bt + (size_t)cur.pn * tstepB;
    PG8_STAGE(PG8_SB(0, 0), cB, voffB); PG8_STAGE(PG8_SB(0, 1), cB + hstepB, voffB); PG8_STAGE(PG8_SA(0, 0), cA, voffA); PG8_STAGE(PG8_SA(0, 1), cA + hstepA, voffA);
    if (wr == 1) PG8_BAR;
    PG8_WAIT_V(2); PG8_BAR;
    PG8_STAGE(PG8_SB(1, 0), cB + kstep, voffB); PG8_STAGE(PG8_SA(1, 0), cA + kstep, voffA); PG8_STAGE(PG8_SB(1, 1), cB + hstepB + kstep, voffB);
    PG8_WAIT_V(6); PG8_BAR;
    for (;;) {
        const bool has_next = S.next(ui + 1, nxt);
        const char* nA = has_next ? (const char*)g.A + (size_t)nxt.pm * tstepA : cA; const char* nB = has_next ? (const char*)g.Bt + (size_t)nxt.pn * tstepB : cB;
        for (int t = 0; t < nt; t += 2) {
            const bool last = (t == nt - 2);
            const char* a1 = cA + (size_t)(t + 1) * kstep;
            const char* a2 = last ? nA : cA + (size_t)(t + 2) * kstep; const char* b2 = last ? nB : cB + (size_t)(t + 2) * kstep;
            const char* a3 = a2 + kstep; const char* b3 = b2 + kstep;
            PG8_LDB(B0, 0, 0); PG8_LDB(B1, 0, 1); PG8_SCHED; PG8_LDA(At, 0, 0); PG8_STAGE(PG8_SA(1, 1), a1 + hstepA, voffA);
            PG8_WAIT_V(8); PG8_WAIT_L(0); PG8_BAR; PG8_MMA(0, 0, At, B0); PG8_MMA(0, 1, At, B1); PG8_BAR; PG8_SCHED;
            PG8_LDA(At, 0, 1); PG8_STAGE(PG8_SB(0, 0), b2, voffB); PG8_STAGE(PG8_SB(0, 1), b2 + hstepB, voffB); PG8_STAGE(PG8_SA(0, 0), a2, voffA);
            PG8_WAIT_V(8); PG8_WAIT_L(0); PG8_BAR; PG8_MMA(1, 0, At, B0); PG8_MMA(1, 1, At, B1); PG8_BAR; PG8_SCHED;
            PG8_LDB(B0, 1, 0); PG8_LDB(B1, 1, 1); PG8_SCHED; PG8_LDA(At, 1, 0); PG8_STAGE(PG8_SA(0, 1), a2 + hstepA, voffA);
            PG8_WAIT_V(8); PG8_WAIT_L(0); PG8_BAR; PG8_MMA(0, 0, At, B0); PG8_MMA(0, 1, At, B1); PG8_BAR; PG8_SCHED;
            PG8_LDA(At, 1, 1); PG8_STAGE(PG8_SB(1, 0), b3, voffB); PG8_STAGE(PG8_SB(1, 1), b3 + hstepB, voffB); PG8_STAGE(PG8_SA(1, 0), a3, voffA);
            PG8_WAIT_V(8); PG8_WAIT_L(0); PG8_BAR; PG8_MMA(1, 0, At, B0); PG8_MMA(1, 1, At, B1); PG8_BAR; PG8_SCHED;
        }
        if (wr == 0) PG8_BAR;
        E(acc, cur, wr, wc, fr, fq);
        if (!has_next) break;
#pragma unroll
        for (int a = 0; a < 2; ++a)
#pragma unroll
            for (int b = 0; b < 2; ++b)
#pragma unroll
                for (int m = 0; m < 4; ++m)
#pragma unroll
                    for (int n = 0; n < 2; ++n) acc[a][b][m][n] = (f32x4){0.f, 0.f, 0.f, 0.f};
        cur = nxt; cA = nA; cB = nB; ++ui;
        if (wr == 1) PG8_BAR;
    }
    PG8_WAIT_V(0);
    PG8_BAR;
#undef PG8_SA
#undef PG8_SB
#undef PG8_STAGE
#undef PG8_LDA
#undef PG8_LDB
#undef PG8_MMA
#undef PG8_WAIT_V
#undef PG8_WAIT_L
#undef PG8_BAR
#undef PG8_SCHED
}
}
using pg8::cvt_pk_bf16;
using pg8::Unit;

__device__ __forceinline__ float bf2f(unsigned short h) { return __uint_as_float((unsigned)h << 16); }
__device__ __forceinline__ float bflo(unsigned w) { return __uint_as_float(w << 16); }
__device__ __forceinline__ float bfhi(unsigned w) { return __uint_as_float(w & 0xffff0000u); }
__device__ __forceinline__ unsigned short f2bf(float f) { return (unsigned short)(cvt_pk_bf16(f, 0.f) & 0xffffu); }
__device__ __forceinline__ float sigm(float x) { return __builtin_amdgcn_rcpf(1.f + __expf(-x)); }
__device__ __forceinline__ float wave_sum(float v) {
#pragma unroll
    for (int o = 1; o < 64; o <<= 1) v += __shfl_xor(v, o);
    return v;
}
__device__ __forceinline__ float wave_max(float v) {
#pragma unroll
    for (int o = 1; o < 64; o <<= 1) v = fmaxf(v, __shfl_xor(v, o));
    return v;
}
__device__ __forceinline__ float log_sigmoid(float x) { return fminf(x, 0.f) - log1pf(expf(-fabsf(x))); }
__device__ __forceinline__ bf16x8 pack8(f32x4 a, f32x4 b) {
    u32x4 w; w.x = cvt_pk_bf16(a[0], a[1]); w.y = cvt_pk_bf16(a[2], a[3]); w.z = cvt_pk_bf16(b[0], b[1]); w.w = cvt_pk_bf16(b[2], b[3]);
    return __builtin_bit_cast(bf16x8, w);
}
__device__ __forceinline__ int kperm32(int kl) { return 8 * ((kl & 15) >> 2) + (kl & 3) + 4 * (kl >> 4); }

struct EpiSwiglu {
    bf16_t* O;
    __device__ __forceinline__ void operator()(const f32x4 (&acc)[2][2][4][2], const Unit& u, int wr, int wc, int fr, int fq) const {
        const int row0 = u.pm * 256 + wr * 64 + fr, col0 = u.pn * 128 + wc * 32 + 8 * fq;
#pragma unroll
        for (int ai = 0; ai < 2; ++ai)
#pragma unroll
            for (int m = 0; m < 4; ++m) {
                bf16_t* rowp = O + (size_t)(row0 + ai * 128 + m * 16) * DFF + col0;
                float v[8];
#pragma unroll
                for (int n = 0; n < 2; ++n)
#pragma unroll
                    for (int e = 0; e < 4; ++e) { const float a = acc[ai][0][m][n][e], b = acc[ai][1][m][n][e]; v[n * 4 + e] = a * sigm(a) * b; }
                u32x4 w; w.x = cvt_pk_bf16(v[0], v[1]); w.y = cvt_pk_bf16(v[2], v[3]); w.z = cvt_pk_bf16(v[4], v[5]); w.w = cvt_pk_bf16(v[6], v[7]);
                *(u32x4*)rowp = w;
            }
    }
};
struct EpiResid {
    const float* base; float* out; const float* gate; float scale;
    __device__ __forceinline__ void operator()(const f32x4 (&acc)[2][2][4][2], const Unit& u, int wr, int wc, int fr, int fq) const {
        const int row0 = u.pm * 256 + wr * 64 + fr, col0 = u.pn * 256 + wc * 32 + 8 * fq;
        const float* gp = gate + (size_t)(u.pm >> 5) * NMOD + col0;
        f32x4 gv[2][2];
#pragma unroll
        for (int bj = 0; bj < 2; ++bj)
#pragma unroll
            for (int n = 0; n < 2; ++n) gv[bj][n] = *(const f32x4*)(gp + bj * 128 + 4 * n) * scale;
#pragma unroll
        for (int ai = 0; ai < 2; ++ai)
#pragma unroll
            for (int m = 0; m < 4; ++m) {
                const size_t off = (size_t)(row0 + ai * 128 + m * 16) * D_ + col0;
#pragma unroll
                for (int bj = 0; bj < 2; ++bj)
#pragma unroll
                    for (int n = 0; n < 2; ++n) { const f32x4 bs = *(const f32x4*)(base + off + bj * 128 + 4 * n); *(f32x4*)(out + off + bj * 128 + 4 * n) = bs + gv[bj][n] * acc[ai][bj][m][n]; }
            }
    }
};
struct EpiProj {
    bf16_t* P; const float* rope;
    __device__ __forceinline__ void operator()(const f32x4 (&acc)[2][2][4][2], const Unit& u, int wr, int wc, int fr, int fq) const {
        const int row0 = u.pm * 256 + wr * 64 + fr, col0 = u.pn * 256 + wc * 32 + 8 * fq;
        const bool sig = u.pn >= 13;
        const bool ropelane = ((wc & 1) == 0) && (fq < 2) && (u.pn <= 4);
#pragma unroll
        for (int ai = 0; ai < 2; ++ai)
#pragma unroll
            for (int m = 0; m < 4; ++m) {
                const int row = row0 + ai * 128 + m * 16;
                f32x4 cs = {1.f, 1.f, 1.f, 1.f}, sn = {0.f, 0.f, 0.f, 0.f};
                if (ropelane) { cs = *(const f32x4*)(rope + (size_t)row * 16 + fq * 4); sn = *(const f32x4*)(rope + (size_t)row * 16 + 8 + fq * 4); }
#pragma unroll
                for (int bj = 0; bj < 2; ++bj) {
                    f32x4 v0 = acc[ai][bj][m][0], v1 = acc[ai][bj][m][1];
                    if (ropelane && (u.pn < 4 || bj == 0)) { const f32x4 x1 = v0, x2 = v1; v0 = x1 * cs - x2 * sn; v1 = x2 * cs + x1 * sn; }
                    if (sig) {
#pragma unroll
                        for (int e = 0; e < 4; ++e) { v0[e] = sigm(v0[e]); v1[e] = sigm(v1[e]); }
                    }
                    u32x4 w; w.x = cvt_pk_bf16(v0[0], v0[1]); w.y = cvt_pk_bf16(v0[2], v0[3]); w.z = cvt_pk_bf16(v1[0], v1[1]); w.w = cvt_pk_bf16(v1[2], v1[3]);
                    *(u32x4*)(P + (size_t)row * PP + col0 + bj * 128) = w;
                }
            }
    }
};
struct EpiMerge {
    bf16_t* P; int first;
    __device__ __forceinline__ void operator()(const f32x4 (&acc)[2][2][4][2], const Unit& u, int wr, int wc, int fr, int fq) const {
        const int row0 = u.pm * 256 + wr * 64 + fr, col0 = u.pn * 256 + wc * 32 + 8 * fq;
#pragma unroll
        for (int ai = 0; ai < 2; ++ai)
#pragma unroll
            for (int m = 0; m < 4; ++m)
#pragma unroll
                for (int bj = 0; bj < 2; ++bj) {
                    bf16_t* zp = P + (size_t)(row0 + ai * 128 + m * 16) * PP + PC_G + col0 + bj * 128;
                    const u32x4 z8 = *(const u32x4*)zp;
                    u32x4 g8 = z8; if (!first) g8 = *(const u32x4*)(zp + 2048);
                    const f32x4 a0 = acc[ai][bj][m][0], a1 = acc[ai][bj][m][1];
                    float o[8];
                    o[0] = bflo(g8.x) * a0[0]; o[1] = bfhi(g8.x) * a0[1]; o[2] = bflo(g8.y) * a0[2]; o[3] = bfhi(g8.y) * a0[3];
                    o[4] = bflo(g8.z) * a1[0]; o[5] = bfhi(g8.z) * a1[1]; o[6] = bflo(g8.w) * a1[2]; o[7] = bfhi(g8.w) * a1[3];
                    if (!first) { o[0] += bflo(z8.x); o[1] += bfhi(z8.x); o[2] += bflo(z8.y); o[3] += bfhi(z8.y); o[4] += bflo(z8.z); o[5] += bfhi(z8.z); o[6] += bflo(z8.w); o[7] += bfhi(z8.w); }
                    u32x4 w; w.x = cvt_pk_bf16(o[0], o[1]); w.y = cvt_pk_bf16(o[2], o[3]); w.z = cvt_pk_bf16(o[4], o[5]); w.w = cvt_pk_bf16(o[6], o[7]);
                    *(u32x4*)zp = w;
                }
    }
};

struct Args {
    const float* x; const float* c; const int* pos; const float* w_ada; const float* b_ada; const float* norm1_g;
    const float* f1_in; const float* f1_out; const float* norm2_g; const float* w_in; const float* conv_w; const float* conv_b;
    const float* b_ig; const float* b_fg; const float* sinks; const float* mnorm_g; const float* w_att; const float* w_ml;
    const float* w_out; const float* norm3_g; const float* f2_in; const float* f2_out; const float* final_g;
    float* out; unsigned char* ws; int ph_lo, ph_hi;
};

template <int KIND> __device__ __forceinline__ int srccol(int n) {
    if (KIND == 0) return n;
    if (KIND == 1) { const int pn = n >> 8, bj = (n >> 7) & 1, i = n & 127; return bj * DFF + pn * 128 + i; }
    if (n < PC_V) { const int d = n & 63; if (d < 16) { const int g = d >> 2; const int dd = (g == 1) ? d + 4 : (g == 2) ? d - 4 : d; return (n & ~63) + dd; } return n; }
    if (n < PC_MO) return n;
    return n + 8;
}
template <int KIND> __device__ __forceinline__ void transpose_item(const float* W, int K, int N, bf16_t* WT, LAS float* scr, int item, int lane, int nblk) {
    const int kb = item / nblk, nb = item % nblk, k0 = 64 * kb, n0 = 32 * nb;
    const int sc = srccol<KIND>(n0 + (lane & 31));
#pragma unroll 8
    for (int i = 0; i < 32; ++i) { const int kk = 2 * i + (lane >> 5); scr[kk * 33 + (lane & 31)] = W[(size_t)(k0 + kk) * N + sc]; }
    asm volatile("s_waitcnt lgkmcnt(0)" ::: "memory");
    const int c = lane & 7;
#pragma unroll
    for (int j = 0; j < 4; ++j) { const int n = (lane >> 3) + 8 * j; const LAS float* s = scr + (8 * c) * 33 + n;
        u32x4 o; o.x = cvt_pk_bf16(s[0 * 33], s[1 * 33]); o.y = cvt_pk_bf16(s[2 * 33], s[3 * 33]); o.z = cvt_pk_bf16(s[4 * 33], s[5 * 33]); o.w = cvt_pk_bf16(s[6 * 33], s[7 * 33]);
        *(u32x4*)(WT + (size_t)(n0 + n) * K + k0 + 8 * c) = o; }
    asm volatile("s_waitcnt lgkmcnt(0)" ::: "memory");
}
template <int KIND> __device__ __forceinline__ void transpose_all(const float* W, int K, int N, int Nout, bf16_t* WT, LAS float* scr, int gw, int ngw, int lane) {
    const int nblk = Nout / 32, items = (K / 64) * nblk;
    for (int it = gw; it < items; it += ngw) transpose_item<KIND>(W, K, N, WT, scr, it, lane, nblk);
}

template <bool GATES> __device__ __forceinline__ void norm_phase(const float* hin, const float* g, const float* mod, int sh_off, int sc_off, bf16_t* uout,
                                                                 float* gif, const float* w_in, LAS unsigned char* lds, int tid, int wave, int lane) {
    LAS float* wgT = (LAS float*)lds;
    if (GATES) {
        for (int idx = tid; idx < 2048 * 8; idx += 512) { const int k = idx >> 3, j = idx & 7; wgT[j * 2048 + k] = w_in[(size_t)k * PROJ_OUT + 3328 + j]; }
        __syncthreads();
    }
    const int gw = blockIdx.x * 8 + wave, ngw = gridDim.x * 8;
    for (int row = gw; row < M_; row += ngw) {
        const int b = row >> 13;
        const f32x4* xr = (const f32x4*)(hin + (size_t)row * D_) + lane;
        f32x4 v[8]; float ss = 0.f;
#pragma unroll
        for (int j = 0; j < 8; ++j) { v[j] = xr[64 * j]; ss += (v[j][0] * v[j][0] + v[j][1] * v[j][1]) + (v[j][2] * v[j][2] + v[j][3] * v[j][3]); }
        const float rstd = 1.0f / sqrtf(wave_sum(ss) * (1.0f / D_) + EPS);
        float ga[8];
#pragma unroll
        for (int i = 0; i < 8; ++i) ga[i] = 0.f;
#pragma unroll
        for (int j = 0; j < 8; ++j) {
            const int col = 256 * j + 4 * lane;
            const f32x4 g4 = *(const f32x4*)(g + col), sc4 = *(const f32x4*)(mod + (size_t)b * NMOD + sc_off + col), sh4 = *(const f32x4*)(mod + (size_t)b * NMOD + sh_off + col);
            const f32x4 y = (v[j] * rstd) * g4 * (sc4 + 1.0f) + sh4;
            u32x2 w; w.x = cvt_pk_bf16(y[0], y[1]); w.y = cvt_pk_bf16(y[2], y[3]);
            *(u32x2*)(uout + (size_t)row * D_ + col) = w;
            if (GATES) {
#pragma unroll
                for (int i = 0; i < 8; ++i) { const f32x4 w4 = *(const LAS f32x4*)(wgT + i * 2048 + col); ga[i] += (y[0] * w4[0] + y[1] * w4[1]) + (y[2] * w4[2] + y[3] * w4[3]); }
            }
        }
        if (GATES) {
#pragma unroll
            for (int i = 0; i < 8; ++i) ga[i] = wave_sum(ga[i]);
            if (lane == 0) { *(f32x4*)(gif + (size_t)row * 8) = (f32x4){ga[0], ga[1], ga[2], ga[3]}; *(f32x4*)(gif + (size_t)row * 8 + 4) = (f32x4){ga[4], ga[5], ga[6], ga[7]}; }
        }
    }
    if (GATES) __syncthreads();
}

__device__ __forceinline__ void attn_item(int item, bf16_t* P, const float* sinks, LAS unsigned char* lds, int tid, int wave, int lane) {
    const int kvh = item & 1, nb = (item >> 1) & 63, b = item >> 7;
    const int r0 = b * T_ + nb * 128;
    LAS bf16_t* Ksh = (LAS bf16_t*)lds;
    LAS bf16_t* VT = (LAS bf16_t*)(lds + 36864);
#pragma unroll
    for (int i = 0; i < 4; ++i) {
        const int chunk = tid + 512 * i, key = chunk >> 3, c8 = chunk & 7;
        const bool valid = (nb > 0) || (key >= 128);
        u32x4 kv = {0u, 0u, 0u, 0u}, vv = {0u, 0u, 0u, 0u};
        if (valid) { const bf16_t* rp = P + (size_t)(r0 - 128 + key) * PP; kv = *(const u32x4*)(rp + PC_K + kvh * 64 + c8 * 8); vv = *(const u32x4*)(rp + PC_V + kvh * 64 + c8 * 8); }
        *(LAS u32x4*)(Ksh + key * 72 + c8 * 8) = kv;
        const int pos = (key & ~31) + kperm32(key & 31);
        LAS bf16_t* vp = VT + (c8 * 8) * 264 + pos;
        vp[0 * 264] = (bf16_t)(vv.x & 0xffff); vp[1 * 264] = (bf16_t)(vv.x >> 16); vp[2 * 264] = (bf16_t)(vv.y & 0xffff); vp[3 * 264] = (bf16_t)(vv.y >> 16);
        vp[4 * 264] = (bf16_t)(vv.z & 0xffff); vp[5 * 264] = (bf16_t)(vv.z >> 16); vp[6 * 264] = (bf16_t)(vv.w & 0xffff); vp[7 * 264] = (bf16_t)(vv.w >> 16);
    }
    __syncthreads();
    const int h = kvh * 8 + wave, fr = lane & 15, fq = lane >> 4;
    const float sink = sinks[h];
    for (int qg = 0; qg < 8; ++qg) {
        const int qrow = r0 + qg * 16 + fr;
        bf16_t* qp = P + (size_t)qrow * PP + h * 64;
        const bf16x8 bq0 = *(const bf16x8*)(qp + 8 * fq), bq1 = *(const bf16x8*)(qp + 32 + 8 * fq);
        const int t0e = qg & ~1;
        f32x4 s[10];
#pragma unroll
        for (int tt = 0; tt < 10; ++tt) {
            const int t = min(t0e + tt, 15);
            const LAS bf16_t* kp = Ksh + (t * 16 + fr) * 72 + 8 * fq;
            const bf16x8 a0 = *(const LAS bf16x8*)kp, a1 = *(const LAS bf16x8*)(kp + 32);
            f32x4 z = {0.f, 0.f, 0.f, 0.f};
            z = __builtin_amdgcn_mfma_f32_16x16x32_bf16(a0, bq0, z, 0, 0, 0);
            s[tt] = __builtin_amdgcn_mfma_f32_16x16x32_bf16(a1, bq1, z, 0, 0, 0);
        }
        const int qi = 128 + qg * 16 + fr;
        float mx = -1e30f;
#pragma unroll
        for (int tt = 0; tt < 10; ++tt)
#pragma unroll
            for (int r = 0; r < 4; ++r) {
                const int kj = (t0e + tt) * 16 + 4 * fq + r;
                const bool ok = (kj <= qi) && (kj > qi - 128) && ((nb > 0) || (kj >= 128));
                const float sv = ok ? s[tt][r] * 0.125f : -1e30f;
                s[tt][r] = sv; mx = fmaxf(mx, sv);
            }
        mx = fmaxf(mx, __shfl_xor(mx, 16)); mx = fmaxf(mx, __shfl_xor(mx, 32)); mx = fmaxf(mx, sink);
        float sum = 0.f;
#pragma unroll
        for (int tt = 0; tt < 10; ++tt)
#pragma unroll
            for (int r = 0; r < 4; ++r) { const float p = __expf(s[tt][r] - mx); s[tt][r] = p; sum += p; }
        sum += __shfl_xor(sum, 16); sum += __shfl_xor(sum, 32);
        const float inv = 1.0f / (sum + __expf(sink - mx));
        bf16x8 bp[5];
#pragma unroll
        for (int g = 0; g < 5; ++g) bp[g] = pack8(s[2 * g], s[2 * g + 1]);
#pragma unroll
        for (int dt = 0; dt < 4; ++dt) {
            f32x4 o = {0.f, 0.f, 0.f, 0.f};
#pragma unroll
            for (int g = 0; g < 5; ++g) {
                const int grp = min((t0e >> 1) + g, 7);
                const bf16x8 a = *(const LAS bf16x8*)(VT + (dt * 16 + fr) * 264 + grp * 32 + 8 * fq);
                o = __builtin_amdgcn_mfma_f32_16x16x32_bf16(a, bp[g], o, 0, 0, 0);
            }
            u32x2 w; w.x = cvt_pk_bf16(o[0] * inv, o[1] * inv); w.y = cvt_pk_bf16(o[2] * inv, o[3] * inv);
            *(u32x2*)(qp + dt * 16 + 4 * fq) = w;
        }
    }
    __syncthreads();
}

__device__ __forceinline__ void m1_item(int item, const bf16_t* P, bf16_t* QK, const float* gif, const float* conv_w, const float* conv_b, const float* b_ig, const float* b_fg,
                                        float* Cbuf, float* scal, LAS unsigned char* lds, int tid, int wave, int lane) {
    const int c = item & 127, h = (item >> 7) & 3, b = item >> 9;
    const int r0 = b * T_ + c * 64;
    LAS bf16_t* VT = (LAS bf16_t*)lds;
    LAS bf16_t* KT = (LAS bf16_t*)(lds + 39168);
    LAS float* wl = (LAS float*)(lds + 57600);
    if (wave == 0) {
        const int row = r0 + lane;
        const float fpre = gif[(size_t)row * 8 + 4 + h] + b_fg[h], ipre = gif[(size_t)row * 8 + h] + b_ig[h];
        float bc = log_sigmoid(fpre);
#pragma unroll
        for (int o = 1; o < 64; o <<= 1) { const float t = __shfl_up(bc, o); if (lane >= o) bc += t; }
        const float blast = __shfl(bc, 63);
        const float gg = blast - bc + ipre;
        const float gmax = wave_max(gg);
        wl[lane] = expf(gg - gmax);
        if (lane == 0) { scal[item * 4 + 0] = gmax; scal[item * 4 + 1] = blast; }
    }
    for (int idx = tid; idx < 16 * 72; idx += 512) VT[256 * 72 + idx] = (idx < 64) ? (bf16_t)0x3F80 : (bf16_t)0;
    __syncthreads();
#pragma unroll
    for (int i = 0; i < 4; ++i) {
        const int task = tid + 512 * i, tl = task & 63, ch8 = task >> 6, qk = ch8 >> 4, j0 = (ch8 & 15) * 8;
        const int chan = qk * 512 + h * 128 + j0;
        float a[8];
        { const f32x4 b0 = *(const f32x4*)(conv_b + chan), b1 = *(const f32x4*)(conv_b + chan + 4); a[0] = b0[0]; a[1] = b0[1]; a[2] = b0[2]; a[3] = b0[3]; a[4] = b1[0]; a[5] = b1[1]; a[6] = b1[2]; a[7] = b1[3]; }
#pragma unroll
        for (int kk = 0; kk < 4; ++kk) {
            const int ts = c * 64 + tl - 3 + kk;
            if (ts >= 0) {
                const u32x4 x8 = *(const u32x4*)(P + (size_t)(b * T_ + ts) * PP + PC_MQK + chan);
                const f32x4 w0 = *(const f32x4*)(conv_w + kk * 1024 + chan), w1 = *(const f32x4*)(conv_w + kk * 1024 + chan + 4);
                a[0] += w0[0] * bflo(x8.x); a[1] += w0[1] * bfhi(x8.x); a[2] += w0[2] * bflo(x8.y); a[3] += w0[3] * bfhi(x8.y);
                a[4] += w1[0] * bflo(x8.z); a[5] += w1[1] * bfhi(x8.z); a[6] += w1[2] * bflo(x8.w); a[7] += w1[3] * bfhi(x8.w);
            }
        }
        const float ksc = qk ? 0.08838834764831845f : 1.0f;
#pragma unroll
        for (int e = 0; e < 8; ++e) a[e] = a[e] * sigm(a[e]) * ksc;
        u32x4 w; w.x = cvt_pk_bf16(a[0], a[1]); w.y = cvt_pk_bf16(a[2], a[3]); w.z = cvt_pk_bf16(a[4], a[5]); w.w = cvt_pk_bf16(a[6], a[7]);
        *(u32x4*)(QK + (size_t)(r0 + tl) * 1024 + chan) = w;
        if (qk) {
            const float wt = wl[tl];
#pragma unroll
            for (int e = 0; e < 8; ++e) KT[(j0 + e) * 72 + tl] = f2bf(a[e] * wt);
        }
    }
#pragma unroll
    for (int i = 0; i < 4; ++i) {
        const int task = tid + 512 * i, tl = task & 63, ce = task >> 6;
        const u32x4 vv = *(const u32x4*)(P + (size_t)(r0 + tl) * PP + PC_MV + h * 256 + ce * 8);
        LAS bf16_t* vp = VT + (ce * 8) * 72 + tl;
        vp[0 * 72] = (bf16_t)(vv.x & 0xffff); vp[1 * 72] = (bf16_t)(vv.x >> 16); vp[2 * 72] = (bf16_t)(vv.y & 0xffff); vp[3 * 72] = (bf16_t)(vv.y >> 16);
        vp[4 * 72] = (bf16_t)(vv.z & 0xffff); vp[5 * 72] = (bf16_t)(vv.z >> 16); vp[6 * 72] = (bf16_t)(vv.w & 0xffff); vp[7 * 72] = (bf16_t)(vv.w >> 16);
    }
    __syncthreads();
    const int fr = lane & 15, fq = lane >> 4;
    float* Cit = Cbuf + (size_t)item * 257 * 128;
#pragma unroll
    for (int et2 = 0; et2 < 2; ++et2) {
        const int et = 2 * wave + et2;
        const bf16x8 a0 = *(const LAS bf16x8*)(VT + (et * 16 + fr) * 72 + 8 * fq), a1 = *(const LAS bf16x8*)(VT + (et * 16 + fr) * 72 + 32 + 8 * fq);
#pragma unroll
        for (int dt = 0; dt < 8; ++dt) {
            const bf16x8 b0 = *(const LAS bf16x8*)(KT + (dt * 16 + fr) * 72 + 8 * fq), b1 = *(const LAS bf16x8*)(KT + (dt * 16 + fr) * 72 + 32 + 8 * fq);
            f32x4 z = {0.f, 0.f, 0.f, 0.f};
            z = __builtin_amdgcn_mfma_f32_16x16x32_bf16(a0, b0, z, 0, 0, 0);
            z = __builtin_amdgcn_mfma_f32_16x16x32_bf16(a1, b1, z, 0, 0, 0);
#pragma unroll
            for (int r = 0; r < 4; ++r) Cit[(size_t)(et * 16 + 4 * fq + r) * 128 + dt * 16 + fr] = z[r];
        }
    }
    if (wave == 0) {
        const bf16x8 a0 = *(const LAS bf16x8*)(VT + (256 + fr) * 72 + 8 * fq), a1 = *(const LAS bf16x8*)(VT + (256 + fr) * 72 + 32 + 8 * fq);
#pragma unroll
        for (int dt = 0; dt < 8; ++dt) {
            const bf16x8 b0 = *(const LAS bf16x8*)(KT + (dt * 16 + fr) * 72 + 8 * fq), b1 = *(const LAS bf16x8*)(KT + (dt * 16 + fr) * 72 + 32 + 8 * fq);
            f32x4 z = {0.f, 0.f, 0.f, 0.f};
            z = __builtin_amdgcn_mfma_f32_16x16x32_bf16(a0, b0, z, 0, 0, 0);
            z = __builtin_amdgcn_mfma_f32_16x16x32_bf16(a1, b1, z, 0, 0, 0);
            if (fq == 0) Cit[(size_t)256 * 128 + dt * 16 + fr] = z[0];
        }
    }
    __syncthreads();
}

__device__ __forceinline__ void m2_scan(float* Cbuf, float* scal, int gtid, int gthreads) {
    constexpr int PER_BH = 257 * 32, TOTAL = 8 * PER_BH;
    constexpr size_t CSTRIDE = (size_t)257 * 128;
    for (int w = gtid; w < TOTAL; w += gthreads) {
        const int bh = w / PER_BH, rem = w % PER_BH, e = rem >> 5, d4 = (rem & 31) * 4;
        float* ptr = Cbuf + ((size_t)bh * 128 * 257 + e) * 128 + d4;
        const bool lead = (rem == 0);
        f32x4 C = {0.f, 0.f, 0.f, 0.f}; float m = -1e30f;
        for (int c0 = 0; c0 < 128; c0 += 8) {
            f32x4 cl[8]; float gm[8], bl[8];
#pragma unroll
            for (int u = 0; u < 8; ++u) { cl[u] = *(const f32x4*)(ptr + (size_t)(c0 + u) * CSTRIDE); gm[u] = scal[(bh * 128 + c0 + u) * 4]; bl[u] = scal[(bh * 128 + c0 + u) * 4 + 1]; }
#pragma unroll
            for (int u = 0; u < 8; ++u) {
                *(f32x4*)(ptr + (size_t)(c0 + u) * CSTRIDE) = C;
                if (lead) scal[(bh * 128 + c0 + u) * 4 + 2] = m;
                const float mn = fmaxf(bl[u] + m, gm[u]);
                const float a = expf(bl[u] + m - mn), s = expf(gm[u] - mn);
                C = C * a + cl[u] * s; m = mn;
            }
        }
    }
}

__device__ __forceinline__ void m3_item(int item, bf16_t* P, const bf16_t* QK, const float* gif, const float* b_ig, const float* b_fg, const float* Cbuf, const float* scal,
                                        const float* norm_g, LAS unsigned char* lds, int tid, int wave, int lane) {
    const int c = item & 127, h = (item >> 7) & 3, b = item >> 9;
    const int r0 = b * T_ + c * 64;
    LAS bf16_t* VT = (LAS bf16_t*)lds;
    LAS float* tb = (LAS float*)(lds + 36864);
    LAS float* red = tb + 256;
    if (wave == 0) {
        const int row = r0 + lane;
        const float fpre = gif[(size_t)row * 8 + 4 + h] + b_fg[h], ipre = gif[(size_t)row * 8 + h] + b_ig[h];
        float bc = log_sigmoid(fpre);
#pragma unroll
        for (int o = 1; o < 64; o <<= 1) { const float t = __shfl_up(bc, o); if (lane >= o) bc += t; }
        const float gs = ipre - bc;
        float mxs = gs;
#pragma unroll
        for (int o = 1; o < 64; o <<= 1) { const float t = __shfl_up(mxs, o); if (lane >= o) mxs = fmaxf(mxs, t); }
        const float m_in = scal[item * 4 + 2];
        const float alog = bc + m_in;
        const float mt = fmaxf(alog, bc + mxs);
        tb[lane] = bc; tb[64 + lane] = gs; tb[128 + lane] = mt; tb[192 + lane] = expf(alog - mt);
    }
#pragma unroll
    for (int i = 0; i < 4; ++i) {
        const int task = tid + 512 * i, tl = task & 63, ce = task >> 6;
        const u32x4 vv = *(const u32x4*)(P + (size_t)(r0 + tl) * PP + PC_MV + h * 256 + ce * 8);
        const int pos = (tl & 32) + kperm32(tl & 31);
        LAS bf16_t* vp = VT + (ce * 8) * 72 + pos;
        vp[0 * 72] = (bf16_t)(vv.x & 0xffff); vp[1 * 72] = (bf16_t)(vv.x >> 16); vp[2 * 72] = (bf16_t)(vv.y & 0xffff); vp[3 * 72] = (bf16_t)(vv.y >> 16);
        vp[4 * 72] = (bf16_t)(vv.z & 0xffff); vp[5 * 72] = (bf16_t)(vv.z >> 16); vp[6 * 72] = (bf16_t)(vv.w & 0xffff); vp[7 * 72] = (bf16_t)(vv.w >> 16);
    }
    __syncthreads();
    const int fr = lane & 15, fq = lane >> 4, tt = wave & 3, eh = wave >> 2;
    const int t = tt * 16 + fr;
    const bf16_t* qp = QK + (size_t)(r0 + t) * 1024 + h * 128 + 8 * fq;
    bf16x8 bq[4];
#pragma unroll
    for (int ks = 0; ks < 4; ++ks) bq[ks] = *(const bf16x8*)(qp + ks * 32);
    f32x4 sacc[4];
#pragma unroll
    for (int st = 0; st < 4; ++st) {
        const bf16_t* kp = QK + (size_t)(r0 + st * 16 + fr) * 1024 + 512 + h * 128 + 8 * fq;
        f32x4 z = {0.f, 0.f, 0.f, 0.f};
#pragma unroll
        for (int ks = 0; ks < 4; ++ks) z = __builtin_amdgcn_mfma_f32_16x16x32_bf16(*(const bf16x8*)(kp + ks * 32), bq[ks], z, 0, 0, 0);
        sacc[st] = z;
    }
    const float bc_t = tb[t], mt_t = tb[128 + t], inter_t = tb[192 + t];
    float dsum = 0.f;
#pragma unroll
    for (int st = 0; st < 4; ++st)
#pragma unroll
        for (int r = 0; r < 4; ++r) {
            const int s = st * 16 + 4 * fq + r;
            const float wgt = (s <= t) ? __expf(bc_t + tb[64 + s] - mt_t) : 0.f;
            const float qk = sacc[st][r] * wgt; sacc[st][r] = qk; dsum += qk;
        }
    dsum += __shfl_xor(dsum, 16); dsum += __shfl_xor(dsum, 32);
    bf16x8 bp[2];
    bp[0] = pack8(sacc[0], sacc[1]); bp[1] = pack8(sacc[2], sacc[3]);
    const float* Cin = Cbuf + (size_t)item * 257 * 128;
    f32x4 acc[8];
#pragma unroll
    for (int et = 0; et < 8; ++et) {
        const float* cp = Cin + (size_t)((eh * 8 + et) * 16 + fr) * 128 + 8 * fq;
        f32x4 z = {0.f, 0.f, 0.f, 0.f};
#pragma unroll
        for (int ks = 0; ks < 4; ++ks) { const f32x4 f0 = *(const f32x4*)(cp + ks * 32), f1 = *(const f32x4*)(cp + ks * 32 + 4); z = __builtin_amdgcn_mfma_f32_16x16x32_bf16(pack8(f0, f1), bq[ks], z, 0, 0, 0); }
        acc[et] = z;
    }
    float qn;
    {
        const float* np = Cin + (size_t)256 * 128 + 8 * fq;
        f32x4 z = {0.f, 0.f, 0.f, 0.f};
#pragma unroll
        for (int ks = 0; ks < 4; ++ks) { const f32x4 f0 = *(const f32x4*)(np + ks * 32), f1 = *(const f32x4*)(np + ks * 32 + 4); z = __builtin_amdgcn_mfma_f32_16x16x32_bf16(pack8(f0, f1), bq[ks], z, 0, 0, 0); }
        qn = z[0];
    }
#pragma unroll
    for (int et = 0; et < 8; ++et) {
        f32x4 z = acc[et] * inter_t;
#pragma unroll
        for (int g = 0; g < 2; ++g) z = __builtin_amdgcn_mfma_f32_16x16x32_bf16(*(const LAS bf16x8*)(VT + ((eh * 8 + et) * 16 + fr) * 72 + g * 32 + 8 * fq), bp[g], z, 0, 0, 0);
        acc[et] = z;
    }
    const float den = inter_t * qn + dsum;
    const float inv = 1.0f / fmaxf(fabsf(den), expf(-mt_t));
    float ss = 0.f;
#pragma unroll
    for (int et = 0; et < 8; ++et) { acc[et] = acc[et] * inv; ss += (acc[et][0] * acc[et][0] + acc[et][1] * acc[et][1]) + (acc[et][2] * acc[et][2] + acc[et][3] * acc[et][3]); }
    ss += __shfl_xor(ss, 16); ss += __shfl_xor(ss, 32);
    if (fq == 0) red[eh * 64 + t] = ss;
    __syncthreads();
    const float rstd = 1.0f / sqrtf((red[t] + red[64 + t]) * (1.0f / 256.0f) + EPS);
    bf16_t* prow = P + (size_t)(r0 + t) * PP;
#pragma unroll
    for (int et = 0; et < 8; ++et) {
        const int e0 = h * 256 + (eh * 8 + et) * 16 + 4 * fq;
        const f32x4 gn = *(const f32x4*)(norm_g + e0);
        const u32x2 mo = *(const u32x2*)(prow + PC_MO + e0);
        const f32x4 o = acc[et] * rstd * gn;
        u32x2 w; w.x = cvt_pk_bf16(o[0] * bflo(mo.x), o[1] * bfhi(mo.x)); w.y = cvt_pk_bf16(o[2] * bflo(mo.y), o[3] * bfhi(mo.y));
        *(u32x2*)(prow + PC_MV + e0) = w;
    }
    __syncthreads();
}


#define XB_TMO      128
#define XB_XCNT(j)  (256  + 64 * (j))
#define XB_XSUB(j)  (1280 + 64 * (j))
#define XB_XGEN(j)  (2304 + 64 * (j))
#define XB_TOP      3328
#define XB_TOPGEN   3392
#define XCD_BAR_WORDS 3456
#define XB_SPIN_CAP (1u << 20)
__device__ __forceinline__ unsigned xb_ld(unsigned* p)              { return __hip_atomic_load(p, __ATOMIC_RELAXED, __HIP_MEMORY_SCOPE_AGENT); }
__device__ __forceinline__ unsigned xb_add(unsigned* p, unsigned v) { return __hip_atomic_fetch_add(p, v, __ATOMIC_RELAXED, __HIP_MEMORY_SCOPE_AGENT); }
__device__ __forceinline__ unsigned xb_xcc_id() { return (unsigned)__builtin_amdgcn_s_getreg((3 << 11) | 20) & 0xFu; }
#define XB_SPIN(cond, bar) do { unsigned _sp = 0; while (cond) { __builtin_amdgcn_s_sleep(1); \
    if ((++_sp & 255u) == 0u) { if (xb_ld(&(bar)[XB_TMO])) break; if (_sp > XB_SPIN_CAP) { atomicAdd(&(bar)[XB_TMO], 1u); break; } } } } while (0)
struct XcdBarrier { unsigned* bar; unsigned x; volatile LAS unsigned* st; };
__device__ __forceinline__ XcdBarrier xcd_barrier_post(unsigned* bar, volatile LAS unsigned* st) {
    XcdBarrier b; b.bar = bar; b.x = xb_xcc_id(); b.st = st;
    if (threadIdx.x == 0) (void)xb_add(&bar[XB_XCNT(b.x)], 1u);
    return b;
}
__device__ __forceinline__ void xcd_barrier_complete(unsigned* bar, unsigned x, unsigned& nloc, unsigned& nx) {
    const unsigned G = gridDim.x * gridDim.y * gridDim.z;
    unsigned sum, cnt, mine, sp = 0u;
    for (;;) {
        sum = 0u; cnt = 0u; mine = 0u;
#pragma unroll
        for (unsigned j = 0; j < 16; ++j) { const unsigned c = xb_ld(&bar[XB_XCNT(j)]); sum += c; cnt += (c > 0u) ? 1u : 0u; mine = (j == x) ? c : mine; }
        if (sum == G) break;
        __builtin_amdgcn_s_sleep(1);
        if ((++sp & 255u) == 0u) { if (xb_ld(&bar[XB_TMO])) break; if (sp > XB_SPIN_CAP) { atomicAdd(&bar[XB_TMO], 1u); break; } }
    }
    nloc = mine > 0u ? mine : 1u; nx = cnt > 0u ? cnt : 1u;
}
__device__ __forceinline__ void xcd_barrier(const XcdBarrier& b) {
    asm volatile("s_waitcnt vmcnt(0)" ::: "memory");
    __syncthreads();
    if (threadIdx.x == 0) {
        unsigned* bar = b.bar;
        __builtin_amdgcn_s_waitcnt(0);
        unsigned nloc = b.st[0], nx = b.st[1];
        if (nloc == 0u) { xcd_barrier_complete(bar, b.x, nloc, nx); b.st[0] = nloc; b.st[1] = nx; }
        const unsigned old = xb_add(&bar[XB_XSUB(b.x)], 1u);
        const unsigned gen = old / nloc;
        if (old + 1u == (gen + 1u) * nloc) {
            __builtin_amdgcn_fence(__ATOMIC_RELEASE, "agent");
            asm volatile("s_waitcnt vmcnt(0)" ::: "memory");
            const unsigned og = xb_add(&bar[XB_TOP], 1u);
            const unsigned tg = og / nx;
            if (og + 1u == (tg + 1u) * nx) xb_add(&bar[XB_TOPGEN], 1u);
            else XB_SPIN(xb_ld(&bar[XB_TOPGEN]) == tg, bar);
            __builtin_amdgcn_fence(__ATOMIC_ACQUIRE, "agent");
            xb_add(&bar[XB_XGEN(b.x)], 1u);
            asm volatile("s_waitcnt vmcnt(0)" ::: "memory");
        } else {
            XB_SPIN(xb_ld(&bar[XB_XGEN(b.x)]) == gen, bar);
            __builtin_amdgcn_fence(__ATOMIC_ACQUIRE, "agent");
            asm volatile("s_waitcnt vmcnt(0)" ::: "memory");
        }
    }
    __syncthreads();
}

constexpr int N_PHASES = 15;
__global__ void __launch_bounds__(512, 2) fwd_kernel(Args a) {
    extern __shared__ __attribute__((aligned(16))) unsigned char lds_raw[];
    LAS unsigned char* lds = (LAS unsigned char*)lds_raw;
    const int tid = threadIdx.x, lane = tid & 63, wave = __builtin_amdgcn_readfirstlane(tid >> 6);
    const int G = gridDim.x;
    unsigned char* ws = a.ws;
    float* mod = (float*)(ws + WS_MOD); float* rope = (float*)(ws + WS_ROPE); float* gif = (float*)(ws + WS_GIF); float* scal = (float*)(ws + WS_SCAL);
    bf16_t* WinT = (bf16_t*)(ws + WS_WIN); bf16_t* WattT = (bf16_t*)(ws + WS_WATT); bf16_t* WmlT = (bf16_t*)(ws + WS_WML); bf16_t* WoutT = (bf16_t*)(ws + WS_WOUT);
    bf16_t* U = (bf16_t*)(ws + WS_U); bf16_t* QK = U;
    bf16_t* WfinT = (bf16_t*)(ws + WS_WFIN); bf16_t* WfoutT = (bf16_t*)(ws + WS_WFOUT); bf16_t* ACT = (bf16_t*)(ws + WS_ACT);
    bf16_t* P = (bf16_t*)(ws + WS_P); float* Cbuf = (float*)(ws + WS_CBUF);
    float* H = a.out;
    const int lo = a.ph_lo, hi = a.ph_hi;
    const int gw = blockIdx.x * 8 + wave, ngw = G * 8;
#define IN(k) (lo <= (k) && (k) < hi)
#if MK_MULTI
#define SEAM(k) do {} while (0)
#else
#define SEAM(k) do { if (IN(k) && IN((k) + 1)) { if ((k) == 0) { __threadfence(); cg::this_grid().sync(); } else xcd_barrier(xbar); } } while (0)
    volatile LAS unsigned* xst = (volatile LAS unsigned*)(lds + 131072);
    if (tid == 0) { xst[0] = 0u; xst[1] = 0u; }
    __syncthreads();
    const XcdBarrier xbar = xcd_barrier_post((unsigned*)(ws + WS_BAR), xst);
#endif
    if (IN(0)) {
        LAS float* scr = (LAS float*)(lds + wave * 16384);
        transpose_all<1>(a.f1_in, D_, 2 * DFF, 2 * DFF, WfinT, scr, gw, ngw, lane);
        transpose_all<0>(a.f1_out, DFF, D_, D_, WfoutT, scr, gw, ngw, lane);
        transpose_all<2>(a.w_in, D_, PROJ_OUT, PP, WinT, scr, gw, ngw, lane);
        transpose_all<0>(a.w_att, 1024, D_, D_, WattT, scr, gw, ngw, lane);
        transpose_all<0>(a.w_ml, 1024, D_, D_, WmlT, scr, gw, ngw, lane);
        transpose_all<0>(a.w_out, D_, D_, D_, WoutT, scr, gw, ngw, lane);
        for (int it = gw; it < 72 * 32; it += ngw) {
            const int cgp = it % 72, kc = it / 72, col = cgp * 256 + 4 * lane;
            f32x4 s0 = {0.f, 0.f, 0.f, 0.f}, s1 = {0.f, 0.f, 0.f, 0.f};
#pragma unroll 8
            for (int kk = 0; kk < 64; ++kk) {
                const int k = kc * 64 + kk;
                const float c0 = a.c[k], c1 = a.c[D_ + k];
                const float e0 = c0 * sigm(c0), e1 = c1 * sigm(c1);
                const f32x4 w4 = *(const f32x4*)(a.w_ada + (size_t)k * NMOD + col);
                s0 += w4 * e0; s1 += w4 * e1;
            }
            if (kc == 0) { const f32x4 bb = *(const f32x4*)(a.b_ada + col); s0 += bb; s1 += bb; }
#pragma unroll
            for (int e = 0; e < 4; ++e) { atomicAdd(mod + col + e, s0[e]); atomicAdd(mod + NMOD + col + e, s1[e]); }
        }
        for (int i = blockIdx.x * 512 + tid; i < M_ * 8; i += G * 512) {
            const int row = i >> 3, j = i & 7;
            const float invf = (j == 0) ? 1.0f : (j == 1) ? 0.19392274f : (j == 2) ? 0.03760603f : (j == 3) ? 0.0072926646f : (j == 4) ? 0.0014142136f : (j == 5) ? 0.0002742482f : (j == 6) ? 5.3182957e-05f : 1.0313385e-05f;
            const float ang = (float)a.pos[row] * invf;
            double f = (double)ang * 0.15915494309189535; f -= rint(f);
            rope[(size_t)row * 16 + j] = __builtin_amdgcn_cosf((float)f);
            rope[(size_t)row * 16 + 8 + j] = __builtin_amdgcn_sinf((float)f);
        }
        __syncthreads();
    }
    SEAM(0);
    if (IN(1)) norm_phase<false>(a.x, a.norm1_g, mod, 0, 2048, U, nullptr, nullptr, lds, tid, wave, lane);
    SEAM(1);
    if (IN(2)) { pg8::Gemm g{U, WfinT, M_, 2 * DFF, D_, D_}; pg8::StaticOrder S; S.init(M_, 2 * DFF, G, (int)blockIdx.x); EpiSwiglu E{ACT}; pg8::gemm_phase(lds, g, S, E); }
    SEAM(2);
    if (IN(3)) { pg8::Gemm g{ACT, WfoutT, M_, D_, DFF, DFF}; pg8::StaticOrder S; S.init(M_, D_, G, (int)blockIdx.x); EpiResid E{a.x, H, mod + 4096, 0.5f}; pg8::gemm_phase(lds, g, S, E); }
    SEAM(3);
    if (IN(4)) norm_phase<true>(H, a.norm2_g, mod, 6144, 8192, U, gif, a.w_in, lds, tid, wave, lane);
    SEAM(4);
    if (IN(5)) { pg8::Gemm g{U, WinT, M_, PP, D_, D_}; pg8::StaticOrder S; S.init(M_, PP, G, (int)blockIdx.x); EpiProj E{P, rope}; pg8::gemm_phase(lds, g, S, E); }
    SEAM(5);
    if (IN(6)) {
        for (int it = blockIdx.x; it < 256; it += G) attn_item(it, P, a.sinks, lds, tid, wave, lane);
        for (int it = blockIdx.x; it < 1024; it += G) m1_item(it, P, QK, gif, a.conv_w, a.conv_b, a.b_ig, a.b_fg, Cbuf, scal, lds, tid, wave, lane);
    }
    SEAM(6);
    if (IN(7)) m2_scan(Cbuf, scal, blockIdx.x * 512 + tid, G * 512);
    SEAM(7);
    if (IN(8)) for (int it = blockIdx.x; it < 1024; it += G) m3_item(it, P, QK, gif, a.b_ig, a.b_fg, Cbuf, scal, a.mnorm_g, lds, tid, wave, lane);
    SEAM(8);
    if (IN(9)) {
        { pg8::Gemm g{P + PC_Q, WattT, M_, D_, 1024, PP}; pg8::StaticOrder S; S.init(M_, D_, G, (int)blockIdx.x); EpiMerge E{P, 1}; pg8::gemm_phase(lds, g, S, E); }
        { pg8::Gemm g{P + PC_MV, WmlT, M_, D_, 1024, PP}; pg8::StaticOrder S; S.init(M_, D_, G, (int)blockIdx.x); EpiMerge E{P, 0}; pg8::gemm_phase(lds, g, S, E); }
    }
    SEAM(9);
    if (IN(10)) { pg8::Gemm g{P + PC_G, WoutT, M_, D_, D_, PP}; pg8::StaticOrder S; S.init(M_, D_, G, (int)blockIdx.x); EpiResid E{H, H, mod + 10240, 1.0f}; pg8::gemm_phase(lds, g, S, E); }
    SEAM(10);
    if (IN(11)) {
        LAS float* scr = (LAS float*)(lds + wave * 16384);
        transpose_all<1>(a.f2_in, D_, 2 * DFF, 2 * DFF, WfinT, scr, gw, ngw, lane);
        transpose_all<0>(a.f2_out, DFF, D_, D_, WfoutT, scr, gw, ngw, lane);
        norm_phase<false>(H, a.norm3_g, mod, 12288, 14336, U, nullptr, nullptr, lds, tid, wave, lane);
    }
    SEAM(11);
    if (IN(12)) { pg8::Gemm g{U, WfinT, M_, 2 * DFF, D_, D_}; pg8::StaticOrder S; S.init(M_, 2 * DFF, G, (int)blockIdx.x); EpiSwiglu E{ACT}; pg8::gemm_phase(lds, g, S, E); }
    SEAM(12);
    if (IN(13)) { pg8::Gemm g{ACT, WfoutT, M_, D_, DFF, DFF}; pg8::StaticOrder S; S.init(M_, D_, G, (int)blockIdx.x); EpiResid E{H, H, mod + 16384, 0.5f}; pg8::gemm_phase(lds, g, S, E); }
    SEAM(13);
    if (IN(14)) {
        for (int row = gw; row < M_; row += ngw) {
            f32x4* xr = (f32x4*)(H + (size_t)row * D_) + lane;
            f32x4 v[8]; float ss = 0.f;
#pragma unroll
            for (int j = 0; j < 8; ++j) { v[j] = xr[64 * j]; ss += (v[j][0] * v[j][0] + v[j][1] * v[j][1]) + (v[j][2] * v[j][2] + v[j][3] * v[j][3]); }
            const float rstd = 1.0f / sqrtf(wave_sum(ss) * (1.0f / D_) + EPS);
#pragma unroll
            for (int j = 0; j < 8; ++j) { const f32x4 g4 = *(const f32x4*)(a.final_g + 256 * j + 4 * lane); xr[64 * j] = (v[j] * rstd) * g4; }
        }
    }
#undef IN
#undef SEAM
}

extern "C" void kernel_launch(void* const* d_in, const int* in_sizes, int n_in, void* d_out, int out_size, void* d_ws, size_t ws_size, hipStream_t stream) {
    static int grid = 0;
    if (grid == 0) {
        if (n_in != 23 || out_size != M_ * D_ || ws_size < WS_END) { fprintf(stderr, "kernel_launch: unexpected shapes (n_in %d, out %d, ws %zu < %zu)\n", n_in, out_size, ws_size, (size_t)WS_END); grid = -1; return; }
        int dev = 0, cus = 0, per_cu = 0;
        (void)hipGetDevice(&dev);
        (void)hipDeviceGetAttribute(&cus, hipDeviceAttributeMultiprocessorCount, dev);
        (void)hipFuncSetAttribute((const void*)fwd_kernel, hipFuncAttributeMaxDynamicSharedMemorySize, LDS_BYTES);
        (void)hipOccupancyMaxActiveBlocksPerMultiprocessor(&per_cu, (const void*)fwd_kernel, 512, LDS_BYTES);
        if (per_cu < 1) per_cu = 1;
        (void)hipGetLastError();
        grid = cus * per_cu;
    }
    if (grid < 0) return;
    (void)hipMemsetAsync((char*)d_ws + WS_MOD, 0, CTL_ZERO_BYTES, stream);
    Args a{};
    a.x = (const float*)d_in[0]; a.c = (const float*)d_in[1]; a.pos = (const int*)d_in[2]; a.w_ada = (const float*)d_in[3]; a.b_ada = (const float*)d_in[4];
    a.norm1_g = (const float*)d_in[5]; a.f1_in = (const float*)d_in[6]; a.f1_out = (const float*)d_in[7]; a.norm2_g = (const float*)d_in[8]; a.w_in = (const float*)d_in[9];
    a.conv_w = (const float*)d_in[10]; a.conv_b = (const float*)d_in[11]; a.b_ig = (const float*)d_in[12]; a.b_fg = (const float*)d_in[13]; a.sinks = (const float*)d_in[14];
    a.mnorm_g = (const float*)d_in[15]; a.w_att = (const float*)d_in[16]; a.w_ml = (const float*)d_in[17]; a.w_out = (const float*)d_in[18]; a.norm3_g = (const float*)d_in[19];
    a.f2_in = (const float*)d_in[20]; a.f2_out = (const float*)d_in[21]; a.final_g = (const float*)d_in[22];
    a.out = (float*)d_out; a.ws = (unsigned char*)d_ws;
#if MK_MULTI
    for (int p = 0; p < N_PHASES; ++p) { a.ph_lo = p; a.ph_hi = p + 1; hipLaunchKernelGGL(fwd_kernel, dim3(grid), dim3(512), LDS_BYTES, stream, a); }
#else
    a.ph_lo = 0; a.ph_hi = N_PHASES;
    void* args[] = {&a};
    hipError_t e = hipLaunchCooperativeKernel((const void*)fwd_kernel, dim3(grid), dim3(512), args, LDS_BYTES, stream);
    if (e != hipSuccess) fprintf(stderr, "cooperative launch failed: %s (grid %d)\n", hipGetErrorString(e), grid);
#endif
}
```

```cpp
#include <hip/hip_runtime.h>
#include <hip/hip_cooperative_groups.h>
#include <cstdio>
#include <cstdint>
namespace cg = cooperative_groups;

#ifndef MK_MULTI
#define MK_MULTI 0
#endif

#define LAS __attribute__((address_space(3)))
typedef unsigned short bf16_t;
typedef short bf16x8 __attribute__((ext_vector_type(8)));
typedef float f32x4 __attribute__((ext_vector_type(4)));
typedef float f32x2 __attribute__((ext_vector_type(2)));
typedef unsigned u32x4 __attribute__((ext_vector_type(4)));
typedef unsigned u32x2 __attribute__((ext_vector_type(2)));

constexpr int M_ = 16384, D_ = 2048, T_ = 8192, DFF = 5632, NMOD = 18432, PROJ_OUT = 8456;
constexpr int PP = 8448;
constexpr int PC_Q = 0, PC_K = 1024, PC_V = 1152, PC_MQK = 1280, PC_MV = 2304, PC_MO = 3328, PC_G = 4352;
constexpr float EPS = 1e-6f;
constexpr size_t MiB = 1u << 20;
constexpr size_t WS_MOD = 0, MOD_BYTES = 2 * NMOD * 4, WS_BAR = 192 * 1024, CTL_ZERO_BYTES = 256 * 1024;
constexpr size_t WS_ROPE = 1 * MiB, WS_GIF = 2 * MiB, WS_SCAL = 2 * MiB + 512 * 1024;
constexpr size_t WS_WIN = 4 * MiB, WS_WATT = 37 * MiB, WS_WML = 41 * MiB, WS_WOUT = 45 * MiB;
constexpr size_t WS_U = 53 * MiB;
constexpr size_t WS_R = 117 * MiB;
constexpr size_t WS_WFIN = WS_R, WS_WFOUT = WS_R + 44 * MiB, WS_ACT = WS_R + 66 * MiB;
constexpr size_t WS_P = WS_R, WS_CBUF = WS_R + 264 * MiB;
constexpr size_t WS_END = WS_CBUF + (size_t)1024 * 257 * 128 * 4;
constexpr int LDS_BYTES = 147456;

namespace pg8 {
constexpr int BM = 256, BK = 64, HALF = 128, HTB = HALF * BK * 2, STAGE_BYTES = 8 * HTB, NXCD = 8, WGM = 8;
__host__ __device__ __forceinline__ int lds_byte(int r, int c) { const int st = (r >> 4) * 2 + (c >> 5), rr = r & 15, cc = c & 31, ob = rr * 64 + cc * 2; return st * 1024 + (ob ^ (((ob >> 9) & 1) << 5)); }
__host__ __device__ __forceinline__ void stage_rc(int b, int& R, int& C) { const int st = b / 1024, sb = b % 1024, swz = sb ^ (((sb >> 9) & 1) << 5); R = (st >> 1) * 16 + swz / 64; C = (st & 1) * 32 + (swz % 64) / 2; }
__host__ __device__ __forceinline__ int perm32(int rho) { const int n = rho >> 4, i = rho & 15; return 8 * (i >> 2) + 4 * n + (i & 3); }
struct Unit { int pm, pn; };
struct Gemm { const bf16_t* A; const bf16_t* Bt; int M, N, K, lda; };
struct StaticOrder {
    int nM, nN, nwg, G, c;
    __host__ __device__ void init(int M, int N, int G_, int c_) { nM = M / BM; nN = N / BM; nwg = nM * nN; G = G_; c = c_; }
    __host__ __device__ bool next(int i, Unit& u) const {
        const long L = (long)i * G + c; if (L >= nwg) return false;
        int wgid = (int)L; { const int q = nwg / NXCD, r = nwg % NXCD, xcd = wgid % NXCD, off = wgid / NXCD; wgid = (xcd < r ? xcd * (q + 1) : r * (q + 1) + (xcd - r) * q) + off; }
        const int nig = WGM * nN, gid = wgid / nig, fm = gid * WGM, gsz = (nM - fm) < WGM ? (nM - fm) : WGM;
        u.pm = fm + ((wgid % nig) % gsz); u.pn = (wgid % nig) / gsz; return true;
    }
};
__device__ __forceinline__ unsigned cvt_pk_bf16(float lo, float hi) { unsigned r; asm volatile("v_cvt_pk_bf16_f32 %0, %1, %2" : "=v"(r) : "v"(lo), "v"(hi)); return r; }

template <class Epi>
__device__ __forceinline__ void gemm_phase(LAS unsigned char* lds, const Gemm g, const StaticOrder& S, const Epi& E) {
    const int tid = threadIdx.x, wid = __builtin_amdgcn_readfirstlane(tid >> 6), lane = tid & 63, wr = wid >> 2, wc = wid & 3, fr = lane & 15, fq = lane >> 4;
    const int K = g.K, nt = K / BK, lda = g.lda;
    unsigned voffA[2], voffB[2];
#pragma unroll
    for (int i = 0; i < 2; ++i) { int R, C; stage_rc(tid * 16 + i * 8192, R, C); const int Rb = (R & ~31) + perm32(R & 31);
        voffA[i] = (unsigned)(R * lda + C) * 2u; voffB[i] = (unsigned)(Rb * K + C) * 2u; }
    const size_t kstep = (size_t)(BK * 2);
    const size_t hstepA = (size_t)HALF * lda * 2, hstepB = (size_t)HALF * K * 2;
    const size_t tstepA = 2 * hstepA, tstepB = 2 * hstepB;
    const unsigned ldsw = (unsigned)wid * 1024u;
    const int aoff = lds_byte(wr * 64 + fr, fq * 8), boff = lds_byte(wc * 32 + fr, fq * 8);
#define PG8_SA(b, h) (((b) * 2 + (h)) * HTB)
#define PG8_SB(b, h) ((4 + (b) * 2 + (h)) * HTB)
#define PG8_STAGE(bufoff, gbase, voff) do { _Pragma("unroll") for (int _i = 0; _i < 2; ++_i) \
        __builtin_amdgcn_global_load_lds((const unsigned*)((const char*)(gbase) + (voff)[_i]), (LAS unsigned*)(lds + (bufoff) + ldsw + _i * 8192), 16, 0, 0); } while (0)
#define PG8_LDA(dst, b, h) do { _Pragma("unroll") for (int m = 0; m < 4; ++m) _Pragma("unroll") for (int k = 0; k < 2; ++k) dst[m][k] = *(const LAS bf16x8*)(lds + PG8_SA(b, h) + aoff + m * 2048 + k * 1024); } while (0)
#define PG8_LDB(dst, b, h) do { _Pragma("unroll") for (int n = 0; n < 2; ++n) _Pragma("unroll") for (int k = 0; k < 2; ++k) dst[n][k] = *(const LAS bf16x8*)(lds + PG8_SB(b, h) + boff + n * 2048 + k * 1024); } while (0)
#define PG8_MMA(ai, bj, At, Bt) do { __builtin_amdgcn_s_setprio(1); _Pragma("unroll") for (int m = 0; m < 4; ++m) _Pragma("unroll") for (int n = 0; n < 2; ++n) _Pragma("unroll") for (int k = 0; k < 2; ++k) \
        acc[ai][bj][m][n] = __builtin_amdgcn_mfma_f32_16x16x32_bf16(Bt[n][k], At[m][k], acc[ai][bj][m][n], 0, 0, 0); __builtin_amdgcn_s_setprio(0); } while (0)
#define PG8_WAIT_V(n) asm volatile("s_waitcnt vmcnt(" #n ")" ::: "memory")
#define PG8_WAIT_L(n) asm volatile("s_waitcnt lgkmcnt(" #n ")" ::: "memory")
#define PG8_BAR __builtin_amdgcn_s_barrier()
#define PG8_SCHED __builtin_amdgcn_sched_barrier(0)
    Unit cur, nxt; int ui = 0;
    if (!S.next(0, cur)) return;
    f32x4 acc[2][2][4][2];
#pragma unroll
    for (int a = 0; a < 2; ++a)
#pragma unroll
        for (int b = 0; b < 2; ++b)
#pragma unroll
            for (int m = 0; m < 4; ++m)
#pragma unroll
                for (int n = 0; n < 2; ++n) acc[a][b][m][n] = (f32x4){0.f, 0.f, 0.f, 0.f};
    bf16x8 At[4][2], B0[2][2], B1[2][2];
    const char* cA = (const char*)g.A + (size_t)cur.pm * tstepA; const char* cB = (const char*)g.Bt + (size_t)cur.pn * tstepB;
    PG8_STAGE(PG8_SB(0, 0), cB, voffB); PG8_STAGE(PG8_SB(0, 1), cB + hstepB, voffB); PG8_STAGE(PG8_SA(0, 0), cA, voffA); PG8_STAGE(PG8_SA(0, 1), cA + hstepA, voffA);
    if (wr == 1) PG8_BAR;
    PG8_WAIT_V(2); PG8_BAR;
    PG8_STAGE(PG8_SB(1, 0), cB + kstep, voffB); PG8_STAGE(PG8_SA(1, 0), cA + kstep, voffA); PG8_STAGE(PG8_SB(1, 1), cB + hstepB + kstep, voffB);
    PG8_WAIT_V(6); PG8_BAR;
    for (;;) {
        const bool has_next = S.next(ui + 1, nxt);
        const char* nA = has_next ? (const char*)g.A + (size_t)nxt.pm * tstepA : cA; const char* nB = has_next ? (const char*)g.Bt + (size_t)nxt.pn * tstepB : cB;
        for (int t = 0; t < nt; t += 2) {
            const bool last = (t == nt - 2);
            const char* a1 = cA + (size_t)(t + 1) * kstep;
            const char* a2 = last ? nA : cA + (size_t)(t + 2) * kstep; const char* b2 = last ? nB : cB + (size_t)(t + 2) * kstep;
            const char* a3 = a2 + kstep; const char* b3 = b2 + kstep;
            PG8_LDB(B0, 0, 0); PG8_LDB(B1, 0, 1); PG8_SCHED; PG8_LDA(At, 0, 0); PG8_STAGE(PG8_SA(1, 1), a1 + hstepA, voffA);
            PG8_WAIT_V(8); PG8_WAIT_L(0); PG8_BAR; PG8_MMA(0, 0, At, B0); PG8_MMA(0, 1, At, B1); PG8_BAR; PG8_SCHED;
            PG8_LDA(At, 0, 1); PG8_STAGE(PG8_SB(0, 0), b2, voffB); PG8_STAGE(PG8_SB(0, 1), b2 + hstepB, voffB); PG8_STAGE(PG8_SA(0, 0), a2, voffA);
            PG8_WAIT_V(8); PG8_WAIT_L(0); PG8_BAR; PG8_MMA(1, 0, At, B0); PG8_MMA(1, 1, At, B1); PG8_BAR; PG8_SCHED;
            PG8_LDB(B0, 1, 0); PG8_LDB(B1, 1, 1); PG8_SCHED; PG8_LDA(At, 1, 0); PG8_STAGE(PG8_SA(0, 1), a2 + hstepA, voffA);
            PG8_WAIT_V(8); PG8_WAIT_L(0); PG8_BAR; PG8_MMA(0, 0, At, B0); PG8_MMA(0, 1, At, B1); PG8_BAR; PG8_SCHED;
            PG8_LDA(At, 1, 1); PG8_STAGE(PG8_SB(1, 0), b3, voffB); PG8_STAGE(PG8_SB(1, 1), b3 + hstepB, voffB); PG8_STAGE(PG8_SA(1, 0), a3, voffA);
            PG8_WAIT_V(8); PG8_WAIT_L(0); PG8_BAR; PG8_MMA(1, 0, At, B0); PG8_MMA(1, 1, At, B1); PG8_BAR; PG8_SCHED;
        }
        if (wr == 0) PG8_BAR;
        E(acc, cur, wr, wc, fr, fq);
        if (!has_next) break;
#pragma unroll
        for (int a = 0; a < 2; ++a)
#pragma unroll
            for (int b = 0; b < 2; ++b)
#pragma unroll
                for (int m = 0; m < 4; ++m)
#pragma unroll
                    for (int n = 0; n < 2; ++n) acc[a][b][m][n] = (f32x4){0.f, 0.f, 0.f, 0.f};
        cur = nxt; cA = nA; cB = nB; ++ui;
        if (wr == 1) PG8_BAR;
    }
    PG8_WAIT_V(0);
    PG8_BAR;
#undef PG8_SA
#undef PG8_SB
#undef PG8_STAGE
#undef PG8_LDA
#undef PG8_LDB
#undef PG8_MMA
#undef PG8_WAIT_V
#undef PG8_WAIT_L
#undef PG8_BAR
#undef PG8_SCHED
}
}
using pg8::cvt_pk_bf16;
using pg8::Unit;

__device__ __forceinline__ float bf2f(unsigned short h) { return __uint_as_float((unsigned)h << 16); }
__device__ __forceinline__ float bflo(unsigned w) { return __uint_as_float(w << 16); }
__device__ __forceinline__ float bfhi(unsigned w) { return __uint_as_float(w & 0xffff0000u); }
__device__ __forceinline__ unsigned short f2bf(float f) { return (unsigned short)(cvt_pk_bf16(f, 0.f) & 0xffffu); }
__device__ __forceinline__ float sigm(float x) { return __builtin_amdgcn_rcpf(1.f + __expf(-x)); }
__device__ __forceinline__ float wave_sum(float v) {
#pragma unroll
    for (int o = 1; o < 64; o <<= 1) v += __shfl_xor(v, o);
    return v;
}
__device__ __forceinline__ float wave_max(float v) {
#pragma unroll
    for (int o = 1; o < 64; o <<= 1) v = fmaxf(v, __shfl_xor(v, o));
    return v;
}
__device__ __forceinline__ float log_sigmoid(float x) { return fminf(x, 0.f) - log1pf(expf(-fabsf(x))); }
__device__ __forceinline__ bf16x8 pack8(f32x4 a, f32x4 b) {
    u32x4 w; w.x = cvt_pk_bf16(a[0], a[1]); w.y = cvt_pk_bf16(a[2], a[3]); w.z = cvt_pk_bf16(b[0], b[1]); w.w = cvt_pk_bf16(b[2], b[3]);
    return __builtin_bit_cast(bf16x8, w);
}
__device__ __forceinline__ int kperm32(int kl) { return 8 * ((kl & 15) >> 2) + (kl & 3) + 4 * (kl >> 4); }

struct EpiSwiglu {
    bf16_t* O;
    __device__ __forceinline__ void operator()(const f32x4 (&acc)[2][2][4][2], const Unit& u, int wr, int wc, int fr, int fq) const {
        const int row0 = u.pm * 256 + wr * 64 + fr, col0 = u.pn * 128 + wc * 32 + 8 * fq;
#pragma unroll
        for (int ai = 0; ai < 2; ++ai)
#pragma unroll
            for (int m = 0; m < 4; ++m) {
                bf16_t* rowp = O + (size_t)(row0 + ai * 128 + m * 16) * DFF + col0;
                float v[8];
#pragma unroll
                for (int n = 0; n < 2; ++n)
#pragma unroll
                    for (int e = 0; e < 4; ++e) { const float a = acc[ai][0][m][n][e], b = acc[ai][1][m][n][e]; v[n * 4 + e] = a * sigm(a) * b; }
                u32x4 w; w.x = cvt_pk_bf16(v[0], v[1]); w.y = cvt_pk_bf16(v[2], v[3]); w.z = cvt_pk_bf16(v[4], v[5]); w.w = cvt_pk_bf16(v[6], v[7]);
                *(u32x4*)rowp = w;
            }
    }
};
struct EpiResid {
    const float* base; float* out; const float* gate; float scale;
    __device__ __forceinline__ void operator()(const f32x4 (&acc)[2][2][4][2], const Unit& u, int wr, int wc, int fr, int fq) const {
        const int row0 = u.pm * 256 + wr * 64 + fr, col0 = u.pn * 256 + wc * 32 + 8 * fq;
        const float* gp = gate + (size_t)(u.pm >> 5) * NMOD + col0;
        f32x4 gv[2][2];
#pragma unroll
        for (int bj = 0; bj < 2; ++bj)
#pragma unroll
            for (int n = 0; n < 2; ++n) gv[bj][n] = *(const f32x4*)(gp + bj * 128 + 4 * n) * scale;
#pragma unroll
        for (int ai = 0; ai < 2; ++ai)
#pragma unroll
            for (int m = 0; m < 4; ++m) {
                const size_t off = (size_t)(row0 + ai * 128 + m * 16) * D_ + col0;
#pragma unroll
                for (int bj = 0; bj < 2; ++bj)
#pragma unroll
                    for (int n = 0; n < 2; ++n) { const f32x4 bs = *(const f32x4*)(base + off + bj * 128 + 4 * n); *(f32x4*)(out + off + bj * 128 + 4 * n) = bs + gv[bj][n] * acc[ai][bj][m][n]; }
            }
    }
};
struct EpiProj {
    bf16_t* P; const float* rope;
    __device__ __forceinline__ void operator()(const f32x4 (&acc)[2][2][4][2], const Unit& u, int wr, int wc, int fr, int fq) const {
        const int row0 = u.pm * 256 + wr * 64 + fr, col0 = u.pn * 256 + wc * 32 + 8 * fq;
        const bool sig = u.pn >= 13;
        const bool ropelane = ((wc & 1) == 0) && (fq < 2) && (u.pn <= 4);
#pragma unroll
        for (int ai = 0; ai < 2; ++ai)
#pragma unroll
            for (int m = 0; m < 4; ++m) {
                const int row = row0 + ai * 128 + m * 16;
                f32x4 cs = {1.f, 1.f, 1.f, 1.f}, sn = {0.f, 0.f, 0.f, 0.f};
                if (ropelane) { cs = *(const f32x4*)(rope + (size_t)row * 16 + fq * 4); sn = *(const f32x4*)(rope + (size_t)row * 16 + 8 + fq * 4); }
#pragma unroll
                for (int bj = 0; bj < 2; ++bj) {
                    f32x4 v0 = acc[ai][bj][m][0], v1 = acc[ai][bj][m][1];
                    if (ropelane && (u.pn < 4 || bj == 0)) { const f32x4 x1 = v0, x2 = v1; v0 = x1 * cs - x2 * sn; v1 = x2 * cs + x1 * sn; }
                    if (sig) {
#pragma unroll
                        for (int e = 0; e < 4; ++e) { v0[e] = sigm(v0[e]); v1[e] = sigm(v1[e]); }
                    }
                    u32x4 w; w.x = cvt_pk_bf16(v0[0], v0[1]); w.y = cvt_pk_bf16(v0[2], v0[3]); w.z = cvt_pk_bf16(v1[0], v1[1]); w.w = cvt_pk_bf16(v1[2], v1[3]);
                    *(u32x4*)(P + (size_t)row * PP + col0 + bj * 128) = w;
                }
            }
    }
};
struct EpiMerge {
    bf16_t* P; int first;
    __device__ __forceinline__ void operator()(const f32x4 (&acc)[2][2][4][2], const Unit& u, int wr, int wc, int fr, int fq) const {
        const int row0 = u.pm * 256 + wr * 64 + fr, col0 = u.pn * 256 + wc * 32 + 8 * fq;
#pragma unroll
        for (int ai = 0; ai < 2; ++ai)
#pragma unroll
            for (int m = 0; m < 4; ++m)
#pragma unroll
                for (int bj = 0; bj < 2; ++bj) {
                    bf16_t* zp = P + (size_t)(row0 + ai * 128 + m * 16) * PP + PC_G + col0 + bj * 128;
                    const u32x4 z8 = *(const u32x4*)zp;
                    u32x4 g8 = z8; if (!first) g8 = *(const u32x4*)(zp + 2048);
                    const f32x4 a0 = acc[ai][bj][m][0], a1 = acc[ai][bj][m][1];
                    float o[8];
                    o[0] = bflo(g8.x) * a0[0]; o[1] = bfhi(g8.x) * a0[1]; o[2] = bflo(g8.y) * a0[2]; o[3] = bfhi(g8.y) * a0[3];
                    o[4] = bflo(g8.z) * a1[0]; o[5] = bfhi(g8.z) * a1[1]; o[6] = bflo(g8.w) * a1[2]; o[7] = bfhi(g8.w) * a1[3];
                    if (!first) { o[0] += bflo(z8.x); o[1] += bfhi(z8.x); o[2] += bflo(z8.y); o[3] += bfhi(z8.y); o[4] += bflo(z8.z); o[5] += bfhi(z8.z); o[6] += bflo(z8.w); o[7] += bfhi(z8.w); }
                    u32x4 w; w.x = cvt_pk_bf16(o[0], o[1]); w.y = cvt_pk_bf16(o[2], o[3]); w.z = cvt_pk_bf16(o[4], o[5]); w.w = cvt_pk_bf16(o[6], o[7]);
                    *(u32x4*)zp = w;
                }
    }
};

struct Args {
    const float* x; const float* c; const int* pos; const float* w_ada; const float* b_ada; const float* norm1_g;
    const float* f1_in; const float* f1_out; const float* norm2_g; const float* w_in; const float* conv_w; const float* conv_b;
    const float* b_ig; const float* b_fg; const float* sinks; const float* mnorm_g; const float* w_att; const float* w_ml;
    const float* w_out; const float* norm3_g; const float* f2_in; const float* f2_out; const float* final_g;
    float* out; unsigned char* ws; int ph_lo, ph_hi;
};

template <int KIND> __device__ __forceinline__ int srccol(int n) {
    if (KIND == 0) return n;
    if (KIND == 1) { const int pn = n >> 8, bj = (n >> 7) & 1, i = n & 127; return bj * DFF + pn * 128 + i; }
    if (n < PC_V) { const int d = n & 63; if (d < 16) { const int g = d >> 2; const int dd = (g == 1) ? d + 4 : (g == 2) ? d - 4 : d; return (n & ~63) + dd; } return n; }
    if (n < PC_MO) return n;
    return n + 8;
}
template <int KIND> __device__ __forceinline__ void transpose_item(const float* W, int K, int N, bf16_t* WT, LAS float* scr, int item, int lane, int nblk) {
    const int kb = item / nblk, nb = item % nblk, k0 = 64 * kb, n0 = 32 * nb;
    const int sc = srccol<KIND>(n0 + (lane & 31));
#pragma unroll 8
    for (int i = 0; i < 32; ++i) { const int kk = 2 * i + (lane >> 5); scr[kk * 33 + (lane & 31)] = W[(size_t)(k0 + kk) * N + sc]; }
    asm volatile("s_waitcnt lgkmcnt(0)" ::: "memory");
    const int c = lane & 7;
#pragma unroll
    for (int j = 0; j < 4; ++j) { const int n = (lane >> 3) + 8 * j; const LAS float* s = scr + (8 * c) * 33 + n;
        u32x4 o; o.x = cvt_pk_bf16(s[0 * 33], s[1 * 33]); o.y = cvt_pk_bf16(s[2 * 33], s[3 * 33]); o.z = cvt_pk_bf16(s[4 * 33], s[5 * 33]); o.w = cvt_pk_bf16(s[6 * 33], s[7 * 33]);
        *(u32x4*)(WT + (size_t)(n0 + n) * K + k0 + 8 * c) = o; }
    asm volatile("s_waitcnt lgkmcnt(0)" ::: "memory");
}
template <int KIND> __device__ __forceinline__ void transpose_all(const float* W, int K, int N, int Nout, bf16_t* WT, LAS float* scr, int gw, int ngw, int lane) {
    const int nblk = Nout / 32, items = (K / 64) * nblk;
    for (int it = gw; it < items; it += ngw) transpose_item<KIND>(W, K, N, WT, scr, it, lane, nblk);
}

template <bool GATES> __device__ __forceinline__ void norm_phase(const float* hin, const float* g, const float* mod, int sh_off, int sc_off, bf16_t* uout,
                                                                 float* gif, const float* w_in, LAS unsigned char* lds, int tid, int wave, int lane) {
    LAS float* wgT = (LAS float*)lds;
    if (GATES) {
        for (int idx = tid; idx < 2048 * 8; idx += 512) { const int k = idx >> 3, j = idx & 7; wgT[j * 2048 + k] = w_in[(size_t)k * PROJ_OUT + 3328 + j]; }
        __syncthreads();
    }
    const int gw = blockIdx.x * 8 + wave, ngw = gridDim.x * 8;
    for (int row = gw; row < M_; row += ngw) {
        const int b = row >> 13;
        const f32x4* xr = (const f32x4*)(hin + (size_t)row * D_) + lane;
        f32x4 v[8]; float ss = 0.f;
#pragma unroll
        for (int j = 0; j < 8; ++j) { v[j] = xr[64 * j]; ss += (v[j][0] * v[j][0] + v[j][1] * v[j][1]) + (v[j][2] * v[j][2] + v[j][3] * v[j][3]); }
        const float rstd = 1.0f / sqrtf(wave_sum(ss) * (1.0f / D_) + EPS);
        float ga[8];
#pragma unroll
        for (int i = 0; i < 8; ++i) ga[i] = 0.f;
#pragma unroll
        for (int j = 0; j < 8; ++j) {
            const int col = 256 * j + 4 * lane;
            const f32x4 g4 = *(const f32x4*)(g + col), sc4 = *(const f32x4*)(mod + (size_t)b * NMOD + sc_off + col), sh4 = *(const f32x4*)(mod + (size_t)b * NMOD + sh_off + col);
            const f32x4 y = (v[j] * rstd) * g4 * (sc4 + 1.0f) + sh4;
            u32x2 w; w.x = cvt_pk_bf16(y[0], y[1]); w.y = cvt_pk_bf16(y[2], y[3]);
            *(u32x2*)(uout + (size_t)row * D_ + col) = w;
            if (GATES) {
#pragma unroll
                for (int i = 0; i < 8; ++i) { const f32x4 w4 = *(const LAS f32x4*)(wgT + i * 2048 + col); ga[i] += (y[0] * w4[0] + y[1] * w4[1]) + (y[2] * w4[2] + y[3] * w4[3]); }
            }
        }
        if (GATES) {
#pragma unroll
            for (int i = 0; i < 8; ++i) ga[i] = wave_sum(ga[i]);
            if (lane == 0) { *(f32x4*)(gif + (size_t)row * 8) = (f32x4){ga[0], ga[1], ga[2], ga[3]}; *(f32x4*)(gif + (size_t)row * 8 + 4) = (f32x4){ga[4], ga[5], ga[6], ga[7]}; }
        }
    }
    if (GATES) __syncthreads();
}

__device__ __forceinline__ void attn_item(int item, bf16_t* P, const float* sinks, LAS unsigned char* lds, int tid, int wave, int lane) {
    const int kvh = item & 1, nb = (item >> 1) & 63, b = item >> 7;
    const int r0 = b * T_ + nb * 128;
    LAS bf16_t* Ksh = (LAS bf16_t*)lds;
    LAS bf16_t* VT = (LAS bf16_t*)(lds + 36864);
#pragma unroll
    for (int i = 0; i < 4; ++i) {
        const int chunk = tid + 512 * i, key = chunk >> 3, c8 = chunk & 7;
        const bool valid = (nb > 0) || (key >= 128);
        u32x4 kv = {0u, 0u, 0u, 0u}, vv = {0u, 0u, 0u, 0u};
        if (valid) { const bf16_t* rp = P + (size_t)(r0 - 128 + key) * PP; kv = *(const u32x4*)(rp + PC_K + kvh * 64 + c8 * 8); vv = *(const u32x4*)(rp + PC_V + kvh * 64 + c8 * 8); }
        *(LAS u32x4*)(Ksh + key * 72 + c8 * 8) = kv;
        const int pos = (key & ~31) + kperm32(key & 31);
        LAS bf16_t* vp = VT + (c8 * 8) * 264 + pos;
        vp[0 * 264] = (bf16_t)(vv.x & 0xffff); vp[1 * 264] = (bf16_t)(vv.x >> 16); vp[2 * 264] = (bf16_t)(vv.y & 0xffff); vp[3 * 264] = (bf16_t)(vv.y >> 16);
        vp[4 * 264] = (bf16_t)(vv.z & 0xffff); vp[5 * 264] = (bf16_t)(vv.z >> 16); vp[6 * 264] = (bf16_t)(vv.w & 0xffff); vp[7 * 264] = (bf16_t)(vv.w >> 16);
    }
    __syncthreads();
    const int h = kvh * 8 + wave, fr = lane & 15, fq = lane >> 4;
    const float sink = sinks[h];
    for (int qg = 0; qg < 8; ++qg) {
        const int qrow = r0 + qg * 16 + fr;
        bf16_t* qp = P + (size_t)qrow * PP + h * 64;
        const bf16x8 bq0 = *(const bf16x8*)(qp + 8 * fq), bq1 = *(const bf16x8*)(qp + 32 + 8 * fq);
        const int t0e = qg & ~1;
        f32x4 s[10];
#pragma unroll
        for (int tt = 0; tt < 10; ++tt) {
            const int t = min(t0e + tt, 15);
            const LAS bf16_t* kp = Ksh + (t * 16 + fr) * 72 + 8 * fq;
            const bf16x8 a0 = *(const LAS bf16x8*)kp, a1 = *(const LAS bf16x8*)(kp + 32);
            f32x4 z = {0.f, 0.f, 0.f, 0.f};
            z = __builtin_amdgcn_mfma_f32_16x16x32_bf16(a0, bq0, z, 0, 0, 0);
            s[tt] = __builtin_amdgcn_mfma_f32_16x16x32_bf16(a1, bq1, z, 0, 0, 0);
        }
        const int qi = 128 + qg * 16 + fr;
        float mx = -1e30f;
#pragma unroll
        for (int tt = 0; tt < 10; ++tt)
#pragma unroll
            for (int r = 0; r < 4; ++r) {
                const int kj = (t0e + tt) * 16 + 4 * fq + r;
                const bool ok = (kj <= qi) && (kj > qi - 128) && ((nb > 0) || (kj >= 128));
                const float sv = ok ? s[tt][r] * 0.125f : -1e30f;
                s[tt][r] = sv; mx = fmaxf(mx, sv);
            }
        mx = fmaxf(mx, __shfl_xor(mx, 16)); mx = fmaxf(mx, __shfl_xor(mx, 32)); mx = fmaxf(mx, sink);
        float sum = 0.f;
#pragma unroll
        for (int tt = 0; tt < 10; ++tt)
#pragma unroll
            for (int r = 0; r < 4; ++r) { const float p = __expf(s[tt][r] - mx); s[tt][r] = p; sum += p; }
        sum += __shfl_xor(sum, 16); sum += __shfl_xor(sum, 32);
        const float inv = 1.0f / (sum + __expf(sink - mx));
        bf16x8 bp[5];
#pragma unroll
        for (int g = 0; g < 5; ++g) bp[g] = pack8(s[2 * g], s[2 * g + 1]);
#pragma unroll
        for (int dt = 0; dt < 4; ++dt) {
            f32x4 o = {0.f, 0.f, 0.f, 0.f};
#pragma unroll
            for (int g = 0; g < 5; ++g) {
                const int grp = min((t0e >> 1) + g, 7);
                const bf16x8 a = *(const LAS bf16x8*)(VT + (dt * 16 + fr) * 264 + grp * 32 + 8 * fq);
                o = __builtin_amdgcn_mfma_f32_16x16x32_bf16(a, bp[g], o, 0, 0, 0);
            }
            u32x2 w; w.x = cvt_pk_bf16(o[0] * inv, o[1] * inv); w.y = cvt_pk_bf16(o[2] * inv, o[3] * inv);
            *(u32x2*)(qp + dt * 16 + 4 * fq) = w;
        }
    }
    __syncthreads();
}

__device__ __forceinline__ void m1_item(int item, const bf16_t* P, bf16_t* QK, const float* gif, const float* conv_w, const float* conv_b, const float* b_ig, const float* b_fg,
                                        float* Cbuf, float* scal, LAS unsigned char* lds, int tid, int wave, int lane) {
    const int c = item & 127, h = (item >> 7) & 3, b = item >> 9;
    const int r0 = b * T_ + c * 64;
    LAS bf16_t* VT = (LAS bf16_t*)lds;
    LAS bf16_t* KT = (LAS bf16_t*)(lds + 39168);
    LAS float* wl = (LAS float*)(lds + 57600);
    if (wave == 0) {
        const int row = r0 + lane;
        const float fpre = gif[(size_t)row * 8 + 4 + h] + b_fg[h], ipre = gif[(size_t)row * 8 + h] + b_ig[h];
        float bc = log_sigmoid(fpre);
#pragma unroll
        for (int o = 1; o < 64; o <<= 1) { const float t = __shfl_up(bc, o); if (lane >= o) bc += t; }
        const float blast = __shfl(bc, 63);
        const float gg = blast - bc + ipre;
        const float gmax = wave_max(gg);
        wl[lane] = expf(gg - gmax);
        if (lane == 0) { scal[item * 4 + 0] = gmax; scal[item * 4 + 1] = blast; }
    }
    for (int idx = tid; idx < 16 * 72; idx += 512) VT[256 * 72 + idx] = (idx < 64) ? (bf16_t)0x3F80 : (bf16_t)0;
    __syncthreads();
#pragma unroll
    for (int i = 0; i < 4; ++i) {
        const int task = tid + 512 * i, tl = task & 63, ch8 = task >> 6, qk = ch8 >> 4, j0 = (ch8 & 15) * 8;
        const int chan = qk * 512 + h * 128 + j0;
        float a[8];
        { const f32x4 b0 = *(const f32x4*)(conv_b + chan), b1 = *(const f32x4*)(conv_b + chan + 4); a[0] = b0[0]; a[1] = b0[1]; a[2] = b0[2]; a[3] = b0[3]; a[4] = b1[0]; a[5] = b1[1]; a[6] = b1[2]; a[7] = b1[3]; }
#pragma unroll
        for (int kk = 0; kk < 4; ++kk) {
            const int ts = c * 64 + tl - 3 + kk;
            if (ts >= 0) {
                const u32x4 x8 = *(const u32x4*)(P + (size_t)(b * T_ + ts) * PP + PC_MQK + chan);
                const f32x4 w0 = *(const f32x4*)(conv_w + kk * 1024 + chan), w1 = *(const f32x4*)(conv_w + kk * 1024 + chan + 4);
                a[0] += w0[0] * bflo(x8.x); a[1] += w0[1] * bfhi(x8.x); a[2] += w0[2] * bflo(x8.y); a[3] += w0[3] * bfhi(x8.y);
                a[4] += w1[0] * bflo(x8.z); a[5] += w1[1] * bfhi(x8.z); a[6] += w1[2] * bflo(x8.w); a[7] += w1[3] * bfhi(x8.w);
            }
        }
        const float ksc = qk ? 0.08838834764831845f : 1.0f;
#pragma unroll
        for (int e = 0; e < 8; ++e) a[e] = a[e] * sigm(a[e]) * ksc;
        u32x4 w; w.x = cvt_pk_bf16(a[0], a[1]); w.y = cvt_pk_bf16(a[2], a[3]); w.z = cvt_pk_bf16(a[4], a[5]); w.w = cvt_pk_bf16(a[6], a[7]);
        *(u32x4*)(QK + (size_t)(r0 + tl) * 1024 + chan) = w;
        if (qk) {
            const float wt = wl[tl];
#pragma unroll
            for (int e = 0; e < 8; ++e) KT[(j0 + e) * 72 + tl] = f2bf(a[e] * wt);
        }
    }
#pragma unroll
    for (int i = 0; i < 4; ++i) {
        const int task = tid + 512 * i, tl = task & 63, ce = task >> 6;
        const u32x4 vv = *(const u32x4*)(P + (size_t)(r0 + tl) * PP + PC_MV + h * 256 + ce * 8);
        LAS bf16_t* vp = VT + (ce * 8) * 72 + tl;
        vp[0 * 72] = (bf16_t)(vv.x & 0xffff); vp[1 * 72] = (bf16_t)(vv.x >> 16); vp[2 * 72] = (bf16_t)(vv.y & 0xffff); vp[3 * 72] = (bf16_t)(vv.y >> 16);
        vp[4 * 72] = (bf16_t)(vv.z & 0xffff); vp[5 * 72] = (bf16_t)(vv.z >> 16); vp[6 * 72] = (bf16_t)(vv.w & 0xffff); vp[7 * 72] = (bf16_t)(vv.w >> 16);
    }
    __syncthreads();
    const int fr = lane & 15, fq = lane >> 4;
    float* Cit = Cbuf + (size_t)item * 257 * 128;
#pragma unroll
    for (int et2 = 0; et2 < 2; ++et2) {
        const int et = 2 * wave + et2;
        const bf16x8 a0 = *(const LAS bf16x8*)(VT + (et * 16 + fr) * 72 + 8 * fq), a1 = *(const LAS bf16x8*)(VT + (et * 16 + fr) * 72 + 32 + 8 * fq);
#pragma unroll
        for (int dt = 0; dt < 8; ++dt) {
            const bf16x8 b0 = *(const LAS bf16x8*)(KT + (dt * 16 + fr) * 72 + 8 * fq), b1 = *(const LAS bf16x8*)(KT + (dt * 16 + fr) * 72 + 32 + 8 * fq);
            f32x4 z = {0.f, 0.f, 0.f, 0.f};
            z = __builtin_amdgcn_mfma_f32_16x16x32_bf16(a0, b0, z, 0, 0, 0);
            z = __builtin_amdgcn_mfma_f32_16x16x32_bf16(a1, b1, z, 0, 0, 0);
#pragma unroll
            for (int r = 0; r < 4; ++r) Cit[(size_t)(et * 16 + 4 * fq + r) * 128 + dt * 16 + fr] = z[r];
        }
    }
    if (wave == 0) {
        const bf16x8 a0 = *(const LAS bf16x8*)(VT + (256 + fr) * 72 + 8 * fq), a1 = *(const LAS bf16x8*)(VT + (256 + fr) * 72 + 32 + 8 * fq);
#pragma unroll
        for (int dt = 0; dt < 8; ++dt) {
            const bf16x8 b0 = *(const LAS bf16x8*)(KT + (dt * 16 + fr) * 72 + 8 * fq), b1 = *(const LAS bf16x8*)(KT + (dt * 16 + fr) * 72 + 32 + 8 * fq);
            f32x4 z = {0.f, 0.f, 0.f, 0.f};
            z = __builtin_amdgcn_mfma_f32_16x16x32_bf16(a0, b0, z, 0, 0, 0);
            z = __builtin_amdgcn_mfma_f32_16x16x32_bf16(a1, b1, z, 0, 0, 0);
            if (fq == 0) Cit[(size_t)256 * 128 + dt * 16 + fr] = z[0];
        }
    }
    __syncthreads();
}

__device__ __forceinline__ void m2_scan(float* Cbuf, float* scal, int gtid, int gthreads) {
    constexpr int PER_BH = 257 * 32, TOTAL = 8 * PER_BH;
    constexpr size_t CSTRIDE = (size_t)257 * 128;
    for (int w = gtid; w < TOTAL; w += gthreads) {
        const int bh = w / PER_BH, rem = w % PER_BH, e = rem >> 5, d4 = (rem & 31) * 4;
        float* ptr = Cbuf + ((size_t)bh * 128 * 257 + e) * 128 + d4;
        const bool lead = (rem == 0);
        f32x4 C = {0.f, 0.f, 0.f, 0.f}; float m = -1e30f;
        for (int c0 = 0; c0 < 128; c0 += 8) {
            f32x4 cl[8]; float gm[8], bl[8];
#pragma unroll
            for (int u = 0; u < 8; ++u) { cl[u] = *(const f32x4*)(ptr + (size_t)(c0 + u) * CSTRIDE); gm[u] = scal[(bh * 128 + c0 + u) * 4]; bl[u] = scal[(bh * 128 + c0 + u) * 4 + 1]; }
#pragma unroll
            for (int u = 0; u < 8; ++u) {
                *(f32x4*)(ptr + (size_t)(c0 + u) * CSTRIDE) = C;
                if (lead) scal[(bh * 128 + c0 + u) * 4 + 2] = m;
                const float mn = fmaxf(bl[u] + m, gm[u]);
                const float a = expf(bl[u] + m - mn), s = expf(gm[u] - mn);
                C = C * a + cl[u] * s; m = mn;
            }
        }
    }
}

__device__ __forceinline__ void m3_item(int item, bf16_t* P, const bf16_t* QK, const float* gif, const float* b_ig, const float* b_fg, const float* Cbuf, const float* scal,
                                        const float* norm_g, LAS unsigned char* lds, int tid, int wave, int lane) {
    const int c = item & 127, h = (item >> 7) & 3, b = item >> 9;
    const int r0 = b * T_ + c * 64;
    LAS bf16_t* VT = (LAS bf16_t*)lds;
    LAS float* tb = (LAS float*)(lds + 36864);
    LAS float* red = tb + 256;
    if (wave == 0) {
        const int row = r0 + lane;
        const float fpre = gif[(size_t)row * 8 + 4 + h] + b_fg[h], ipre = gif[(size_t)row * 8 + h] + b_ig[h];
        float bc = log_sigmoid(fpre);
#pragma unroll
        for (int o = 1; o < 64; o <<= 1) { const float t = __shfl_up(bc, o); if (lane >= o) bc += t; }
        const float gs = ipre - bc;
        float mxs = gs;
#pragma unroll
        for (int o = 1; o < 64; o <<= 1) { const float t = __shfl_up(mxs, o); if (lane >= o) mxs = fmaxf(mxs, t); }
        const float m_in = scal[item * 4 + 2];
        const float alog = bc + m_in;
        const float mt = fmaxf(alog, bc + mxs);
        tb[lane] = bc; tb[64 + lane] = gs; tb[128 + lane] = mt; tb[192 + lane] = expf(alog - mt);
    }
#pragma unroll
    for (int i = 0; i < 4; ++i) {
        const int task = tid + 512 * i, tl = task & 63, ce = task >> 6;
        const u32x4 vv = *(const u32x4*)(P + (size_t)(r0 + tl) * PP + PC_MV + h * 256 + ce * 8);
        const int pos = (tl & 32) + kperm32(tl & 31);
        LAS bf16_t* vp = VT + (ce * 8) * 72 + pos;
        vp[0 * 72] = (bf16_t)(vv.x & 0xffff); vp[1 * 72] = (bf16_t)(vv.x >> 16); vp[2 * 72] = (bf16_t)(vv.y & 0xffff); vp[3 * 72] = (bf16_t)(vv.y >> 16);
        vp[4 * 72] = (bf16_t)(vv.z & 0xffff); vp[5 * 72] = (bf16_t)(vv.z >> 16); vp[6 * 72] = (bf16_t)(vv.w & 0xffff); vp[7 * 72] = (bf16_t)(vv.w >> 16);
    }
    __syncthreads();
    const int fr = lane & 15, fq = lane >> 4, tt = wave & 3, eh = wave >> 2;
    const int t = tt * 16 + fr;
    const bf16_t* qp = QK + (size_t)(r0 + t) * 1024 + h * 128 + 8 * fq;
    bf16x8 bq[4];
#pragma unroll
    for (int ks = 0; ks < 4; ++ks) bq[ks] = *(const bf16x8*)(qp + ks * 32);
    f32x4 sacc[4];
#pragma unroll
    for (int st = 0; st < 4; ++st) {
        const bf16_t* kp = QK + (size_t)(r0 + st * 16 + fr) * 1024 + 512 + h * 128 + 8 * fq;
        f32x4 z = {0.f, 0.f, 0.f, 0.f};
#pragma unroll
        for (int ks = 0; ks < 4; ++ks) z = __builtin_amdgcn_mfma_f32_16x16x32_bf16(*(const bf16x8*)(kp + ks * 32), bq[ks], z, 0, 0, 0);
        sacc[st] = z;
    }
    const float bc_t = tb[t], mt_t = tb[128 + t], inter_t = tb[192 + t];
    float dsum = 0.f;
#pragma unroll
    for (int st = 0; st < 4; ++st)
#pragma unroll
        for (int r = 0; r < 4; ++r) {
            const int s = st * 16 + 4 * fq + r;
            const float wgt = (s <= t) ? __expf(bc_t + tb[64 + s] - mt_t) : 0.f;
            const float qk = sacc[st][r] * wgt; sacc[st][r] = qk; dsum += qk;
        }
    dsum += __shfl_xor(dsum, 16); dsum += __shfl_xor(dsum, 32);
    bf16x8 bp[2];
    bp[0] = pack8(sacc[0], sacc[1]); bp[1] = pack8(sacc[2], sacc[3]);
    const float* Cin = Cbuf + (size_t)item * 257 * 128;
    f32x4 acc[8];
#pragma unroll
    for (int et = 0; et < 8; ++et) {
        const float* cp = Cin + (size_t)((eh * 8 + et) * 16 + fr) * 128 + 8 * fq;
        f32x4 z = {0.f, 0.f, 0.f, 0.f};
#pragma unroll
        for (int ks = 0; ks < 4; ++ks) { const f32x4 f0 = *(const f32x4*)(cp + ks * 32), f1 = *(const f32x4*)(cp + ks * 32 + 4); z = __builtin_amdgcn_mfma_f32_16x16x32_bf16(pack8(f0, f1), bq[ks], z, 0, 0, 0); }
        acc[et] = z;
    }
    float qn;
    {
        const float* np = Cin + (size_t)256 * 128 + 8 * fq;
        f32x4 z = {0.f, 0.f, 0.f, 0.f};
#pragma unroll
        for (int ks = 0; ks < 4; ++ks) { const f32x4 f0 = *(const f32x4*)(np + ks * 32), f1 = *(const f32x4*)(np + ks * 32 + 4); z = __builtin_amdgcn_mfma_f32_16x16x32_bf16(pack8(f0, f1), bq[ks], z, 0, 0, 0); }
        qn = z[0];
    }
#pragma unroll
    for (int et = 0; et < 8; ++et) {
        f32x4 z = acc[et] * inter_t;
#pragma unroll
        for (int g = 0; g < 2; ++g) z = __builtin_amdgcn_mfma_f32_16x16x32_bf16(*(const LAS bf16x8*)(VT + ((eh * 8 + et) * 16 + fr) * 72 + g * 32 + 8 * fq), bp[g], z, 0, 0, 0);
        acc[et] = z;
    }
    const float den = inter_t * qn + dsum;
    const float inv = 1.0f / fmaxf(fabsf(den), expf(-mt_t));
    float ss = 0.f;
#pragma unroll
    for (int et = 0; et < 8; ++et) { acc[et] = acc[et] * inv; ss += (acc[et][0] * acc[et][0] + acc[et][1] * acc[et][1]) + (acc[et][2] * acc[et][2] + acc[et][3] * acc[et][3]); }
    ss += __shfl_xor(ss, 16); ss += __shfl_xor(ss, 32);
    if (fq == 0) red[eh * 64 + t] = ss;
    __syncthreads();
    const float rstd = 1.0f / sqrtf((red[t] + red[64 + t]) * (1.0f / 256.0f) + EPS);
    bf16_t* prow = P + (size_t)(r0 + t) * PP;
#pragma unroll
    for (int et = 0; et < 8; ++et) {
        const int e0 = h * 256 + (eh * 8 + et) * 16 + 4 * fq;
        const f32x4 gn = *(const f32x4*)(norm_g + e0);
        const u32x2 mo = *(const u32x2*)(prow + PC_MO + e0);
        const f32x4 o = acc[et] * rstd * gn;
        u32x2 w; w.x = cvt_pk_bf16(o[0] * bflo(mo.x), o[1] * bfhi(mo.x)); w.y = cvt_pk_bf16(o[2] * bflo(mo.y), o[3] * bfhi(mo.y));
        *(u32x2*)(prow + PC_MV + e0) = w;
    }
    __syncthreads();
}


#define XB_TMO      128
#define XB_XCNT(j)  (256  + 64 * (j))
#define XB_XSUB(j)  (1280 + 64 * (j))
#define XB_XGEN(j)  (2304 + 64 * (j))
#define XB_TOP      3328
#define XB_TOPGEN   3392
#define XCD_BAR_WORDS 3456
#define XB_SPIN_CAP (1u << 20)
__device__ __forceinline__ unsigned xb_ld(unsigned* p)              { return __hip_atomic_load(p, __ATOMIC_RELAXED, __HIP_MEMORY_SCOPE_AGENT); }
__device__ __forceinline__ unsigned xb_add(unsigned* p, unsigned v) { return __hip_atomic_fetch_add(p, v, __ATOMIC_RELAXED, __HIP_MEMORY_SCOPE_AGENT); }
__device__ __forceinline__ unsigned xb_xcc_id() { return (unsigned)__builtin_amdgcn_s_getreg((3 << 11) | 20) & 0xFu; }
#define XB_SPIN(cond, bar) do { unsigned _sp = 0; while (cond) { __builtin_amdgcn_s_sleep(1); \
    if ((++_sp & 255u) == 0u) { if (xb_ld(&(bar)[XB_TMO])) break; if (_sp > XB_SPIN_CAP) { atomicAdd(&(bar)[XB_TMO], 1u); break; } } } } while (0)
struct XcdBarrier { unsigned* bar; unsigned x; volatile LAS unsigned* st; };
__device__ __forceinline__ XcdBarrier xcd_barrier_post(unsigned* bar, volatile LAS unsigned* st) {
    XcdBarrier b; b.bar = bar; b.x = xb_xcc_id(); b.st = st;
    if (threadIdx.x == 0) (void)xb_add(&bar[XB_XCNT(b.x)], 1u);
    return b;
}
__device__ __forceinline__ void xcd_barrier_complete(unsigned* bar, unsigned x, unsigned& nloc, unsigned& nx) {
    const unsigned G = gridDim.x * gridDim.y * gridDim.z;
    unsigned sum, cnt, mine, sp = 0u;
    for (;;) {
        sum = 0u; cnt = 0u; mine = 0u;
#pragma unroll
        for (unsigned j = 0; j < 16; ++j) { const unsigned c = xb_ld(&bar[XB_XCNT(j)]); sum += c; cnt += (c > 0u) ? 1u : 0u; mine = (j == x) ? c : mine; }
        if (sum == G) break;
        __builtin_amdgcn_s_sleep(1);
        if ((++sp & 255u) == 0u) { if (xb_ld(&bar[XB_TMO])) break; if (sp > XB_SPIN_CAP) { atomicAdd(&bar[XB_TMO], 1u); break; } }
    }
    nloc = mine > 0u ? mine : 1u; nx = cnt > 0u ? cnt : 1u;
}
__device__ __forceinline__ void xcd_barrier(const XcdBarrier& b) {
    asm volatile("s_waitcnt vmcnt(0)" ::: "memory");
    __syncthreads();
    if (threadIdx.x == 0) {
        unsigned* bar = b.bar;
        __builtin_amdgcn_s_waitcnt(0);
        unsigned nloc = b.st[0], nx = b.st[1];
        if (nloc == 0u) { xcd_barrier_complete(bar, b.x, nloc, nx); b.st[0] = nloc; b.st[1] = nx; }
        const unsigned old = xb_add(&bar[XB_XSUB(b.x)], 1u);
        const unsigned gen = old / nloc;
        if (old + 1u == (gen + 1u) * nloc) {
            __builtin_amdgcn_fence(__ATOMIC_RELEASE, "agent");
            asm volatile("s_waitcnt vmcnt(0)" ::: "memory");
            const unsigned og = xb_add(&bar[XB_TOP], 1u);
            const unsigned tg = og / nx;
            if (og + 1u == (tg + 1u) * nx) xb_add(&bar[XB_TOPGEN], 1u);
            else XB_SPIN(xb_ld(&bar[XB_TOPGEN]) == tg, bar);
            __builtin_amdgcn_fence(__ATOMIC_ACQUIRE, "agent");
            xb_add(&bar[XB_XGEN(b.x)], 1u);
            asm volatile("s_waitcnt vmcnt(0)" ::: "memory");
        } else {
            XB_SPIN(xb_ld(&bar[XB_XGEN(b.x)]) == gen, bar);
            __builtin_amdgcn_fence(__ATOMIC_ACQUIRE, "agent");
            asm volatile("s_waitcnt vmcnt(0)" ::: "memory");
        }
    }
    __syncthreads();
}

constexpr int N_PHASES = 15;
__global__ void __launch_bounds__(512, 2) fwd_kernel(Args a) {
    extern __shared__ __attribute__((aligned(16))) unsigned char lds_raw[];
    LAS unsigned char* lds = (LAS unsigned char*)lds_raw;
    const int tid = threadIdx.x, lane = tid & 63, wave = __builtin_amdgcn_readfirstlane(tid >> 6);
    const int G = gridDim.x;
    unsigned char* ws = a.ws;
    float* mod = (float*)(ws + WS_MOD); float* rope = (float*)(ws + WS_ROPE); float* gif = (float*)(ws + WS_GIF); float* scal = (float*)(ws + WS_SCAL);
    bf16_t* WinT = (bf16_t*)(ws + WS_WIN); bf16_t* WattT = (bf16_t*)(ws + WS_WATT); bf16_t* WmlT = (bf16_t*)(ws + WS_WML); bf16_t* WoutT = (bf16_t*)(ws + WS_WOUT);
    bf16_t* U = (bf16_t*)(ws + WS_U); bf16_t* QK = U;
    bf16_t* WfinT = (bf16_t*)(ws + WS_WFIN); bf16_t* WfoutT = (bf16_t*)(ws + WS_WFOUT); bf16_t* ACT = (bf16_t*)(ws + WS_ACT);
    bf16_t* P = (bf16_t*)(ws + WS_P); float* Cbuf = (float*)(ws + WS_CBUF);
    float* H = a.out;
    const int lo = a.ph_lo, hi = a.ph_hi;
    const int gw = blockIdx.x * 8 + wave, ngw = G * 8;
#define IN(k) (lo <= (k) && (k) < hi)
#if MK_MULTI
#define SEAM(k) do {} while (0)
#else
#define SEAM(k) do { if (IN(k) && IN((k) + 1)) { xcd_barrier(xbar); } } while (0)
    volatile LAS unsigned* xst = (volatile LAS unsigned*)(lds + 131072);
    if (tid == 0) { xst[0] = 0u; xst[1] = 0u; }
    __syncthreads();
    const XcdBarrier xbar = xcd_barrier_post((unsigned*)(ws + WS_BAR), xst);
    if (lo == 0) cg::this_grid().sync();
#endif
    if (IN(0)) {
        LAS float* scr = (LAS float*)(lds + wave * 16384);
        transpose_all<1>(a.f1_in, D_, 2 * DFF, 2 * DFF, WfinT, scr, gw, ngw, lane);
        transpose_all<0>(a.f1_out, DFF, D_, D_, WfoutT, scr, gw, ngw, lane);
        transpose_all<2>(a.w_in, D_, PROJ_OUT, PP, WinT, scr, gw, ngw, lane);
        transpose_all<0>(a.w_att, 1024, D_, D_, WattT, scr, gw, ngw, lane);
        transpose_all<0>(a.w_ml, 1024, D_, D_, WmlT, scr, gw, ngw, lane);
        transpose_all<0>(a.w_out, D_, D_, D_, WoutT, scr, gw, ngw, lane);
        for (int it = gw; it < 72 * 32; it += ngw) {
            const int cgp = it % 72, kc = it / 72, col = cgp * 256 + 4 * lane;
            f32x4 s0 = {0.f, 0.f, 0.f, 0.f}, s1 = {0.f, 0.f, 0.f, 0.f};
#pragma unroll 8
            for (int kk = 0; kk < 64; ++kk) {
                const int k = kc * 64 + kk;
                const float c0 = a.c[k], c1 = a.c[D_ + k];
                const float e0 = c0 * sigm(c0), e1 = c1 * sigm(c1);
                const f32x4 w4 = *(const f32x4*)(a.w_ada + (size_t)k * NMOD + col);
                s0 += w4 * e0; s1 += w4 * e1;
            }
            if (kc == 0) { const f32x4 bb = *(const f32x4*)(a.b_ada + col); s0 += bb; s1 += bb; }
#pragma unroll
            for (int e = 0; e < 4; ++e) { atomicAdd(mod + col + e, s0[e]); atomicAdd(mod + NMOD + col + e, s1[e]); }
        }
        for (int i = blockIdx.x * 512 + tid; i < M_ * 8; i += G * 512) {
            const int row = i >> 3, j = i & 7;
            const float invf = (j == 0) ? 1.0f : (j == 1) ? 0.19392274f : (j == 2) ? 0.03760603f : (j == 3) ? 0.0072926646f : (j == 4) ? 0.0014142136f : (j == 5) ? 0.0002742482f : (j == 6) ? 5.3182957e-05f : 1.0313385e-05f;
            const float ang = (float)a.pos[row] * invf;
            double f = (double)ang * 0.15915494309189535; f -= rint(f);
            rope[(size_t)row * 16 + j] = __builtin_amdgcn_cosf((float)f);
            rope[(size_t)row * 16 + 8 + j] = __builtin_amdgcn_sinf((float)f);
        }
        __syncthreads();
    }
    SEAM(0);
    if (IN(1)) norm_phase<false>(a.x, a.norm1_g, mod, 0, 2048, U, nullptr, nullptr, lds, tid, wave, lane);
    SEAM(1);
    if (IN(2)) { pg8::Gemm g{U, WfinT, M_, 2 * DFF, D_, D_}; pg8::StaticOrder S; S.init(M_, 2 * DFF, G, (int)blockIdx.x); EpiSwiglu E{ACT}; pg8::gemm_phase(lds, g, S, E); }
    SEAM(2);
    if (IN(3)) { pg8::Gemm g{ACT, WfoutT, M_, D_, DFF, DFF}; pg8::StaticOrder S; S.init(M_, D_, G, (int)blockIdx.x); EpiResid E{a.x, H, mod + 4096, 0.5f}; pg8::gemm_phase(lds, g, S, E); }
    SEAM(3);
    if (IN(4)) norm_phase<true>(H, a.norm2_g, mod, 6144, 8192, U, gif, a.w_in, lds, tid, wave, lane);
    SEAM(4);
    if (IN(5)) { pg8::Gemm g{U, WinT, M_, PP, D_, D_}; pg8::StaticOrder S; S.init(M_, PP, G, (int)blockIdx.x); EpiProj E{P, rope}; pg8::gemm_phase(lds, g, S, E); }
    SEAM(5);
    if (IN(6)) {
        for (int it = blockIdx.x; it < 256; it += G) attn_item(it, P, a.sinks, lds, tid, wave, lane);
        for (int it = blockIdx.x; it < 1024; it += G) m1_item(it, P, QK, gif, a.conv_w, a.conv_b, a.b_ig, a.b_fg, Cbuf, scal, lds, tid, wave, lane);
    }
    SEAM(6);
    if (IN(7)) m2_scan(Cbuf, scal, blockIdx.x * 512 + tid, G * 512);
    SEAM(7);
    if (IN(8)) for (int it = blockIdx.x; it < 1024; it += G) m3_item(it, P, QK, gif, a.b_ig, a.b_fg, Cbuf, scal, a.mnorm_g, lds, tid, wave, lane);
    SEAM(8);
    if (IN(9)) {
        { pg8::Gemm g{P + PC_Q, WattT, M_, D_, 1024, PP}; pg8::StaticOrder S; S.init(M_, D_, G, (int)blockIdx.x); EpiMerge E{P, 1}; pg8::gemm_phase(lds, g, S, E); }
        { pg8::Gemm g{P + PC_MV, WmlT, M_, D_, 1024, PP}; pg8::StaticOrder S; S.init(M_, D_, G, (int)blockIdx.x); EpiMerge E{P, 0}; pg8::gemm_phase(lds, g, S, E); }
    }
    SEAM(9);
    if (IN(10)) { pg8::Gemm g{P + PC_G, WoutT, M_, D_, D_, PP}; pg8::StaticOrder S; S.init(M_, D_, G, (int)blockIdx.x); EpiResid E{H, H, mod + 10240, 1.0f}; pg8::gemm_phase(lds, g, S, E); }
    SEAM(10);
    if (IN(11)) {
        LAS float* scr = (LAS float*)(lds + wave * 16384);
        transpose_all<1>(a.f2_in, D_, 2 * DFF, 2 * DFF, WfinT, scr, gw, ngw, lane);
        transpose_all<0>(a.f2_out, DFF, D_, D_, WfoutT, scr, gw, ngw, lane);
        norm_phase<false>(H, a.norm3_g, mod, 12288, 14336, U, nullptr, nullptr, lds, tid, wave, lane);
    }
    SEAM(11);
    if (IN(12)) { pg8::Gemm g{U, WfinT, M_, 2 * DFF, D_, D_}; pg8::StaticOrder S; S.init(M_, 2 * DFF, G, (int)blockIdx.x); EpiSwiglu E{ACT}; pg8::gemm_phase(lds, g, S, E); }
    SEAM(12);
    if (IN(13)) { pg8::Gemm g{ACT, WfoutT, M_, D_, DFF, DFF}; pg8::StaticOrder S; S.init(M_, D_, G, (int)blockIdx.x); EpiResid E{H, H, mod + 16384, 0.5f}; pg8::gemm_phase(lds, g, S, E); }
    SEAM(13);
    if (IN(14)) {
        for (int row = gw; row < M_; row += ngw) {
            f32x4* xr = (f32x4*)(H + (size_t)row * D_) + lane;
            f32x4 v[8]; float ss = 0.f;
#pragma unroll
            for (int j = 0; j < 8; ++j) { v[j] = xr[64 * j]; ss += (v[j][0] * v[j][0] + v[j][1] * v[j][1]) + (v[j][2] * v[j][2] + v[j][3] * v[j][3]); }
            const float rstd = 1.0f / sqrtf(wave_sum(ss) * (1.0f / D_) + EPS);
#pragma unroll
            for (int j = 0; j < 8; ++j) { const f32x4 g4 = *(const f32x4*)(a.final_g + 256 * j + 4 * lane); xr[64 * j] = (v[j] * rstd) * g4; }
        }
    }
#undef IN
#undef SEAM
}

extern "C" void kernel_launch(void* const* d_in, const int* in_sizes, int n_in, void* d_out, int out_size, void* d_ws, size_t ws_size, hipStream_t stream) {
    static int grid = 0;
    if (grid == 0) {
        if (n_in != 23 || out_size != M_ * D_ || ws_size < WS_END) { fprintf(stderr, "kernel_launch: unexpected shapes (n_in %d, out %d, ws %zu < %zu)\n", n_in, out_size, ws_size, (size_t)WS_END); grid = -1; return; }
        int dev = 0, cus = 0, per_cu = 0;
        (void)hipGetDevice(&dev);
        (void)hipDeviceGetAttribute(&cus, hipDeviceAttributeMultiprocessorCount, dev);
        (void)hipFuncSetAttribute((const void*)fwd_kernel, hipFuncAttributeMaxDynamicSharedMemorySize, LDS_BYTES);
        (void)hipOccupancyMaxActiveBlocksPerMultiprocessor(&per_cu, (const void*)fwd_kernel, 512, LDS_BYTES);
        if (per_cu < 1) per_cu = 1;
        (void)hipGetLastError();
        grid = cus * per_cu;
    }
    if (grid < 0) return;
    (void)hipMemsetAsync((char*)d_ws + WS_MOD, 0, CTL_ZERO_BYTES, stream);
    Args a{};
    a.x = (const float*)d_in[0]; a.c = (const float*)d_in[1]; a.pos = (const int*)d_in[2]; a.w_ada = (const float*)d_in[3]; a.b_ada = (const float*)d_in[4];
    a.norm1_g = (const float*)d_in[5]; a.f1_in = (const float*)d_in[6]; a.f1_out = (const float*)d_in[7]; a.norm2_g = (const float*)d_in[8]; a.w_in = (const float*)d_in[9];
    a.conv_w = (const float*)d_in[10]; a.conv_b = (const float*)d_in[11]; a.b_ig = (const float*)d_in[12]; a.b_fg = (const float*)d_in[13]; a.sinks = (const float*)d_in[14];
    a.mnorm_g = (const float*)d_in[15]; a.w_att = (const float*)d_in[16]; a.w_ml = (const float*)d_in[17]; a.w_out = (const float*)d_in[18]; a.norm3_g = (const float*)d_in[19];
    a.f2_in = (const float*)d_in[20]; a.f2_out = (const float*)d_in[21]; a.final_g = (const float*)d_in[22];
    a.out = (float*)d_out; a.ws = (unsigned char*)d_ws;
#if MK_MULTI
    for (int p = 0; p < N_PHASES; ++p) { a.ph_lo = p; a.ph_hi = p + 1; hipLaunchKernelGGL(fwd_kernel, dim3(grid), dim3(512), LDS_BYTES, stream, a); }
#else
    a.ph_lo = 0; a.ph_hi = N_PHASES;
    void* args[] = {&a};
    hipError_t e = hipLaunchCooperativeKernel((const void*)fwd_kernel, dim3(grid), dim3(512), args, LDS_BYTES, stream);
    if (e != hipSuccess) fprintf(stderr, "cooperative launch failed: %s (grid %d)\n", hipGetErrorString(e), grid);
#endif
}
```

```cpp
#include <hip/hip_runtime.h>
#include <hip/hip_cooperative_groups.h>
#include <cstdio>
#include <cstdint>
namespace cg = cooperative_groups;

#ifndef MK_MULTI
#define MK_MULTI 0
#endif

#define LAS __attribute__((address_space(3)))
typedef unsigned short bf16_t;
typedef short bf16x8 __attribute__((ext_vector_type(8)));
typedef float f32x4 __attribute__((ext_vector_type(4)));
typedef float f32x2 __attribute__((ext_vector_type(2)));
typedef unsigned u32x4 __attribute__((ext_vector_type(4)));
typedef unsigned u32x2 __attribute__((ext_vector_type(2)));

constexpr int M_ = 16384, D_ = 2048, T_ = 8192, DFF = 5632, NMOD = 18432, PROJ_OUT = 8456;
constexpr int PP = 8448;
constexpr int PC_Q = 0, PC_K = 1024, PC_V = 1152, PC_MQK = 1280, PC_MV = 2304, PC_MO = 3328, PC_G = 4352;
constexpr float EPS = 1e-6f;
constexpr size_t MiB = 1u << 20;
constexpr size_t WS_MOD = 0, MOD_BYTES = 2 * NMOD * 4, WS_BAR = 192 * 1024, CTL_ZERO_BYTES = 256 * 1024;
constexpr size_t WS_ROPE = 1 * MiB, WS_GIF = 2 * MiB, WS_SCAL = 2 * MiB + 512 * 1024;
constexpr size_t WS_WIN = 4 * MiB, WS_WATT = 37 * MiB, WS_WML = 41 * MiB, WS_WOUT = 45 * MiB;
constexpr size_t WS_U = 53 * MiB;
constexpr size_t WS_R = 117 * MiB;
constexpr size_t WS_WFIN = WS_R, WS_WFOUT = WS_R + 44 * MiB, WS_ACT = WS_R + 66 * MiB;
constexpr size_t WS_P = WS_R, WS_CBUF = WS_R + 264 * MiB;
constexpr size_t WS_CIN = WS_CBUF + (size_t)1024 * 257 * 128 * 4;
constexpr size_t WS_END = WS_CIN + (size_t)1024 * 257 * 128 * 2;
constexpr int LDS_BYTES = 147456;

namespace pg8 {
constexpr int BM = 256, BK = 64, HALF = 128, HTB = HALF * BK * 2, STAGE_BYTES = 8 * HTB, NXCD = 8, WGM = 8;
__host__ __device__ __forceinline__ int lds_byte(int r, int c) { const int st = (r >> 4) * 2 + (c >> 5), rr = r & 15, cc = c & 31, ob = rr * 64 + cc * 2; return st * 1024 + (ob ^ (((ob >> 9) & 1) << 5)); }
__host__ __device__ __forceinline__ void stage_rc(int b, int& R, int& C) { const int st = b / 1024, sb = b % 1024, swz = sb ^ (((sb >> 9) & 1) << 5); R = (st >> 1) * 16 + swz / 64; C = (st & 1) * 32 + (swz % 64) / 2; }
__host__ __device__ __forceinline__ int perm32(int rho) { const int n = rho >> 4, i = rho & 15; return 8 * (i >> 2) + 4 * n + (i & 3); }
struct Unit { int pm, pn; };
struct Gemm { const bf16_t* A; const bf16_t* Bt; int M, N, K, lda; };
struct StaticOrder {
    int nM, nN, nwg, G, c;
    __host__ __device__ void init(int M, int N, int G_, int c_) { nM = M / BM; nN = N / BM; nwg = nM * nN; G = G_; c = c_; }
    __host__ __device__ bool next(int i, Unit& u) const {
        const long L = (long)i * G + c; if (L >= nwg) return false;
        int wgid = (int)L; { const int q = nwg / NXCD, r = nwg % NXCD, xcd = wgid % NXCD, off = wgid / NXCD; wgid = (xcd < r ? xcd * (q + 1) : r * (q + 1) + (xcd - r) * q) + off; }
        const int nig = WGM * nN, gid = wgid / nig, fm = gid * WGM, gsz = (nM - fm) < WGM ? (nM - fm) : WGM;
        u.pm = fm + ((wgid % nig) % gsz); u.pn = (wgid % nig) / gsz; return true;
    }
};
__device__ __forceinline__ unsigned cvt_pk_bf16(float lo, float hi) { unsigned r; asm volatile("v_cvt_pk_bf16_f32 %0, %1, %2" : "=v"(r) : "v"(lo), "v"(hi)); return r; }

template <class Epi>
__device__ __forceinline__ void gemm_phase(LAS unsigned char* lds, const Gemm g, const StaticOrder& S, const Epi& E) {
    const int tid = threadIdx.x, wid = __builtin_amdgcn_readfirstlane(tid >> 6), lane = tid & 63, wr = wid >> 2, wc = wid & 3, fr = lane & 15, fq = lane >> 4;
    const int K = g.K, nt = K / BK, lda = g.lda;
    unsigned voffA[2], voffB[2];
#pragma unroll
    for (int i = 0; i < 2; ++i) { int R, C; stage_rc(tid * 16 + i * 8192, R, C); const int Rb = (R & ~31) + perm32(R & 31);
        voffA[i] = (unsigned)(R * lda + C) * 2u; voffB[i] = (unsigned)(Rb * K + C) * 2u; }
    const size_t kstep = (size_t)(BK * 2);
    const size_t hstepA = (size_t)HALF * lda * 2, hstepB = (size_t)HALF * K * 2;
    const size_t tstepA = 2 * hstepA, tstepB = 2 * hstepB;
    const unsigned ldsw = (unsigned)wid * 1024u;
    const int aoff = lds_byte(wr * 64 + fr, fq * 8), boff = lds_byte(wc * 32 + fr, fq * 8);
#define PG8_SA(b, h) (((b) * 2 + (h)) * HTB)
#define PG8_SB(b, h) ((4 + (b) * 2 + (h)) * HTB)
#define PG8_STAGE(bufoff, gbase, voff) do { _Pragma("unroll") for (int _i = 0; _i < 2; ++_i) \
        __builtin_amdgcn_global_load_lds((const unsigned*)((const char*)(gbase) + (voff)[_i]), (LAS unsigned*)(lds + (bufoff) + ldsw + _i * 8192), 16, 0, 0); } while (0)
#define PG8_LDA(dst, b, h) do { _Pragma("unroll") for (int m = 0; m < 4; ++m) _Pragma("unroll") for (int k = 0; k < 2; ++k) dst[m][k] = *(const LAS bf16x8*)(lds + PG8_SA(b, h) + aoff + m * 2048 + k * 1024); } while (0)
#define PG8_LDB(dst, b, h) do { _Pragma("unroll") for (int n = 0; n < 2; ++n) _Pragma("unroll") for (int k = 0; k < 2; ++k) dst[n][k] = *(const LAS bf16x8*)(lds + PG8_SB(b, h) + boff + n * 2048 + k * 1024); } while (0)
#define PG8_MMA(ai, bj, At, Bt) do { __builtin_amdgcn_s_setprio(1); _Pragma("unroll") for (int m = 0; m < 4; ++m) _Pragma("unroll") for (int n = 0; n < 2; ++n) _Pragma("unroll") for (int k = 0; k < 2; ++k) \
        acc[ai][bj][m][n] = __builtin_amdgcn_mfma_f32_16x16x32_bf16(Bt[n][k], At[m][k], acc[ai][bj][m][n], 0, 0, 0); __builtin_amdgcn_s_setprio(0); } while (0)
#define PG8_WAIT_V(n) asm volatile("s_waitcnt vmcnt(" #n ")" ::: "memory")
#define PG8_WAIT_L(n) asm volatile("s_waitcnt lgkmcnt(" #n ")" ::: "memory")
#define PG8_BAR __builtin_amdgcn_s_barrier()
#define PG8_SCHED __builtin_amdgcn_sched_barrier(0)
    Unit cur, nxt; int ui = 0;
    if (!S.next(0, cur)) return;
    f32x4 acc[2][2][4][2];
#pragma unroll
    for (int a = 0; a < 2; ++a)
#pragma unroll
        for (int b = 0; b < 2; ++b)
#pragma unroll
            for (int m = 0; m < 4; ++m)
#pragma unroll
                for (int n = 0; n < 2; ++n) acc[a][b][m][n] = (f32x4){0.f, 0.f, 0.f, 0.f};
    bf16x8 At[4][2], B0[2][2], B1[2][2];
    const char* cA = (const char*)g.A + (size_t)cur.pm * tstepA; const char* cB = (const char*)g.Bt + (size_t)cur.pn * tstepB;
    PG8_STAGE(PG8_SB(0, 0), cB, voffB); PG8_STAGE(PG8_SB(0, 1), cB + hstepB, voffB); PG8_STAGE(PG8_SA(0, 0), cA, voffA); PG8_STAGE(PG8_SA(0, 1), cA + hstepA, voffA);
    if (wr == 1) PG8_BAR;
    PG8_WAIT_V(2); PG8_BAR;
    PG8_STAGE(PG8_SB(1, 0), cB + kstep, voffB); PG8_STAGE(PG8_SA(1, 0), cA + kstep, voffA); PG8_STAGE(PG8_SB(1, 1), cB + hstepB + kstep, voffB);
    PG8_WAIT_V(6); PG8_BAR;
    for (;;) {
        const bool has_next = S.next(ui + 1, nxt);
        const char* nA = has_next ? (const char*)g.A + (size_t)nxt.pm * tstepA : cA; const char* nB = has_next ? (const char*)g.Bt + (size_t)nxt.pn * tstepB : cB;
        for (int t = 0; t < nt; t += 2) {
            const bool last = (t == nt - 2);
            const char* a1 = cA + (size_t)(t + 1) * kstep;
            const char* a2 = last ? nA : cA + (size_t)(t + 2) * kstep; const char* b2 = last ? nB : cB + (size_t)(t + 2) * kstep;
            const char* a3 = a2 + kstep; const char* b3 = b2 + kstep;
            PG8_LDB(B0, 0, 0); PG8_LDB(B1, 0, 1); PG8_SCHED; PG8_LDA(At, 0, 0); PG8_STAGE(PG8_SA(1, 1), a1 + hstepA, voffA);
            PG8_WAIT_V(8); PG8_WAIT_L(0); PG8_BAR; PG8_MMA(0, 0, At, B0); PG8_MMA(0, 1, At, B1); PG8_BAR; PG8_SCHED;
            PG8_LDA(At, 0, 1); PG8_STAGE(PG8_SB(0, 0), b2, voffB); PG8_STAGE(PG8_SB(0, 1), b2 + hstepB, voffB); PG8_STAGE(PG8_SA(0, 0), a2, voffA);
            PG8_WAIT_V(8); PG8_WAIT_L(0); PG8_BAR; PG8_MMA(1, 0, At, B0); PG8_MMA(1, 1, At, B1); PG8_BAR; PG8_SCHED;
            PG8_LDB(B0, 1, 0); PG8_LDB(B1, 1, 1); PG8_SCHED; PG8_LDA(At, 1, 0); PG8_STAGE(PG8_SA(0, 1), a2 + hstepA, voffA);
            PG8_WAIT_V(8); PG8_WAIT_L(0); PG8_BAR; PG8_MMA(0, 0, At, B0); PG8_MMA(0, 1, At, B1); PG8_BAR; PG8_SCHED;
            PG8_LDA(At, 1, 1); PG8_STAGE(PG8_SB(1, 0), b3, voffB); PG8_STAGE(PG8_SB(1, 1), b3 + hstepB, voffB); PG8_STAGE(PG8_SA(1, 0), a3, voffA);
            PG8_WAIT_V(8); PG8_WAIT_L(0); PG8_BAR; PG8_MMA(1, 0, At, B0); PG8_MMA(1, 1, At, B1); PG8_BAR; PG8_SCHED;
        }
        if (wr == 0) PG8_BAR;
        E(acc, cur, wr, wc, fr, fq);
        if (!has_next) break;
#pragma unroll
        for (int a = 0; a < 2; ++a)
#pragma unroll
            for (int b = 0; b < 2; ++b)
#pragma unroll
                for (int m = 0; m < 4; ++m)
#pragma unroll
                    for (int n = 0; n < 2; ++n) acc[a][b][m][n] = (f32x4){0.f, 0.f, 0.f, 0.f};
        cur = nxt; cA = nA; cB = nB; ++ui;
        if (wr == 1) PG8_BAR;
    }
    PG8_WAIT_V(0);
    PG8_BAR;
#undef PG8_SA
#undef PG8_SB
#undef PG8_STAGE
#undef PG8_LDA
#undef PG8_LDB
#undef PG8_MMA
#undef PG8_WAIT_V
#undef PG8_WAIT_L
#undef PG8_BAR
#undef PG8_SCHED
}
}
using pg8::cvt_pk_bf16;
using pg8::Unit;

__device__ __forceinline__ float bf2f(unsigned short h) { return __uint_as_float((unsigned)h << 16); }
__device__ __forceinline__ float bflo(unsigned w) { return __uint_as_float(w << 16); }
__device__ __forceinline__ float bfhi(unsigned w) { return __uint_as_float(w & 0xffff0000u); }
__device__ __forceinline__ unsigned short f2bf(float f) { return (unsigned short)(cvt_pk_bf16(f, 0.f) & 0xffffu); }
__device__ __forceinline__ float sigm(float x) { return __builtin_amdgcn_rcpf(1.f + __expf(-x)); }
__device__ __forceinline__ float wave_sum(float v) {
#pragma unroll
    for (int o = 1; o < 64; o <<= 1) v += __shfl_xor(v, o);
    return v;
}
__device__ __forceinline__ float wave_max(float v) {
#pragma unroll
    for (int o = 1; o < 64; o <<= 1) v = fmaxf(v, __shfl_xor(v, o));
    return v;
}
__device__ __forceinline__ float log_sigmoid(float x) { return fminf(x, 0.f) - log1pf(expf(-fabsf(x))); }
__device__ __forceinline__ bf16x8 pack8(f32x4 a, f32x4 b) {
    u32x4 w; w.x = cvt_pk_bf16(a[0], a[1]); w.y = cvt_pk_bf16(a[2], a[3]); w.z = cvt_pk_bf16(b[0], b[1]); w.w = cvt_pk_bf16(b[2], b[3]);
    return __builtin_bit_cast(bf16x8, w);
}
__device__ __forceinline__ int kperm32(int kl) { return 8 * ((kl & 15) >> 2) + (kl & 3) + 4 * (kl >> 4); }

struct EpiSwiglu {
    bf16_t* O;
    __device__ __forceinline__ void operator()(const f32x4 (&acc)[2][2][4][2], const Unit& u, int wr, int wc, int fr, int fq) const {
        const int row0 = u.pm * 256 + wr * 64 + fr, col0 = u.pn * 128 + wc * 32 + 8 * fq;
#pragma unroll
        for (int ai = 0; ai < 2; ++ai)
#pragma unroll
            for (int m = 0; m < 4; ++m) {
                bf16_t* rowp = O + (size_t)(row0 + ai * 128 + m * 16) * DFF + col0;
                float v[8];
#pragma unroll
                for (int n = 0; n < 2; ++n)
#pragma unroll
                    for (int e = 0; e < 4; ++e) { const float a = acc[ai][0][m][n][e], b = acc[ai][1][m][n][e]; v[n * 4 + e] = a * sigm(a) * b; }
                u32x4 w; w.x = cvt_pk_bf16(v[0], v[1]); w.y = cvt_pk_bf16(v[2], v[3]); w.z = cvt_pk_bf16(v[4], v[5]); w.w = cvt_pk_bf16(v[6], v[7]);
                *(u32x4*)rowp = w;
            }
    }
};
struct EpiResid {
    const float* base; float* out; const float* gate; float scale;
    __device__ __forceinline__ void operator()(const f32x4 (&acc)[2][2][4][2], const Unit& u, int wr, int wc, int fr, int fq) const {
        const int row0 = u.pm * 256 + wr * 64 + fr, col0 = u.pn * 256 + wc * 32 + 8 * fq;
        const float* gp = gate + (size_t)(u.pm >> 5) * NMOD + col0;
        f32x4 gv[2][2];
#pragma unroll
        for (int bj = 0; bj < 2; ++bj)
#pragma unroll
            for (int n = 0; n < 2; ++n) gv[bj][n] = *(const f32x4*)(gp + bj * 128 + 4 * n) * scale;
#pragma unroll
        for (int ai = 0; ai < 2; ++ai)
#pragma unroll
            for (int m = 0; m < 4; ++m) {
                const size_t off = (size_t)(row0 + ai * 128 + m * 16) * D_ + col0;
#pragma unroll
                for (int bj = 0; bj < 2; ++bj)
#pragma unroll
                    for (int n = 0; n < 2; ++n) { const f32x4 bs = *(const f32x4*)(base + off + bj * 128 + 4 * n); *(f32x4*)(out + off + bj * 128 + 4 * n) = bs + gv[bj][n] * acc[ai][bj][m][n]; }
            }
    }
};
struct EpiProj {
    bf16_t* P; const float* rope;
    __device__ __forceinline__ void operator()(const f32x4 (&acc)[2][2][4][2], const Unit& u, int wr, int wc, int fr, int fq) const {
        const int row0 = u.pm * 256 + wr * 64 + fr, col0 = u.pn * 256 + wc * 32 + 8 * fq;
        const bool sig = u.pn >= 13;
        const bool ropelane = ((wc & 1) == 0) && (fq < 2) && (u.pn <= 4);
#pragma unroll
        for (int ai = 0; ai < 2; ++ai)
#pragma unroll
            for (int m = 0; m < 4; ++m) {
                const int row = row0 + ai * 128 + m * 16;
                f32x4 cs = {1.f, 1.f, 1.f, 1.f}, sn = {0.f, 0.f, 0.f, 0.f};
                if (ropelane) { cs = *(const f32x4*)(rope + (size_t)row * 16 + fq * 4); sn = *(const f32x4*)(rope + (size_t)row * 16 + 8 + fq * 4); }
#pragma unroll
                for (int bj = 0; bj < 2; ++bj) {
                    f32x4 v0 = acc[ai][bj][m][0], v1 = acc[ai][bj][m][1];
                    if (ropelane && (u.pn < 4 || bj == 0)) { const f32x4 x1 = v0, x2 = v1; v0 = x1 * cs - x2 * sn; v1 = x2 * cs + x1 * sn; }
                    if (sig) {
#pragma unroll
                        for (int e = 0; e < 4; ++e) { v0[e] = sigm(v0[e]); v1[e] = sigm(v1[e]); }
                    }
                    u32x4 w; w.x = cvt_pk_bf16(v0[0], v0[1]); w.y = cvt_pk_bf16(v0[2], v0[3]); w.z = cvt_pk_bf16(v1[0], v1[1]); w.w = cvt_pk_bf16(v1[2], v1[3]);
                    *(u32x4*)(P + (size_t)row * PP + col0 + bj * 128) = w;
                }
            }
    }
};
struct EpiMerge {
    bf16_t* P; int first;
    __device__ __forceinline__ void operator()(const f32x4 (&acc)[2][2][4][2], const Unit& u, int wr, int wc, int fr, int fq) const {
        const int row0 = u.pm * 256 + wr * 64 + fr, col0 = u.pn * 256 + wc * 32 + 8 * fq;
#pragma unroll
        for (int ai = 0; ai < 2; ++ai)
#pragma unroll
            for (int m = 0; m < 4; ++m)
#pragma unroll
                for (int bj = 0; bj < 2; ++bj) {
                    bf16_t* zp = P + (size_t)(row0 + ai * 128 + m * 16) * PP + PC_G + col0 + bj * 128;
                    const u32x4 z8 = *(const u32x4*)zp;
                    u32x4 g8 = z8; if (!first) g8 = *(const u32x4*)(zp + 2048);
                    const f32x4 a0 = acc[ai][bj][m][0], a1 = acc[ai][bj][m][1];
                    float o[8];
                    o[0] = bflo(g8.x) * a0[0]; o[1] = bfhi(g8.x) * a0[1]; o[2] = bflo(g8.y) * a0[2]; o[3] = bfhi(g8.y) * a0[3];
                    o[4] = bflo(g8.z) * a1[0]; o[5] = bfhi(g8.z) * a1[1]; o[6] = bflo(g8.w) * a1[2]; o[7] = bfhi(g8.w) * a1[3];
                    if (!first) { o[0] += bflo(z8.x); o[1] += bfhi(z8.x); o[2] += bflo(z8.y); o[3] += bfhi(z8.y); o[4] += bflo(z8.z); o[5] += bfhi(z8.z); o[6] += bflo(z8.w); o[7] += bfhi(z8.w); }
                    u32x4 w; w.x = cvt_pk_bf16(o[0], o[1]); w.y = cvt_pk_bf16(o[2], o[3]); w.z = cvt_pk_bf16(o[4], o[5]); w.w = cvt_pk_bf16(o[6], o[7]);
                    *(u32x4*)zp = w;
                }
    }
};

struct Args {
    const float* x; const float* c; const int* pos; const float* w_ada; const float* b_ada; const float* norm1_g;
    const float* f1_in; const float* f1_out; const float* norm2_g; const float* w_in; const float* conv_w; const float* conv_b;
    const float* b_ig; const float* b_fg; const float* sinks; const float* mnorm_g; const float* w_att; const float* w_ml;
    const float* w_out; const float* norm3_g; const float* f2_in; const float* f2_out; const float* final_g;
    float* out; unsigned char* ws; int ph_lo, ph_hi;
};

template <int KIND> __device__ __forceinline__ int srccol(int n) {
    if (KIND == 0) return n;
    if (KIND == 1) { const int pn = n >> 8, bj = (n >> 7) & 1, i = n & 127; return bj * DFF + pn * 128 + i; }
    if (n < PC_V) { const int d = n & 63; if (d < 16) { const int g = d >> 2; const int dd = (g == 1) ? d + 4 : (g == 2) ? d - 4 : d; return (n & ~63) + dd; } return n; }
    if (n < PC_MO) return n;
    return n + 8;
}
template <int KIND> __device__ __forceinline__ void transpose_item(const float* W, int K, int N, bf16_t* WT, LAS float* scr, int item, int lane, int nblk) {
    const int kb = item / nblk, nb = item % nblk, k0 = 64 * kb, n0 = 32 * nb;
    const int sc = srccol<KIND>(n0 + (lane & 31));
#pragma unroll 8
    for (int i = 0; i < 32; ++i) { const int kk = 2 * i + (lane >> 5); scr[kk * 33 + (lane & 31)] = W[(size_t)(k0 + kk) * N + sc]; }
    asm volatile("s_waitcnt lgkmcnt(0)" ::: "memory");
    const int c = lane & 7;
#pragma unroll
    for (int j = 0; j < 4; ++j) { const int n = (lane >> 3) + 8 * j; const LAS float* s = scr + (8 * c) * 33 + n;
        u32x4 o; o.x = cvt_pk_bf16(s[0 * 33], s[1 * 33]); o.y = cvt_pk_bf16(s[2 * 33], s[3 * 33]); o.z = cvt_pk_bf16(s[4 * 33], s[5 * 33]); o.w = cvt_pk_bf16(s[6 * 33], s[7 * 33]);
        *(u32x4*)(WT + (size_t)(n0 + n) * K + k0 + 8 * c) = o; }
    asm volatile("s_waitcnt lgkmcnt(0)" ::: "memory");
}
template <int KIND> __device__ __forceinline__ void transpose_all(const float* W, int K, int N, int Nout, bf16_t* WT, LAS float* scr, int gw, int ngw, int lane) {
    const int nblk = Nout / 32, items = (K / 64) * nblk;
    for (int it = gw; it < items; it += ngw) transpose_item<KIND>(W, K, N, WT, scr, it, lane, nblk);
}

template <bool GATES> __device__ __forceinline__ void norm_phase(const float* hin, const float* g, const float* mod, int sh_off, int sc_off, bf16_t* uout,
                                                                 float* gif, const float* w_in, LAS unsigned char* lds, int tid, int wave, int lane) {
    LAS float* wgT = (LAS float*)lds;
    if (GATES) {
        for (int idx = tid; idx < 2048 * 8; idx += 512) { const int k = idx >> 3, j = idx & 7; wgT[j * 2048 + k] = w_in[(size_t)k * PROJ_OUT + 3328 + j]; }
        __syncthreads();
    }
    const int gw = blockIdx.x * 8 + wave, ngw = gridDim.x * 8;
    for (int row = gw; row < M_; row += ngw) {
        const int b = row >> 13;
        const f32x4* xr = (const f32x4*)(hin + (size_t)row * D_) + lane;
        f32x4 v[8]; float ss = 0.f;
#pragma unroll
        for (int j = 0; j < 8; ++j) { v[j] = xr[64 * j]; ss += (v[j][0] * v[j][0] + v[j][1] * v[j][1]) + (v[j][2] * v[j][2] + v[j][3] * v[j][3]); }
        const float rstd = 1.0f / sqrtf(wave_sum(ss) * (1.0f / D_) + EPS);
        float ga[8];
#pragma unroll
        for (int i = 0; i < 8; ++i) ga[i] = 0.f;
#pragma unroll
        for (int j = 0; j < 8; ++j) {
            const int col = 256 * j + 4 * lane;
            const f32x4 g4 = *(const f32x4*)(g + col), sc4 = *(const f32x4*)(mod + (size_t)b * NMOD + sc_off + col), sh4 = *(const f32x4*)(mod + (size_t)b * NMOD + sh_off + col);
            const f32x4 y = (v[j] * rstd) * g4 * (sc4 + 1.0f) + sh4;
            u32x2 w; w.x = cvt_pk_bf16(y[0], y[1]); w.y = cvt_pk_bf16(y[2], y[3]);
            *(u32x2*)(uout + (size_t)row * D_ + col) = w;
            if (GATES) {
#pragma unroll
                for (int i = 0; i < 8; ++i) { const f32x4 w4 = *(const LAS f32x4*)(wgT + i * 2048 + col); ga[i] += (y[0] * w4[0] + y[1] * w4[1]) + (y[2] * w4[2] + y[3] * w4[3]); }
            }
        }
        if (GATES) {
#pragma unroll
            for (int i = 0; i < 8; ++i) ga[i] = wave_sum(ga[i]);
            if (lane == 0) { *(f32x4*)(gif + (size_t)row * 8) = (f32x4){ga[0], ga[1], ga[2], ga[3]}; *(f32x4*)(gif + (size_t)row * 8 + 4) = (f32x4){ga[4], ga[5], ga[6], ga[7]}; }
        }
    }
    if (GATES) __syncthreads();
}

__device__ __forceinline__ void attn_item(int item, bf16_t* P, const float* sinks, LAS unsigned char* lds, int tid, int wave, int lane) {
    const int kvh = item & 1, nb = (item >> 1) & 63, b = item >> 7;
    const int r0 = b * T_ + nb * 128;
    LAS bf16_t* Ksh = (LAS bf16_t*)lds;
    LAS bf16_t* VT = (LAS bf16_t*)(lds + 36864);
#pragma unroll
    for (int i = 0; i < 4; ++i) {
        const int chunk = tid + 512 * i, key = chunk >> 3, c8 = chunk & 7;
        const bool valid = (nb > 0) || (key >= 128);
        u32x4 kv = {0u, 0u, 0u, 0u}, vv = {0u, 0u, 0u, 0u};
        if (valid) { const bf16_t* rp = P + (size_t)(r0 - 128 + key) * PP; kv = *(const u32x4*)(rp + PC_K + kvh * 64 + c8 * 8); vv = *(const u32x4*)(rp + PC_V + kvh * 64 + c8 * 8); }
        *(LAS u32x4*)(Ksh + key * 72 + c8 * 8) = kv;
        const int pos = (key & ~31) + kperm32(key & 31);
        LAS bf16_t* vp = VT + (c8 * 8) * 264 + pos;
        vp[0 * 264] = (bf16_t)(vv.x & 0xffff); vp[1 * 264] = (bf16_t)(vv.x >> 16); vp[2 * 264] = (bf16_t)(vv.y & 0xffff); vp[3 * 264] = (bf16_t)(vv.y >> 16);
        vp[4 * 264] = (bf16_t)(vv.z & 0xffff); vp[5 * 264] = (bf16_t)(vv.z >> 16); vp[6 * 264] = (bf16_t)(vv.w & 0xffff); vp[7 * 264] = (bf16_t)(vv.w >> 16);
    }
    __syncthreads();
    const int h = kvh * 8 + wave, fr = lane & 15, fq = lane >> 4;
    const float sink = sinks[h];
    for (int qg = 0; qg < 8; ++qg) {
        const int qrow = r0 + qg * 16 + fr;
        bf16_t* qp = P + (size_t)qrow * PP + h * 64;
        const bf16x8 bq0 = *(const bf16x8*)(qp + 8 * fq), bq1 = *(const bf16x8*)(qp + 32 + 8 * fq);
        const int t0e = qg & ~1;
        f32x4 s[10];
#pragma unroll
        for (int tt = 0; tt < 10; ++tt) {
            const int t = min(t0e + tt, 15);
            const LAS bf16_t* kp = Ksh + (t * 16 + fr) * 72 + 8 * fq;
            const bf16x8 a0 = *(const LAS bf16x8*)kp, a1 = *(const LAS bf16x8*)(kp + 32);
            f32x4 z = {0.f, 0.f, 0.f, 0.f};
            z = __builtin_amdgcn_mfma_f32_16x16x32_bf16(a0, bq0, z, 0, 0, 0);
            s[tt] = __builtin_amdgcn_mfma_f32_16x16x32_bf16(a1, bq1, z, 0, 0, 0);
        }
        const int qi = 128 + qg * 16 + fr;
        float mx = -1e30f;
#pragma unroll
        for (int tt = 0; tt < 10; ++tt)
#pragma unroll
            for (int r = 0; r < 4; ++r) {
                const int kj = (t0e + tt) * 16 + 4 * fq + r;
                const bool ok = (kj <= qi) && (kj > qi - 128) && ((nb > 0) || (kj >= 128));
                const float sv = ok ? s[tt][r] * 0.125f : -1e30f;
                s[tt][r] = sv; mx = fmaxf(mx, sv);
            }
        mx = fmaxf(mx, __shfl_xor(mx, 16)); mx = fmaxf(mx, __shfl_xor(mx, 32)); mx = fmaxf(mx, sink);
        float sum = 0.f;
#pragma unroll
        for (int tt = 0; tt < 10; ++tt)
#pragma unroll
            for (int r = 0; r < 4; ++r) { const float p = __expf(s[tt][r] - mx); s[tt][r] = p; sum += p; }
        sum += __shfl_xor(sum, 16); sum += __shfl_xor(sum, 32);
        const float inv = 1.0f / (sum + __expf(sink - mx));
        bf16x8 bp[5];
#pragma unroll
        for (int g = 0; g < 5; ++g) bp[g] = pack8(s[2 * g], s[2 * g + 1]);
#pragma unroll
        for (int dt = 0; dt < 4; ++dt) {
            f32x4 o = {0.f, 0.f, 0.f, 0.f};
#pragma unroll
            for (int g = 0; g < 5; ++g) {
                const int grp = min((t0e >> 1) + g, 7);
                const bf16x8 a = *(const LAS bf16x8*)(VT + (dt * 16 + fr) * 264 + grp * 32 + 8 * fq);
                o = __builtin_amdgcn_mfma_f32_16x16x32_bf16(a, bp[g], o, 0, 0, 0);
            }
            u32x2 w; w.x = cvt_pk_bf16(o[0] * inv, o[1] * inv); w.y = cvt_pk_bf16(o[2] * inv, o[3] * inv);
            *(u32x2*)(qp + dt * 16 + 4 * fq) = w;
        }
    }
    __syncthreads();
}

__device__ __forceinline__ void m1_item(int item, const bf16_t* P, bf16_t* QK, const float* gif, const float* conv_w, const float* conv_b, const float* b_ig, const float* b_fg,
                                        float* Cbuf, float* scal, LAS unsigned char* lds, int tid, int wave, int lane) {
    const int c = item & 127, h = (item >> 7) & 3, b = item >> 9;
    const int r0 = b * T_ + c * 64;
    LAS bf16_t* VT = (LAS bf16_t*)lds;
    LAS bf16_t* KT = (LAS bf16_t*)(lds + 39168);
    LAS float* wl = (LAS float*)(lds + 57600);
    if (wave == 0) {
        const int row = r0 + lane;
        const float fpre = gif[(size_t)row * 8 + 4 + h] + b_fg[h], ipre = gif[(size_t)row * 8 + h] + b_ig[h];
        float bc = log_sigmoid(fpre);
#pragma unroll
        for (int o = 1; o < 64; o <<= 1) { const float t = __shfl_up(bc, o); if (lane >= o) bc += t; }
        const float blast = __shfl(bc, 63);
        const float gg = blast - bc + ipre;
        const float gmax = wave_max(gg);
        wl[lane] = expf(gg - gmax);
        if (lane == 0) { scal[item * 4 + 0] = gmax; scal[item * 4 + 1] = blast; }
    }
    for (int idx = tid; idx < 16 * 72; idx += 512) VT[256 * 72 + idx] = (idx < 64) ? (bf16_t)0x3F80 : (bf16_t)0;
    __syncthreads();
#pragma unroll
    for (int i = 0; i < 4; ++i) {
        const int task = tid + 512 * i, tl = task & 63, ch8 = task >> 6, qk = ch8 >> 4, j0 = (ch8 & 15) * 8;
        const int chan = qk * 512 + h * 128 + j0;
        float a[8];
        { const f32x4 b0 = *(const f32x4*)(conv_b + chan), b1 = *(const f32x4*)(conv_b + chan + 4); a[0] = b0[0]; a[1] = b0[1]; a[2] = b0[2]; a[3] = b0[3]; a[4] = b1[0]; a[5] = b1[1]; a[6] = b1[2]; a[7] = b1[3]; }
#pragma unroll
        for (int kk = 0; kk < 4; ++kk) {
            const int ts = c * 64 + tl - 3 + kk;
            if (ts >= 0) {
                const u32x4 x8 = *(const u32x4*)(P + (size_t)(b * T_ + ts) * PP + PC_MQK + chan);
                const f32x4 w0 = *(const f32x4*)(conv_w + kk * 1024 + chan), w1 = *(const f32x4*)(conv_w + kk * 1024 + chan + 4);
                a[0] += w0[0] * bflo(x8.x); a[1] += w0[1] * bfhi(x8.x); a[2] += w0[2] * bflo(x8.y); a[3] += w0[3] * bfhi(x8.y);
                a[4] += w1[0] * bflo(x8.z); a[5] += w1[1] * bfhi(x8.z); a[6] += w1[2] * bflo(x8.w); a[7] += w1[3] * bfhi(x8.w);
            }
        }
        const float ksc = qk ? 0.08838834764831845f : 1.0f;
#pragma unroll
        for (int e = 0; e < 8; ++e) a[e] = a[e] * sigm(a[e]) * ksc;
        u32x4 w; w.x = cvt_pk_bf16(a[0], a[1]); w.y = cvt_pk_bf16(a[2], a[3]); w.z = cvt_pk_bf16(a[4], a[5]); w.w = cvt_pk_bf16(a[6], a[7]);
        *(u32x4*)(QK + (size_t)(r0 + tl) * 1024 + chan) = w;
        if (qk) {
            const float wt = wl[tl];
#pragma unroll
            for (int e = 0; e < 8; ++e) KT[(j0 + e) * 72 + tl] = f2bf(a[e] * wt);
        }
    }
#pragma unroll
    for (int i = 0; i < 4; ++i) {
        const int task = tid + 512 * i, tl = task & 63, ce = task >> 6;
        const u32x4 vv = *(const u32x4*)(P + (size_t)(r0 + tl) * PP + PC_MV + h * 256 + ce * 8);
        LAS bf16_t* vp = VT + (ce * 8) * 72 + tl;
        vp[0 * 72] = (bf16_t)(vv.x & 0xffff); vp[1 * 72] = (bf16_t)(vv.x >> 16); vp[2 * 72] = (bf16_t)(vv.y & 0xffff); vp[3 * 72] = (bf16_t)(vv.y >> 16);
        vp[4 * 72] = (bf16_t)(vv.z & 0xffff); vp[5 * 72] = (bf16_t)(vv.z >> 16); vp[6 * 72] = (bf16_t)(vv.w & 0xffff); vp[7 * 72] = (bf16_t)(vv.w >> 16);
    }
    __syncthreads();
    const int fr = lane & 15, fq = lane >> 4;
    float* Cit = Cbuf + (size_t)item * 257 * 128;
#pragma unroll
    for (int et2 = 0; et2 < 2; ++et2) {
        const int et = 2 * wave + et2;
        const bf16x8 v0 = *(const LAS bf16x8*)(VT + (et * 16 + fr) * 72 + 8 * fq), v1 = *(const LAS bf16x8*)(VT + (et * 16 + fr) * 72 + 32 + 8 * fq);
#pragma unroll
        for (int dt = 0; dt < 8; ++dt) {
            const bf16x8 k0 = *(const LAS bf16x8*)(KT + (dt * 16 + fr) * 72 + 8 * fq), k1 = *(const LAS bf16x8*)(KT + (dt * 16 + fr) * 72 + 32 + 8 * fq);
            f32x4 z = {0.f, 0.f, 0.f, 0.f};
            z = __builtin_amdgcn_mfma_f32_16x16x32_bf16(k0, v0, z, 0, 0, 0);
            z = __builtin_amdgcn_mfma_f32_16x16x32_bf16(k1, v1, z, 0, 0, 0);
            *(f32x4*)(Cit + (size_t)(et * 16 + fr) * 128 + dt * 16 + 4 * fq) = z;
        }
    }
    if (wave == 0) {
        const bf16x8 v0 = *(const LAS bf16x8*)(VT + (256 + fr) * 72 + 8 * fq), v1 = *(const LAS bf16x8*)(VT + (256 + fr) * 72 + 32 + 8 * fq);
#pragma unroll
        for (int dt = 0; dt < 8; ++dt) {
            const bf16x8 k0 = *(const LAS bf16x8*)(KT + (dt * 16 + fr) * 72 + 8 * fq), k1 = *(const LAS bf16x8*)(KT + (dt * 16 + fr) * 72 + 32 + 8 * fq);
            f32x4 z = {0.f, 0.f, 0.f, 0.f};
            z = __builtin_amdgcn_mfma_f32_16x16x32_bf16(k0, v0, z, 0, 0, 0);
            z = __builtin_amdgcn_mfma_f32_16x16x32_bf16(k1, v1, z, 0, 0, 0);
            if (fr == 0) *(f32x4*)(Cit + (size_t)256 * 128 + dt * 16 + 4 * fq) = z;
        }
    }
    __syncthreads();
}

__device__ __forceinline__ void m2_scan(const float* Cbuf, bf16_t* Cin, float* scal, int gtid, int gthreads) {
    constexpr int PER_BH = 257 * 32, TOTAL = 8 * PER_BH;
    constexpr size_t CSTRIDE = (size_t)257 * 128;
    for (int w = gtid; w < TOTAL; w += gthreads) {
        const int bh = w / PER_BH, rem = w % PER_BH, e = rem >> 5, d4 = (rem & 31) * 4;
        const size_t off = ((size_t)bh * 128 * 257 + e) * 128 + d4;
        const float* ptr = Cbuf + off; bf16_t* optr = Cin + off;
        const bool lead = (rem == 0);
        f32x4 C = {0.f, 0.f, 0.f, 0.f}; float m = -1e30f;
        for (int c0 = 0; c0 < 128; c0 += 8) {
            f32x4 cl[8]; float gm[8], bl[8];
#pragma unroll
            for (int u = 0; u < 8; ++u) { cl[u] = *(const f32x4*)(ptr + (size_t)(c0 + u) * CSTRIDE); gm[u] = scal[(bh * 128 + c0 + u) * 4]; bl[u] = scal[(bh * 128 + c0 + u) * 4 + 1]; }
#pragma unroll
            for (int u = 0; u < 8; ++u) {
                u32x2 o; o.x = cvt_pk_bf16(C[0], C[1]); o.y = cvt_pk_bf16(C[2], C[3]);
                *(u32x2*)(optr + (size_t)(c0 + u) * CSTRIDE) = o;
                if (lead) scal[(bh * 128 + c0 + u) * 4 + 2] = m;
                const float mn = fmaxf(bl[u] + m, gm[u]);
                const float a = expf(bl[u] + m - mn), sc = expf(gm[u] - mn);
                C = C * a + cl[u] * sc; m = mn;
            }
        }
    }
}

__device__ __forceinline__ void m3_item(int item, bf16_t* P, const bf16_t* QK, const float* gif, const float* b_ig, const float* b_fg, const bf16_t* Cbuf, const float* scal,
                                        const float* norm_g, LAS unsigned char* lds, int tid, int wave, int lane) {
    const int c = item & 127, h = (item >> 7) & 3, b = item >> 9;
    const int r0 = b * T_ + c * 64;
    LAS bf16_t* VT = (LAS bf16_t*)lds;
    LAS float* tb = (LAS float*)(lds + 36864);
    LAS float* red = tb + 256;
    if (wave == 0) {
        const int row = r0 + lane;
        const float fpre = gif[(size_t)row * 8 + 4 + h] + b_fg[h], ipre = gif[(size_t)row * 8 + h] + b_ig[h];
        float bc = log_sigmoid(fpre);
#pragma unroll
        for (int o = 1; o < 64; o <<= 1) { const float t = __shfl_up(bc, o); if (lane >= o) bc += t; }
        const float gs = ipre - bc;
        float mxs = gs;
#pragma unroll
        for (int o = 1; o < 64; o <<= 1) { const float t = __shfl_up(mxs, o); if (lane >= o) mxs = fmaxf(mxs, t); }
        const float m_in = scal[item * 4 + 2];
        const float alog = bc + m_in;
        const float mt = fmaxf(alog, bc + mxs);
        tb[lane] = bc; tb[64 + lane] = gs; tb[128 + lane] = mt; tb[192 + lane] = expf(alog - mt);
    }
#pragma unroll
    for (int i = 0; i < 4; ++i) {
        const int task = tid + 512 * i, tl = task & 63, ce = task >> 6;
        const u32x4 vv = *(const u32x4*)(P + (size_t)(r0 + tl) * PP + PC_MV + h * 256 + ce * 8);
        const int pos = (tl & 32) + kperm32(tl & 31);
        LAS bf16_t* vp = VT + (ce * 8) * 72 + pos;
        vp[0 * 72] = (bf16_t)(vv.x & 0xffff); vp[1 * 72] = (bf16_t)(vv.x >> 16); vp[2 * 72] = (bf16_t)(vv.y & 0xffff); vp[3 * 72] = (bf16_t)(vv.y >> 16);
        vp[4 * 72] = (bf16_t)(vv.z & 0xffff); vp[5 * 72] = (bf16_t)(vv.z >> 16); vp[6 * 72] = (bf16_t)(vv.w & 0xffff); vp[7 * 72] = (bf16_t)(vv.w >> 16);
    }
    __syncthreads();
    const int fr = lane & 15, fq = lane >> 4, tt = wave & 3, eh = wave >> 2;
    const int t = tt * 16 + fr;
    const bf16_t* qp = QK + (size_t)(r0 + t) * 1024 + h * 128 + 8 * fq;
    bf16x8 bq[4];
#pragma unroll
    for (int ks = 0; ks < 4; ++ks) bq[ks] = *(const bf16x8*)(qp + ks * 32);
    f32x4 sacc[4];
#pragma unroll
    for (int st = 0; st < 4; ++st) {
        const bf16_t* kp = QK + (size_t)(r0 + st * 16 + fr) * 1024 + 512 + h * 128 + 8 * fq;
        f32x4 z = {0.f, 0.f, 0.f, 0.f};
#pragma unroll
        for (int ks = 0; ks < 4; ++ks) z = __builtin_amdgcn_mfma_f32_16x16x32_bf16(*(const bf16x8*)(kp + ks * 32), bq[ks], z, 0, 0, 0);
        sacc[st] = z;
    }
    const float bc_t = tb[t], mt_t = tb[128 + t], inter_t = tb[192 + t];
    float dsum = 0.f;
#pragma unroll
    for (int st = 0; st < 4; ++st)
#pragma unroll
        for (int r = 0; r < 4; ++r) {
            const int s = st * 16 + 4 * fq + r;
            const float wgt = (s <= t) ? __expf(bc_t + tb[64 + s] - mt_t) : 0.f;
            const float qk = sacc[st][r] * wgt; sacc[st][r] = qk; dsum += qk;
        }
    dsum += __shfl_xor(dsum, 16); dsum += __shfl_xor(dsum, 32);
    bf16x8 bp[2];
    bp[0] = pack8(sacc[0], sacc[1]); bp[1] = pack8(sacc[2], sacc[3]);
    const bf16_t* Cin = Cbuf + (size_t)item * 257 * 128;
    f32x4 acc[8];
#pragma unroll
    for (int et = 0; et < 8; ++et) {
        const bf16_t* cp = Cin + (size_t)((eh * 8 + et) * 16 + fr) * 128 + 8 * fq;
        f32x4 z = {0.f, 0.f, 0.f, 0.f};
#pragma unroll
        for (int ks = 0; ks < 4; ++ks) z = __builtin_amdgcn_mfma_f32_16x16x32_bf16(*(const bf16x8*)(cp + ks * 32), bq[ks], z, 0, 0, 0);
        acc[et] = z;
    }
    float qn;
    {
        const bf16_t* np = Cin + (size_t)256 * 128 + 8 * fq;
        f32x4 z = {0.f, 0.f, 0.f, 0.f};
#pragma unroll
        for (int ks = 0; ks < 4; ++ks) z = __builtin_amdgcn_mfma_f32_16x16x32_bf16(*(const bf16x8*)(np + ks * 32), bq[ks], z, 0, 0, 0);
        qn = z[0];
    }
#pragma unroll
    for (int et = 0; et < 8; ++et) {
        f32x4 z = acc[et] * inter_t;
#pragma unroll
        for (int g = 0; g < 2; ++g) z = __builtin_amdgcn_mfma_f32_16x16x32_bf16(*(const LAS bf16x8*)(VT + ((eh * 8 + et) * 16 + fr) * 72 + g * 32 + 8 * fq), bp[g], z, 0, 0, 0);
        acc[et] = z;
    }
    const float den = inter_t * qn + dsum;
    const float inv = 1.0f / fmaxf(fabsf(den), expf(-mt_t));
    float ss = 0.f;
#pragma unroll
    for (int et = 0; et < 8; ++et) { acc[et] = acc[et] * inv; ss += (acc[et][0] * acc[et][0] + acc[et][1] * acc[et][1]) + (acc[et][2] * acc[et][2] + acc[et][3] * acc[et][3]); }
    ss += __shfl_xor(ss, 16); ss += __shfl_xor(ss, 32);
    if (fq == 0) red[eh * 64 + t] = ss;
    __syncthreads();
    const float rstd = 1.0f / sqrtf((red[t] + red[64 + t]) * (1.0f / 256.0f) + EPS);
    bf16_t* prow = P + (size_t)(r0 + t) * PP;
#pragma unroll
    for (int et = 0; et < 8; ++et) {
        const int e0 = h * 256 + (eh * 8 + et) * 16 + 4 * fq;
        const f32x4 gn = *(const f32x4*)(norm_g + e0);
        const u32x2 mo = *(const u32x2*)(prow + PC_MO + e0);
        const f32x4 o = acc[et] * rstd * gn;
        u32x2 w; w.x = cvt_pk_bf16(o[0] * bflo(mo.x), o[1] * bfhi(mo.x)); w.y = cvt_pk_bf16(o[2] * bflo(mo.y), o[3] * bfhi(mo.y));
        *(u32x2*)(prow + PC_MV + e0) = w;
    }
    __syncthreads();
}


#define XB_TMO      128
#define XB_XCNT(j)  (256  + 64 * (j))
#define XB_XSUB(j)  (1280 + 64 * (j))
#define XB_XGEN(j)  (2304 + 64 * (j))
#define XB_TOP      3328
#define XB_TOPGEN   3392
#define XCD_BAR_WORDS 3456
#define XB_SPIN_CAP (1u << 20)
__device__ __forceinline__ unsigned xb_ld(unsigned* p)              { return __hip_atomic_load(p, __ATOMIC_RELAXED, __HIP_MEMORY_SCOPE_AGENT); }
__device__ __forceinline__ unsigned xb_add(unsigned* p, unsigned v) { return __hip_atomic_fetch_add(p, v, __ATOMIC_RELAXED, __HIP_MEMORY_SCOPE_AGENT); }
__device__ __forceinline__ unsigned xb_xcc_id() { return (unsigned)__builtin_amdgcn_s_getreg((3 << 11) | 20) & 0xFu; }
#define XB_SPIN(cond, bar) do { unsigned _sp = 0; while (cond) { __builtin_amdgcn_s_sleep(1); \
    if ((++_sp & 255u) == 0u) { if (xb_ld(&(bar)[XB_TMO])) break; if (_sp > XB_SPIN_CAP) { atomicAdd(&(bar)[XB_TMO], 1u); break; } } } } while (0)
struct XcdBarrier { unsigned* bar; unsigned x; volatile LAS unsigned* st; };
__device__ __forceinline__ XcdBarrier xcd_barrier_post(unsigned* bar, volatile LAS unsigned* st) {
    XcdBarrier b; b.bar = bar; b.x = xb_xcc_id(); b.st = st;
    if (threadIdx.x == 0) (void)xb_add(&bar[XB_XCNT(b.x)], 1u);
    return b;
}
__device__ __forceinline__ void xcd_barrier_complete(unsigned* bar, unsigned x, unsigned& nloc, unsigned& nx) {
    const unsigned G = gridDim.x * gridDim.y * gridDim.z;
    unsigned sum, cnt, mine, sp = 0u;
    for (;;) {
        sum = 0u; cnt = 0u; mine = 0u;
#pragma unroll
        for (unsigned j = 0; j < 16; ++j) { const unsigned c = xb_ld(&bar[XB_XCNT(j)]); sum += c; cnt += (c > 0u) ? 1u : 0u; mine = (j == x) ? c : mine; }
        if (sum == G) break;
        __builtin_amdgcn_s_sleep(1);
        if ((++sp & 255u) == 0u) { if (xb_ld(&bar[XB_TMO])) break; if (sp > XB_SPIN_CAP) { atomicAdd(&bar[XB_TMO], 1u); break; } }
    }
    nloc = mine > 0u ? mine : 1u; nx = cnt > 0u ? cnt : 1u;
}
__device__ __forceinline__ void xcd_barrier(const XcdBarrier& b) {
    asm volatile("s_waitcnt vmcnt(0)" ::: "memory");
    __syncthreads();
    if (threadIdx.x == 0) {
        unsigned* bar = b.bar;
        __builtin_amdgcn_s_waitcnt(0);
        unsigned nloc = b.st[0], nx = b.st[1];
        if (nloc == 0u) { xcd_barrier_complete(bar, b.x, nloc, nx); b.st[0] = nloc; b.st[1] = nx; }
        const unsigned old = xb_add(&bar[XB_XSUB(b.x)], 1u);
        const unsigned gen = old / nloc;
        if (old + 1u == (gen + 1u) * nloc) {
            __builtin_amdgcn_fence(__ATOMIC_RELEASE, "agent");
            asm volatile("s_waitcnt vmcnt(0)" ::: "memory");
            const unsigned og = xb_add(&bar[XB_TOP], 1u);
            const unsigned tg = og / nx;
            if (og + 1u == (tg + 1u) * nx) xb_add(&bar[XB_TOPGEN], 1u);
            else XB_SPIN(xb_ld(&bar[XB_TOPGEN]) == tg, bar);
            __builtin_amdgcn_fence(__ATOMIC_ACQUIRE, "agent");
            xb_add(&bar[XB_XGEN(b.x)], 1u);
            asm volatile("s_waitcnt vmcnt(0)" ::: "memory");
        } else {
            XB_SPIN(xb_ld(&bar[XB_XGEN(b.x)]) == gen, bar);
            __builtin_amdgcn_fence(__ATOMIC_ACQUIRE, "agent");
            asm volatile("s_waitcnt vmcnt(0)" ::: "memory");
        }
    }
    __syncthreads();
}

constexpr int N_PHASES = 15;
__global__ void __launch_bounds__(512, 2) fwd_kernel(Args a) {
    extern __shared__ __attribute__((aligned(16))) unsigned char lds_raw[];
    LAS unsigned char* lds = (LAS unsigned char*)lds_raw;
    const int tid = threadIdx.x, lane = tid & 63, wave = __builtin_amdgcn_readfirstlane(tid >> 6);
    const int G = gridDim.x;
    unsigned char* ws = a.ws;
    float* mod = (float*)(ws + WS_MOD); float* rope = (float*)(ws + WS_ROPE); float* gif = (float*)(ws + WS_GIF); float* scal = (float*)(ws + WS_SCAL);
    bf16_t* WinT = (bf16_t*)(ws + WS_WIN); bf16_t* WattT = (bf16_t*)(ws + WS_WATT); bf16_t* WmlT = (bf16_t*)(ws + WS_WML); bf16_t* WoutT = (bf16_t*)(ws + WS_WOUT);
    bf16_t* U = (bf16_t*)(ws + WS_U); bf16_t* QK = U;
    bf16_t* WfinT = (bf16_t*)(ws + WS_WFIN); bf16_t* WfoutT = (bf16_t*)(ws + WS_WFOUT); bf16_t* ACT = (bf16_t*)(ws + WS_ACT);
    bf16_t* P = (bf16_t*)(ws + WS_P); float* Cbuf = (float*)(ws + WS_CBUF); bf16_t* CinB = (bf16_t*)(ws + WS_CIN);
    float* H = a.out;
    const int lo = a.ph_lo, hi = a.ph_hi;
    const int gw = blockIdx.x * 8 + wave, ngw = G * 8;
#define IN(k) (lo <= (k) && (k) < hi)
#if MK_MULTI
#define SEAM(k) do {} while (0)
#else
#define SEAM(k) do { if (IN(k) && IN((k) + 1)) { xcd_barrier(xbar); } } while (0)
    volatile LAS unsigned* xst = (volatile LAS unsigned*)(lds + 131072);
    if (tid == 0) { xst[0] = 0u; xst[1] = 0u; }
    if (blockIdx.x == 0) for (int i = tid; i < XCD_BAR_WORDS; i += 512) __hip_atomic_store((unsigned*)(ws + WS_BAR) + i, 0u, __ATOMIC_RELAXED, __HIP_MEMORY_SCOPE_AGENT);
    for (int i = blockIdx.x * 512 + tid; i < 2 * NMOD; i += G * 512) __hip_atomic_store((unsigned*)mod + i, 0u, __ATOMIC_RELAXED, __HIP_MEMORY_SCOPE_AGENT);
    __threadfence();
    cg::this_grid().sync();
    const XcdBarrier xbar = xcd_barrier_post((unsigned*)(ws + WS_BAR), xst);
#endif
    if (IN(0)) {
        LAS float* scr = (LAS float*)(lds + wave * 16384);
        transpose_all<1>(a.f1_in, D_, 2 * DFF, 2 * DFF, WfinT, scr, gw, ngw, lane);
        transpose_all<0>(a.f1_out, DFF, D_, D_, WfoutT, scr, gw, ngw, lane);
        transpose_all<2>(a.w_in, D_, PROJ_OUT, PP, WinT, scr, gw, ngw, lane);
        transpose_all<0>(a.w_att, 1024, D_, D_, WattT, scr, gw, ngw, lane);
        transpose_all<0>(a.w_ml, 1024, D_, D_, WmlT, scr, gw, ngw, lane);
        transpose_all<0>(a.w_out, D_, D_, D_, WoutT, scr, gw, ngw, lane);
        for (int it = gw; it < 72 * 32; it += ngw) {
            const int cgp = it % 72, kc = it / 72, col = cgp * 256 + 4 * lane;
            f32x4 s0 = {0.f, 0.f, 0.f, 0.f}, s1 = {0.f, 0.f, 0.f, 0.f};
#pragma unroll 8
            for (int kk = 0; kk < 64; ++kk) {
                const int k = kc * 64 + kk;
                const float c0 = a.c[k], c1 = a.c[D_ + k];
                const float e0 = c0 * sigm(c0), e1 = c1 * sigm(c1);
                const f32x4 w4 = *(const f32x4*)(a.w_ada + (size_t)k * NMOD + col);
                s0 += w4 * e0; s1 += w4 * e1;
            }
            if (kc == 0) { const f32x4 bb = *(const f32x4*)(a.b_ada + col); s0 += bb; s1 += bb; }
#pragma unroll
            for (int e = 0; e < 4; ++e) { atomicAdd(mod + col + e, s0[e]); atomicAdd(mod + NMOD + col + e, s1[e]); }
        }
        for (int i = blockIdx.x * 512 + tid; i < M_ * 8; i += G * 512) {
            const int row = i >> 3, j = i & 7;
            const float invf = (j == 0) ? 1.0f : (j == 1) ? 0.19392274f : (j == 2) ? 0.03760603f : (j == 3) ? 0.0072926646f : (j == 4) ? 0.0014142136f : (j == 5) ? 0.0002742482f : (j == 6) ? 5.3182957e-05f : 1.0313385e-05f;
            const float ang = (float)a.pos[row] * invf;
            double f = (double)ang * 0.15915494309189535; f -= rint(f);
            rope[(size_t)row * 16 + j] = __builtin_amdgcn_cosf((float)f);
            rope[(size_t)row * 16 + 8 + j] = __builtin_amdgcn_sinf((float)f);
        }
        __syncthreads();
    }
    SEAM(0);
    if (IN(1)) norm_phase<false>(a.x, a.norm1_g, mod, 0, 2048, U, nullptr, nullptr, lds, tid, wave, lane);
    SEAM(1);
    if (IN(2)) { pg8::Gemm g{U, WfinT, M_, 2 * DFF, D_, D_}; pg8::StaticOrder S; S.init(M_, 2 * DFF, G, (int)blockIdx.x); EpiSwiglu E{ACT}; pg8::gemm_phase(lds, g, S, E); }
    SEAM(2);
    if (IN(3)) { pg8::Gemm g{ACT, WfoutT, M_, D_, DFF, DFF}; pg8::StaticOrder S; S.init(M_, D_, G, (int)blockIdx.x); EpiResid E{a.x, H, mod + 4096, 0.5f}; pg8::gemm_phase(lds, g, S, E); }
    SEAM(3);
    if (IN(4)) norm_phase<true>(H, a.norm2_g, mod, 6144, 8192, U, gif, a.w_in, lds, tid, wave, lane);
    SEAM(4);
    if (IN(5)) { pg8::Gemm g{U, WinT, M_, PP, D_, D_}; pg8::StaticOrder S; S.init(M_, PP, G, (int)blockIdx.x); EpiProj E{P, rope}; pg8::gemm_phase(lds, g, S, E); }
    SEAM(5);
    if (IN(6)) {
        for (int it = blockIdx.x; it < 256; it += G) attn_item(it, P, a.sinks, lds, tid, wave, lane);
        for (int it = blockIdx.x; it < 1024; it += G) m1_item(it, P, QK, gif, a.conv_w, a.conv_b, a.b_ig, a.b_fg, Cbuf, scal, lds, tid, wave, lane);
    }
    SEAM(6);
    if (IN(7)) m2_scan(Cbuf, CinB, scal, blockIdx.x * 512 + tid, G * 512);
    SEAM(7);
    if (IN(8)) for (int it = blockIdx.x; it < 1024; it += G) m3_item(it, P, QK, gif, a.b_ig, a.b_fg, CinB, scal, a.mnorm_g, lds, tid, wave, lane);
    SEAM(8);
    if (IN(9)) {
        { pg8::Gemm g{P + PC_Q, WattT, M_, D_, 1024, PP}; pg8::StaticOrder S; S.init(M_, D_, G, (int)blockIdx.x); EpiMerge E{P, 1}; pg8::gemm_phase(lds, g, S, E); }
        { pg8::Gemm g{P + PC_MV, WmlT, M_, D_, 1024, PP}; pg8::StaticOrder S; S.init(M_, D_, G, (int)blockIdx.x); EpiMerge E{P, 0}; pg8::gemm_phase(lds, g, S, E); }
    }
    SEAM(9);
    if (IN(10)) { pg8::Gemm g{P + PC_G, WoutT, M_, D_, D_, PP}; pg8::StaticOrder S; S.init(M_, D_, G, (int)blockIdx.x); EpiResid E{H, H, mod + 10240, 1.0f}; pg8::gemm_phase(lds, g, S, E); }
    SEAM(10);
    if (IN(11)) {
        LAS float* scr = (LAS float*)(lds + wave * 16384);
        transpose_all<1>(a.f2_in, D_, 2 * DFF, 2 * DFF, WfinT, scr, gw, ngw, lane);
        transpose_all<0>(a.f2_out, DFF, D_, D_, WfoutT, scr, gw, ngw, lane);
        norm_phase<false>(H, a.norm3_g, mod, 12288, 14336, U, nullptr, nullptr, lds, tid, wave, lane);
    }
    SEAM(11);
    if (IN(12)) { pg8::Gemm g{U, WfinT, M_, 2 * DFF, D_, D_}; pg8::StaticOrder S; S.init(M_, 2 * DFF, G, (int)blockIdx.x); EpiSwiglu E{ACT}; pg8::gemm_phase(lds, g, S, E); }
    SEAM(12);
    if (IN(13)) { pg8::Gemm g{ACT, WfoutT, M_, D_, DFF, DFF}; pg8::StaticOrder S; S.init(M_, D_, G, (int)blockIdx.x); EpiResid E{H, H, mod + 16384, 0.5f}; pg8::gemm_phase(lds, g, S, E); }
    SEAM(13);
    if (IN(14)) {
        for (int row = gw; row < M_; row += ngw) {
            f32x4* xr = (f32x4*)(H + (size_t)row * D_) + lane;
            f32x4 v[8]; float ss = 0.f;
#pragma unroll
            for (int j = 0; j < 8; ++j) { v[j] = xr[64 * j]; ss += (v[j][0] * v[j][0] + v[j][1] * v[j][1]) + (v[j][2] * v[j][2] + v[j][3] * v[j][3]); }
            const float rstd = 1.0f / sqrtf(wave_sum(ss) * (1.0f / D_) + EPS);
#pragma unroll
            for (int j = 0; j < 8; ++j) { const f32x4 g4 = *(const f32x4*)(a.final_g + 256 * j + 4 * lane); xr[64 * j] = (v[j] * rstd) * g4; }
        }
    }
#undef IN
#undef SEAM
}

extern "C" void kernel_launch(void* const* d_in, const int* in_sizes, int n_in, void* d_out, int out_size, void* d_ws, size_t ws_size, hipStream_t stream) {
    static int grid = 0;
    if (grid == 0) {
        if (n_in != 23 || out_size != M_ * D_ || ws_size < WS_END) { fprintf(stderr, "kernel_launch: unexpected shapes (n_in %d, out %d, ws %zu < %zu)\n", n_in, out_size, ws_size, (size_t)WS_END); grid = -1; return; }
        int dev = 0, cus = 0, per_cu = 0;
        (void)hipGetDevice(&dev);
        (void)hipDeviceGetAttribute(&cus, hipDeviceAttributeMultiprocessorCount, dev);
        (void)hipFuncSetAttribute((const void*)fwd_kernel, hipFuncAttributeMaxDynamicSharedMemorySize, LDS_BYTES);
        (void)hipOccupancyMaxActiveBlocksPerMultiprocessor(&per_cu, (const void*)fwd_kernel, 512, LDS_BYTES);
        if (per_cu < 1) per_cu = 1;
        (void)hipGetLastError();
        grid = cus * per_cu;
    }
    if (grid < 0) return;
#if MK_MULTI
    (void)hipMemsetAsync((char*)d_ws + WS_MOD, 0, CTL_ZERO_BYTES, stream);
#endif
    Args a{};
    a.x = (const float*)d_in[0]; a.c = (const float*)d_in[1]; a.pos = (const int*)d_in[2]; a.w_ada = (const float*)d_in[3]; a.b_ada = (const float*)d_in[4];
    a.norm1_g = (const float*)d_in[5]; a.f1_in = (const float*)d_in[6]; a.f1_out = (const float*)d_in[7]; a.norm2_g = (const float*)d_in[8]; a.w_in = (const float*)d_in[9];
    a.conv_w = (const float*)d_in[10]; a.conv_b = (const float*)d_in[11]; a.b_ig = (const float*)d_in[12]; a.b_fg = (const float*)d_in[13]; a.sinks = (const float*)d_in[14];
    a.mnorm_g = (const float*)d_in[15]; a.w_att = (const float*)d_in[16]; a.w_ml = (const float*)d_in[17]; a.w_out = (const float*)d_in[18]; a.norm3_g = (const float*)d_in[19];
    a.f2_in = (const float*)d_in[20]; a.f2_out = (const float*)d_in[21]; a.final_g = (const float*)d_in[22];
    a.out = (float*)d_out; a.ws = (unsigned char*)d_ws;
#if MK_MULTI
    for (int p = 0; p < N_PHASES; ++p) { a.ph_lo = p; a.ph_hi = p + 1; hipLaunchKernelGGL(fwd_kernel, dim3(grid), dim3(512), LDS_BYTES, stream, a); }
#else
    a.ph_lo = 0; a.ph_hi = N_PHASES;
    void* args[] = {&a};
    hipError_t e = hipLaunchCooperativeKernel((const void*)fwd_kernel, dim3(grid), dim3(512), args, LDS_BYTES, stream);
    if (e != hipSuccess) fprintf(stderr, "cooperative launch failed: %s (grid %d)\n", hipGetErrorString(e), grid);
#endif
}
```

```cpp
#include <hip/hip_runtime.h>
#include <hip/hip_cooperative_groups.h>
#include <cstdio>
#include <cstdint>
namespace cg = cooperative_groups;

#ifndef MK_MULTI
#define MK_MULTI 0
#endif

#define LAS __attribute__((address_space(3)))
typedef unsigned short bf16_t;
typedef short bf16x8 __attribute__((ext_vector_type(8)));
typedef float f32x4 __attribute__((ext_vector_type(4)));
typedef float f32x2 __attribute__((ext_vector_type(2)));
typedef unsigned u32x4 __attribute__((ext_vector_type(4)));
typedef unsigned u32x2 __attribute__((ext_vector_type(2)));

constexpr int M_ = 16384, D_ = 2048, T_ = 8192, DFF = 5632, NMOD = 18432, PROJ_OUT = 8456;
constexpr int PP = 8448;
constexpr int PC_Q = 0, PC_K = 1024, PC_V = 1152, PC_MQK = 1280, PC_MV = 2304, PC_MO = 3328, PC_G = 4352;
constexpr float EPS = 1e-6f;
constexpr size_t MiB = 1u << 20;
constexpr size_t WS_MOD = 0, MOD_BYTES = 2 * NMOD * 4, WS_BAR = 192 * 1024, CTL_ZERO_BYTES = 256 * 1024;
constexpr size_t WS_ROPE = 1 * MiB, WS_GIF = 2 * MiB, WS_SCAL = 2 * MiB + 512 * 1024;
constexpr size_t WS_WIN = 4 * MiB, WS_WATT = 37 * MiB, WS_WML = 41 * MiB, WS_WOUT = 45 * MiB;
constexpr size_t WS_U = 53 * MiB;
constexpr size_t WS_R = 117 * MiB;
constexpr size_t WS_WFIN = WS_R, WS_WFOUT = WS_R + 44 * MiB, WS_ACT = WS_R + 66 * MiB;
constexpr size_t WS_P = WS_R, WS_CBUF = WS_R + 264 * MiB;
constexpr size_t WS_CIN = WS_CBUF + (size_t)1024 * 257 * 128 * 4;
constexpr size_t WS_END = WS_CIN + (size_t)1024 * 257 * 128 * 2;
constexpr int LDS_BYTES = 147456;

namespace pg8 {
constexpr int BM = 256, BK = 64, HALF = 128, HTB = HALF * BK * 2, STAGE_BYTES = 8 * HTB, NXCD = 8, WGM = 8;
__host__ __device__ __forceinline__ int lds_byte(int r, int c) { const int st = (r >> 4) * 2 + (c >> 5), rr = r & 15, cc = c & 31, ob = rr * 64 + cc * 2; return st * 1024 + (ob ^ (((ob >> 9) & 1) << 5)); }
__host__ __device__ __forceinline__ void stage_rc(int b, int& R, int& C) { const int st = b / 1024, sb = b % 1024, swz = sb ^ (((sb >> 9) & 1) << 5); R = (st >> 1) * 16 + swz / 64; C = (st & 1) * 32 + (swz % 64) / 2; }
__host__ __device__ __forceinline__ int perm32(int rho) { const int n = rho >> 4, i = rho & 15; return 8 * (i >> 2) + 4 * n + (i & 3); }
struct Unit { int pm, pn; };
struct Gemm { const bf16_t* A; const bf16_t* Bt; int M, N, K, lda; };
struct StaticOrder {
    int nM, nN, nwg, G, c, wgm;
    __host__ __device__ void init(int M, int N, int G_, int c_, int wgm_ = WGM) { nM = M / BM; nN = N / BM; nwg = nM * nN; G = G_; c = c_; wgm = wgm_; }
    __host__ __device__ bool next(int i, Unit& u) const {
        const long L = (long)i * G + c; if (L >= nwg) return false;
        int wgid = (int)L; { const int q = nwg / NXCD, r = nwg % NXCD, xcd = wgid % NXCD, off = wgid / NXCD; wgid = (xcd < r ? xcd * (q + 1) : r * (q + 1) + (xcd - r) * q) + off; }
        const int nig = wgm * nN, gid = wgid / nig, fm = gid * wgm, gsz = (nM - fm) < wgm ? (nM - fm) : wgm;
        u.pm = fm + ((wgid % nig) % gsz); u.pn = (wgid % nig) / gsz; return true;
    }
};
__device__ __forceinline__ unsigned cvt_pk_bf16(float lo, float hi) { unsigned r; asm volatile("v_cvt_pk_bf16_f32 %0, %1, %2" : "=v"(r) : "v"(lo), "v"(hi)); return r; }

template <class Epi>
__device__ __forceinline__ void gemm_phase(LAS unsigned char* lds, const Gemm g, const StaticOrder& S, const Epi& E) {
    const int tid = threadIdx.x, wid = __builtin_amdgcn_readfirstlane(tid >> 6), lane = tid & 63, wr = wid >> 2, wc = wid & 3, fr = lane & 15, fq = lane >> 4;
    const int K = g.K, nt = K / BK, lda = g.lda;
    unsigned voffA[2], voffB[2];
#pragma unroll
    for (int i = 0; i < 2; ++i) { int R, C; stage_rc(tid * 16 + i * 8192, R, C); const int Rb = (R & ~31) + perm32(R & 31);
        voffA[i] = (unsigned)(R * lda + C) * 2u; voffB[i] = (unsigned)(Rb * K + C) * 2u; }
    const size_t kstep = (size_t)(BK * 2);
    const size_t hstepA = (size_t)HALF * lda * 2, hstepB = (size_t)HALF * K * 2;
    const size_t tstepA = 2 * hstepA, tstepB = 2 * hstepB;
    const unsigned ldsw = (unsigned)wid * 1024u;
    const int aoff = lds_byte(wr * 64 + fr, fq * 8), boff = lds_byte(wc * 32 + fr, fq * 8);
#define PG8_SA(b, h) (((b) * 2 + (h)) * HTB)
#define PG8_SB(b, h) ((4 + (b) * 2 + (h)) * HTB)
#define PG8_STAGE(bufoff, gbase, voff) do { _Pragma("unroll") for (int _i = 0; _i < 2; ++_i) \
        __builtin_amdgcn_global_load_lds((const unsigned*)((const char*)(gbase) + (voff)[_i]), (LAS unsigned*)(lds + (bufoff) + ldsw + _i * 8192), 16, 0, 0); } while (0)
#define PG8_LDA(dst, b, h) do { _Pragma("unroll") for (int m = 0; m < 4; ++m) _Pragma("unroll") for (int k = 0; k < 2; ++k) dst[m][k] = *(const LAS bf16x8*)(lds + PG8_SA(b, h) + aoff + m * 2048 + k * 1024); } while (0)
#define PG8_LDB(dst, b, h) do { _Pragma("unroll") for (int n = 0; n < 2; ++n) _Pragma("unroll") for (int k = 0; k < 2; ++k) dst[n][k] = *(const LAS bf16x8*)(lds + PG8_SB(b, h) + boff + n * 2048 + k * 1024); } while (0)
#define PG8_MMA(ai, bj, At, Bt) do { __builtin_amdgcn_s_setprio(1); _Pragma("unroll") for (int m = 0; m < 4; ++m) _Pragma("unroll") for (int n = 0; n < 2; ++n) _Pragma("unroll") for (int k = 0; k < 2; ++k) \
        acc[ai][bj][m][n] = __builtin_amdgcn_mfma_f32_16x16x32_bf16(Bt[n][k], At[m][k], acc[ai][bj][m][n], 0, 0, 0); __builtin_amdgcn_s_setprio(0); } while (0)
#define PG8_WAIT_V(n) asm volatile("s_waitcnt vmcnt(" #n ")" ::: "memory")
#define PG8_WAIT_L(n) asm volatile("s_waitcnt lgkmcnt(" #n ")" ::: "memory")
#define PG8_BAR __builtin_amdgcn_s_barrier()
#define PG8_SCHED __builtin_amdgcn_sched_barrier(0)
    Unit cur, nxt; int ui = 0;
    if (!S.next(0, cur)) return;
    f32x4 acc[2][2][4][2];
#pragma unroll
    for (int a = 0; a < 2; ++a)
#pragma unroll
        for (int b = 0; b < 2; ++b)
#pragma unroll
            for (int m = 0; m < 4; ++m)
#pragma unroll
                for (int n = 0; n < 2; ++n) acc[a][b][m][n] = (f32x4){0.f, 0.f, 0.f, 0.f};
    bf16x8 At[4][2], B0[2][2], B1[2][2];
    const char* cA = (const char*)g.A + (size_t)cur.pm * tstepA; const char* cB = (const char*)g.Bt + (size_t)cur.pn * tstepB;
    PG8_STAGE(PG8_SB(0, 0), cB, voffB); PG8_STAGE(PG8_SB(0, 1), cB + hstepB, voffB); PG8_STAGE(PG8_SA(0, 0), cA, voffA); PG8_STAGE(PG8_SA(0, 1), cA + hstepA, voffA);
    if (wr == 1) PG8_BAR;
    PG8_WAIT_V(2); PG8_BAR;
    PG8_STAGE(PG8_SB(1, 0), cB + kstep, voffB); PG8_STAGE(PG8_SA(1, 0), cA + kstep, voffA); PG8_STAGE(PG8_SB(1, 1), cB + hstepB + kstep, voffB);
    PG8_WAIT_V(6); PG8_BAR;
    for (;;) {
        const bool has_next = S.next(ui + 1, nxt);
        const char* nA = has_next ? (const char*)g.A + (size_t)nxt.pm * tstepA : cA; const char* nB = has_next ? (const char*)g.Bt + (size_t)nxt.pn * tstepB : cB;
        for (int t = 0; t < nt; t += 2) {
            const bool last = (t == nt - 2);
            const char* a1 = cA + (size_t)(t + 1) * kstep;
            const char* a2 = last ? nA : cA + (size_t)(t + 2) * kstep; const char* b2 = last ? nB : cB + (size_t)(t + 2) * kstep;
            const char* a3 = a2 + kstep; const char* b3 = b2 + kstep;
            PG8_LDB(B0, 0, 0); PG8_LDB(B1, 0, 1); PG8_SCHED; PG8_LDA(At, 0, 0); PG8_STAGE(PG8_SA(1, 1), a1 + hstepA, voffA);
            PG8_WAIT_V(8); PG8_WAIT_L(0); PG8_BAR; PG8_MMA(0, 0, At, B0); PG8_MMA(0, 1, At, B1); PG8_BAR; PG8_SCHED;
            PG8_LDA(At, 0, 1); PG8_STAGE(PG8_SB(0, 0), b2, voffB); PG8_STAGE(PG8_SB(0, 1), b2 + hstepB, voffB); PG8_STAGE(PG8_SA(0, 0), a2, voffA);
            PG8_WAIT_V(8); PG8_WAIT_L(0); PG8_BAR; PG8_MMA(1, 0, At, B0); PG8_MMA(1, 1, At, B1); PG8_BAR; PG8_SCHED;
            PG8_LDB(B0, 1, 0); PG8_LDB(B1, 1, 1); PG8_SCHED; PG8_LDA(At, 1, 0); PG8_STAGE(PG8_SA(0, 1), a2 + hstepA, voffA);
            PG8_WAIT_V(8); PG8_WAIT_L(0); PG8_BAR; PG8_MMA(0, 0, At, B0); PG8_MMA(0, 1, At, B1); PG8_BAR; PG8_SCHED;
            PG8_LDA(At, 1, 1); PG8_STAGE(PG8_SB(1, 0), b3, voffB); PG8_STAGE(PG8_SB(1, 1), b3 + hstepB, voffB); PG8_STAGE(PG8_SA(1, 0), a3, voffA);
            PG8_WAIT_V(8); PG8_WAIT_L(0); PG8_BAR; PG8_MMA(1, 0, At, B0); PG8_MMA(1, 1, At, B1); PG8_BAR; PG8_SCHED;
        }
        if (wr == 0) PG8_BAR;
        E(acc, cur, wr, wc, fr, fq);
        if (!has_next) break;
#pragma unroll
        for (int a = 0; a < 2; ++a)
#pragma unroll
            for (int b = 0; b < 2; ++b)
#pragma unroll
                for (int m = 0; m < 4; ++m)
#pragma unroll
                    for (int n = 0; n < 2; ++n) acc[a][b][m][n] = (f32x4){0.f, 0.f, 0.f, 0.f};
        cur = nxt; cA = nA; cB = nB; ++ui;
        if (wr == 1) PG8_BAR;
    }
    PG8_WAIT_V(0);
    PG8_BAR;
#undef PG8_SA
#undef PG8_SB
#undef PG8_STAGE
#undef PG8_LDA
#undef PG8_LDB
#undef PG8_MMA
#undef PG8_WAIT_V
#undef PG8_WAIT_L
#undef PG8_BAR
#undef PG8_SCHED
}
}
using pg8::cvt_pk_bf16;
using pg8::Unit;

__device__ __forceinline__ float bf2f(unsigned short h) { return __uint_as_float((unsigned)h << 16); }
__device__ __forceinline__ float bflo(unsigned w) { return __uint_as_float(w << 16); }
__device__ __forceinline__ float bfhi(unsigned w) { return __uint_as_float(w & 0xffff0000u); }
__device__ __forceinline__ unsigned short f2bf(float f) { return (unsigned short)(cvt_pk_bf16(f, 0.f) & 0xffffu); }
__device__ __forceinline__ float sigm(float x) { return __builtin_amdgcn_rcpf(1.f + __expf(-x)); }
__device__ __forceinline__ float wave_sum(float v) {
#pragma unroll
    for (int o = 1; o < 64; o <<= 1) v += __shfl_xor(v, o);
    return v;
}
__device__ __forceinline__ float wave_max(float v) {
#pragma unroll
    for (int o = 1; o < 64; o <<= 1) v = fmaxf(v, __shfl_xor(v, o));
    return v;
}
__device__ __forceinline__ float log_sigmoid(float x) { return fminf(x, 0.f) - log1pf(expf(-fabsf(x))); }
__device__ __forceinline__ bf16x8 pack8(f32x4 a, f32x4 b) {
    u32x4 w; w.x = cvt_pk_bf16(a[0], a[1]); w.y = cvt_pk_bf16(a[2], a[3]); w.z = cvt_pk_bf16(b[0], b[1]); w.w = cvt_pk_bf16(b[2], b[3]);
    return __builtin_bit_cast(bf16x8, w);
}
__device__ __forceinline__ int kperm32(int kl) { return 8 * ((kl & 15) >> 2) + (kl & 3) + 4 * (kl >> 4); }

struct EpiSwiglu {
    bf16_t* O;
    __device__ __forceinline__ void operator()(const f32x4 (&acc)[2][2][4][2], const Unit& u, int wr, int wc, int fr, int fq) const {
        const int row0 = u.pm * 256 + wr * 64 + fr, col0 = u.pn * 128 + wc * 32 + 8 * fq;
#pragma unroll
        for (int ai = 0; ai < 2; ++ai)
#pragma unroll
            for (int m = 0; m < 4; ++m) {
                bf16_t* rowp = O + (size_t)(row0 + ai * 128 + m * 16) * DFF + col0;
                float v[8];
#pragma unroll
                for (int n = 0; n < 2; ++n)
#pragma unroll
                    for (int e = 0; e < 4; ++e) { const float a = acc[ai][0][m][n][e], b = acc[ai][1][m][n][e]; v[n * 4 + e] = a * sigm(a) * b; }
                u32x4 w; w.x = cvt_pk_bf16(v[0], v[1]); w.y = cvt_pk_bf16(v[2], v[3]); w.z = cvt_pk_bf16(v[4], v[5]); w.w = cvt_pk_bf16(v[6], v[7]);
                *(u32x4*)rowp = w;
            }
    }
};
struct EpiResid {
    const float* base; float* out; const float* gate; float scale;
    __device__ __forceinline__ void operator()(const f32x4 (&acc)[2][2][4][2], const Unit& u, int wr, int wc, int fr, int fq) const {
        const int row0 = u.pm * 256 + wr * 64 + fr, col0 = u.pn * 256 + wc * 32 + 8 * fq;
        const float* gp = gate + (size_t)(u.pm >> 5) * NMOD + col0;
        f32x4 gv[2][2];
#pragma unroll
        for (int bj = 0; bj < 2; ++bj)
#pragma unroll
            for (int n = 0; n < 2; ++n) gv[bj][n] = *(const f32x4*)(gp + bj * 128 + 4 * n) * scale;
#pragma unroll
        for (int ai = 0; ai < 2; ++ai)
#pragma unroll
            for (int m = 0; m < 4; ++m) {
                const size_t off = (size_t)(row0 + ai * 128 + m * 16) * D_ + col0;
#pragma unroll
                for (int bj = 0; bj < 2; ++bj)
#pragma unroll
                    for (int n = 0; n < 2; ++n) { const f32x4 bs = *(const f32x4*)(base + off + bj * 128 + 4 * n); *(f32x4*)(out + off + bj * 128 + 4 * n) = bs + gv[bj][n] * acc[ai][bj][m][n]; }
            }
    }
};
struct EpiProj {
    bf16_t* P; const float* rope;
    __device__ __forceinline__ void operator()(const f32x4 (&acc)[2][2][4][2], const Unit& u, int wr, int wc, int fr, int fq) const {
        const int row0 = u.pm * 256 + wr * 64 + fr, col0 = u.pn * 256 + wc * 32 + 8 * fq;
        const bool sig = u.pn >= 13;
        const bool ropelane = ((wc & 1) == 0) && (fq < 2) && (u.pn <= 4);
#pragma unroll
        for (int ai = 0; ai < 2; ++ai)
#pragma unroll
            for (int m = 0; m < 4; ++m) {
                const int row = row0 + ai * 128 + m * 16;
                f32x4 cs = {1.f, 1.f, 1.f, 1.f}, sn = {0.f, 0.f, 0.f, 0.f};
                if (ropelane) { cs = *(const f32x4*)(rope + (size_t)row * 16 + fq * 4); sn = *(const f32x4*)(rope + (size_t)row * 16 + 8 + fq * 4); }
#pragma unroll
                for (int bj = 0; bj < 2; ++bj) {
                    f32x4 v0 = acc[ai][bj][m][0], v1 = acc[ai][bj][m][1];
                    if (ropelane && (u.pn < 4 || bj == 0)) { const f32x4 x1 = v0, x2 = v1; v0 = x1 * cs - x2 * sn; v1 = x2 * cs + x1 * sn; }
                    if (sig) {
#pragma unroll
                        for (int e = 0; e < 4; ++e) { v0[e] = sigm(v0[e]); v1[e] = sigm(v1[e]); }
                    }
                    u32x4 w; w.x = cvt_pk_bf16(v0[0], v0[1]); w.y = cvt_pk_bf16(v0[2], v0[3]); w.z = cvt_pk_bf16(v1[0], v1[1]); w.w = cvt_pk_bf16(v1[2], v1[3]);
                    *(u32x4*)(P + (size_t)row * PP + col0 + bj * 128) = w;
                }
            }
    }
};
struct EpiMerge {
    bf16_t* P; int first;
    __device__ __forceinline__ void operator()(const f32x4 (&acc)[2][2][4][2], const Unit& u, int wr, int wc, int fr, int fq) const {
        const int row0 = u.pm * 256 + wr * 64 + fr, col0 = u.pn * 256 + wc * 32 + 8 * fq;
#pragma unroll
        for (int ai = 0; ai < 2; ++ai)
#pragma unroll
            for (int m = 0; m < 4; ++m)
#pragma unroll
                for (int bj = 0; bj < 2; ++bj) {
                    bf16_t* zp = P + (size_t)(row0 + ai * 128 + m * 16) * PP + PC_G + col0 + bj * 128;
                    const u32x4 z8 = *(const u32x4*)zp;
                    u32x4 g8 = z8; if (!first) g8 = *(const u32x4*)(zp + 2048);
                    const f32x4 a0 = acc[ai][bj][m][0], a1 = acc[ai][bj][m][1];
                    float o[8];
                    o[0] = bflo(g8.x) * a0[0]; o[1] = bfhi(g8.x) * a0[1]; o[2] = bflo(g8.y) * a0[2]; o[3] = bfhi(g8.y) * a0[3];
                    o[4] = bflo(g8.z) * a1[0]; o[5] = bfhi(g8.z) * a1[1]; o[6] = bflo(g8.w) * a1[2]; o[7] = bfhi(g8.w) * a1[3];
                    if (!first) { o[0] += bflo(z8.x); o[1] += bfhi(z8.x); o[2] += bflo(z8.y); o[3] += bfhi(z8.y); o[4] += bflo(z8.z); o[5] += bfhi(z8.z); o[6] += bflo(z8.w); o[7] += bfhi(z8.w); }
                    u32x4 w; w.x = cvt_pk_bf16(o[0], o[1]); w.y = cvt_pk_bf16(o[2], o[3]); w.z = cvt_pk_bf16(o[4], o[5]); w.w = cvt_pk_bf16(o[6], o[7]);
                    *(u32x4*)zp = w;
                }
    }
};

struct Args {
    const float* x; const float* c; const int* pos; const float* w_ada; const float* b_ada; const float* norm1_g;
    const float* f1_in; const float* f1_out; const float* norm2_g; const float* w_in; const float* conv_w; const float* conv_b;
    const float* b_ig; const float* b_fg; const float* sinks; const float* mnorm_g; const float* w_att; const float* w_ml;
    const float* w_out; const float* norm3_g; const float* f2_in; const float* f2_out; const float* final_g;
    float* out; unsigned char* ws; int ph_lo, ph_hi;
};

template <int KIND> __device__ __forceinline__ int srccol(int n) {
    if (KIND == 0) return n;
    if (KIND == 1) { const int pn = n >> 8, bj = (n >> 7) & 1, i = n & 127; return bj * DFF + pn * 128 + i; }
    if (n < PC_V) { const int d = n & 63; if (d < 16) { const int g = d >> 2; const int dd = (g == 1) ? d + 4 : (g == 2) ? d - 4 : d; return (n & ~63) + dd; } return n; }
    if (n < PC_MO) return n;
    return n + 8;
}
template <int KIND> __device__ __forceinline__ void transpose_item(const float* W, int K, int N, bf16_t* WT, LAS float* scr, int item, int lane, int nblk) {
    const int kb = item / nblk, nb = item % nblk, k0 = 64 * kb, n0 = 32 * nb;
    const int sc = srccol<KIND>(n0 + (lane & 31));
#pragma unroll 8
    for (int i = 0; i < 32; ++i) { const int kk = 2 * i + (lane >> 5); scr[kk * 33 + (lane & 31)] = W[(size_t)(k0 + kk) * N + sc]; }
    asm volatile("s_waitcnt lgkmcnt(0)" ::: "memory");
    const int c = lane & 7;
#pragma unroll
    for (int j = 0; j < 4; ++j) { const int n = (lane >> 3) + 8 * j; const LAS float* s = scr + (8 * c) * 33 + n;
        u32x4 o; o.x = cvt_pk_bf16(s[0 * 33], s[1 * 33]); o.y = cvt_pk_bf16(s[2 * 33], s[3 * 33]); o.z = cvt_pk_bf16(s[4 * 33], s[5 * 33]); o.w = cvt_pk_bf16(s[6 * 33], s[7 * 33]);
        *(u32x4*)(WT + (size_t)(n0 + n) * K + k0 + 8 * c) = o; }
    asm volatile("s_waitcnt lgkmcnt(0)" ::: "memory");
}
template <int KIND> __device__ __forceinline__ void transpose_all(const float* W, int K, int N, int Nout, bf16_t* WT, LAS float* scr, int gw, int ngw, int lane) {
    const int nblk = Nout / 32, items = (K / 64) * nblk;
    for (int it = gw; it < items; it += ngw) transpose_item<KIND>(W, K, N, WT, scr, it, lane, nblk);
}

template <bool GATES> __device__ __forceinline__ void norm_phase(const float* hin, const float* g, const float* mod, int sh_off, int sc_off, bf16_t* uout,
                                                                 float* gif, const float* w_in, LAS unsigned char* lds, int tid, int wave, int lane) {
    LAS float* wgT = (LAS float*)lds;
    if (GATES) {
        for (int idx = tid; idx < 2048 * 8; idx += 512) { const int k = idx >> 3, j = idx & 7; wgT[j * 2048 + k] = w_in[(size_t)k * PROJ_OUT + 3328 + j]; }
        __syncthreads();
    }
    const int gw = blockIdx.x * 8 + wave, ngw = gridDim.x * 8;
    for (int row = gw; row < M_; row += ngw) {
        const int b = row >> 13;
        const f32x4* xr = (const f32x4*)(hin + (size_t)row * D_) + lane;
        f32x4 v[8]; float ss = 0.f;
#pragma unroll
        for (int j = 0; j < 8; ++j) { v[j] = xr[64 * j]; ss += (v[j][0] * v[j][0] + v[j][1] * v[j][1]) + (v[j][2] * v[j][2] + v[j][3] * v[j][3]); }
        const float rstd = 1.0f / sqrtf(wave_sum(ss) * (1.0f / D_) + EPS);
        float ga[8];
#pragma unroll
        for (int i = 0; i < 8; ++i) ga[i] = 0.f;
#pragma unroll
        for (int j = 0; j < 8; ++j) {
            const int col = 256 * j + 4 * lane;
            const f32x4 g4 = *(const f32x4*)(g + col), sc4 = *(const f32x4*)(mod + (size_t)b * NMOD + sc_off + col), sh4 = *(const f32x4*)(mod + (size_t)b * NMOD + sh_off + col);
            const f32x4 y = (v[j] * rstd) * g4 * (sc4 + 1.0f) + sh4;
            u32x2 w; w.x = cvt_pk_bf16(y[0], y[1]); w.y = cvt_pk_bf16(y[2], y[3]);
            *(u32x2*)(uout + (size_t)row * D_ + col) = w;
            if (GATES) {
#pragma unroll
                for (int i = 0; i < 8; ++i) { const f32x4 w4 = *(const LAS f32x4*)(wgT + i * 2048 + col); ga[i] += (y[0] * w4[0] + y[1] * w4[1]) + (y[2] * w4[2] + y[3] * w4[3]); }
            }
        }
        if (GATES) {
#pragma unroll
            for (int i = 0; i < 8; ++i) ga[i] = wave_sum(ga[i]);
            if (lane == 0) { *(f32x4*)(gif + (size_t)row * 8) = (f32x4){ga[0], ga[1], ga[2], ga[3]}; *(f32x4*)(gif + (size_t)row * 8 + 4) = (f32x4){ga[4], ga[5], ga[6], ga[7]}; }
        }
    }
    if (GATES) __syncthreads();
}

__device__ __forceinline__ void attn_item(int item, bf16_t* P, const float* sinks, LAS unsigned char* lds, int tid, int wave, int lane) {
    const int kvh = item & 1, nb = (item >> 1) & 63, b = item >> 7;
    const int r0 = b * T_ + nb * 128;
    LAS bf16_t* Ksh = (LAS bf16_t*)lds;
    LAS bf16_t* VT = (LAS bf16_t*)(lds + 36864);
#pragma unroll
    for (int i = 0; i < 4; ++i) {
        const int chunk = tid + 512 * i, key = chunk >> 3, c8 = chunk & 7;
        const bool valid = (nb > 0) || (key >= 128);
        u32x4 kv = {0u, 0u, 0u, 0u}, vv = {0u, 0u, 0u, 0u};
        if (valid) { const bf16_t* rp = P + (size_t)(r0 - 128 + key) * PP; kv = *(const u32x4*)(rp + PC_K + kvh * 64 + c8 * 8); vv = *(const u32x4*)(rp + PC_V + kvh * 64 + c8 * 8); }
        *(LAS u32x4*)(Ksh + key * 72 + c8 * 8) = kv;
        const int pos = (key & ~31) + kperm32(key & 31);
        LAS bf16_t* vp = VT + (c8 * 8) * 264 + pos;
        vp[0 * 264] = (bf16_t)(vv.x & 0xffff); vp[1 * 264] = (bf16_t)(vv.x >> 16); vp[2 * 264] = (bf16_t)(vv.y & 0xffff); vp[3 * 264] = (bf16_t)(vv.y >> 16);
        vp[4 * 264] = (bf16_t)(vv.z & 0xffff); vp[5 * 264] = (bf16_t)(vv.z >> 16); vp[6 * 264] = (bf16_t)(vv.w & 0xffff); vp[7 * 264] = (bf16_t)(vv.w >> 16);
    }
    __syncthreads();
    const int h = kvh * 8 + wave, fr = lane & 15, fq = lane >> 4;
    const float sink = sinks[h];
    for (int qg = 0; qg < 8; ++qg) {
        const int qrow = r0 + qg * 16 + fr;
        bf16_t* qp = P + (size_t)qrow * PP + h * 64;
        const bf16x8 bq0 = *(const bf16x8*)(qp + 8 * fq), bq1 = *(const bf16x8*)(qp + 32 + 8 * fq);
        const int t0e = qg & ~1;
        f32x4 s[10];
#pragma unroll
        for (int tt = 0; tt < 10; ++tt) {
            const int t = min(t0e + tt, 15);
            const LAS bf16_t* kp = Ksh + (t * 16 + fr) * 72 + 8 * fq;
            const bf16x8 a0 = *(const LAS bf16x8*)kp, a1 = *(const LAS bf16x8*)(kp + 32);
            f32x4 z = {0.f, 0.f, 0.f, 0.f};
            z = __builtin_amdgcn_mfma_f32_16x16x32_bf16(a0, bq0, z, 0, 0, 0);
            s[tt] = __builtin_amdgcn_mfma_f32_16x16x32_bf16(a1, bq1, z, 0, 0, 0);
        }
        const int qi = 128 + qg * 16 + fr;
        float mx = -1e30f;
#pragma unroll
        for (int tt = 0; tt < 10; ++tt)
#pragma unroll
            for (int r = 0; r < 4; ++r) {
                const int kj = (t0e + tt) * 16 + 4 * fq + r;
                const bool ok = (kj <= qi) && (kj > qi - 128) && ((nb > 0) || (kj >= 128));
                const float sv = ok ? s[tt][r] * 0.125f : -1e30f;
                s[tt][r] = sv; mx = fmaxf(mx, sv);
            }
        mx = fmaxf(mx, __shfl_xor(mx, 16)); mx = fmaxf(mx, __shfl_xor(mx, 32)); mx = fmaxf(mx, sink);
        float sum = 0.f;
#pragma unroll
        for (int tt = 0; tt < 10; ++tt)
#pragma unroll
            for (int r = 0; r < 4; ++r) { const float p = __expf(s[tt][r] - mx); s[tt][r] = p; sum += p; }
        sum += __shfl_xor(sum, 16); sum += __shfl_xor(sum, 32);
        const float inv = 1.0f / (sum + __expf(sink - mx));
        bf16x8 bp[5];
#pragma unroll
        for (int g = 0; g < 5; ++g) bp[g] = pack8(s[2 * g], s[2 * g + 1]);
#pragma unroll
        for (int dt = 0; dt < 4; ++dt) {
            f32x4 o = {0.f, 0.f, 0.f, 0.f};
#pragma unroll
            for (int g = 0; g < 5; ++g) {
                const int grp = min((t0e >> 1) + g, 7);
                const bf16x8 a = *(const LAS bf16x8*)(VT + (dt * 16 + fr) * 264 + grp * 32 + 8 * fq);
                o = __builtin_amdgcn_mfma_f32_16x16x32_bf16(a, bp[g], o, 0, 0, 0);
            }
            u32x2 w; w.x = cvt_pk_bf16(o[0] * inv, o[1] * inv); w.y = cvt_pk_bf16(o[2] * inv, o[3] * inv);
            *(u32x2*)(qp + dt * 16 + 4 * fq) = w;
        }
    }
    __syncthreads();
}

__device__ __forceinline__ void m1_item(int item, const bf16_t* P, bf16_t* QK, const float* gif, const float* conv_w, const float* conv_b, const float* b_ig, const float* b_fg,
                                        float* Cbuf, float* scal, LAS unsigned char* lds, int tid, int wave, int lane) {
    const int c = item & 127, h = (item >> 7) & 3, b = item >> 9;
    const int r0 = b * T_ + c * 64;
    LAS bf16_t* VT = (LAS bf16_t*)lds;
    LAS bf16_t* KT = (LAS bf16_t*)(lds + 39168);
    LAS float* wl = (LAS float*)(lds + 57600);
    if (wave == 0) {
        const int row = r0 + lane;
        const float fpre = gif[(size_t)row * 8 + 4 + h] + b_fg[h], ipre = gif[(size_t)row * 8 + h] + b_ig[h];
        float bc = log_sigmoid(fpre);
#pragma unroll
        for (int o = 1; o < 64; o <<= 1) { const float t = __shfl_up(bc, o); if (lane >= o) bc += t; }
        const float blast = __shfl(bc, 63);
        const float gg = blast - bc + ipre;
        const float gmax = wave_max(gg);
        wl[lane] = expf(gg - gmax);
        if (lane == 0) { scal[item * 4 + 0] = gmax; scal[item * 4 + 1] = blast; }
    }
    for (int idx = tid; idx < 16 * 72; idx += 512) VT[256 * 72 + idx] = (idx < 64) ? (bf16_t)0x3F80 : (bf16_t)0;
    __syncthreads();
#pragma unroll
    for (int i = 0; i < 4; ++i) {
        const int task = tid + 512 * i, tl = task & 63, ch8 = task >> 6, qk = ch8 >> 4, j0 = (ch8 & 15) * 8;
        const int chan = qk * 512 + h * 128 + j0;
        float a[8];
        { const f32x4 b0 = *(const f32x4*)(conv_b + chan), b1 = *(const f32x4*)(conv_b + chan + 4); a[0] = b0[0]; a[1] = b0[1]; a[2] = b0[2]; a[3] = b0[3]; a[4] = b1[0]; a[5] = b1[1]; a[6] = b1[2]; a[7] = b1[3]; }
#pragma unroll
        for (int kk = 0; kk < 4; ++kk) {
            const int ts = c * 64 + tl - 3 + kk;
            if (ts >= 0) {
                const u32x4 x8 = *(const u32x4*)(P + (size_t)(b * T_ + ts) * PP + PC_MQK + chan);
                const f32x4 w0 = *(const f32x4*)(conv_w + kk * 1024 + chan), w1 = *(const f32x4*)(conv_w + kk * 1024 + chan + 4);
                a[0] += w0[0] * bflo(x8.x); a[1] += w0[1] * bfhi(x8.x); a[2] += w0[2] * bflo(x8.y); a[3] += w0[3] * bfhi(x8.y);
                a[4] += w1[0] * bflo(x8.z); a[5] += w1[1] * bfhi(x8.z); a[6] += w1[2] * bflo(x8.w); a[7] += w1[3] * bfhi(x8.w);
            }
        }
        const float ksc = qk ? 0.08838834764831845f : 1.0f;
#pragma unroll
        for (int e = 0; e < 8; ++e) a[e] = a[e] * sigm(a[e]) * ksc;
        u32x4 w; w.x = cvt_pk_bf16(a[0], a[1]); w.y = cvt_pk_bf16(a[2], a[3]); w.z = cvt_pk_bf16(a[4], a[5]); w.w = cvt_pk_bf16(a[6], a[7]);
        *(u32x4*)(QK + (size_t)(r0 + tl) * 1024 + chan) = w;
        if (qk) {
            const float wt = wl[tl];
#pragma unroll
            for (int e = 0; e < 8; ++e) KT[(j0 + e) * 72 + tl] = f2bf(a[e] * wt);
        }
    }
#pragma unroll
    for (int i = 0; i < 4; ++i) {
        const int task = tid + 512 * i, tl = task & 63, ce = task >> 6;
        const u32x4 vv = *(const u32x4*)(P + (size_t)(r0 + tl) * PP + PC_MV + h * 256 + ce * 8);
        LAS bf16_t* vp = VT + (ce * 8) * 72 + tl;
        vp[0 * 72] = (bf16_t)(vv.x & 0xffff); vp[1 * 72] = (bf16_t)(vv.x >> 16); vp[2 * 72] = (bf16_t)(vv.y & 0xffff); vp[3 * 72] = (bf16_t)(vv.y >> 16);
        vp[4 * 72] = (bf16_t)(vv.z & 0xffff); vp[5 * 72] = (bf16_t)(vv.z >> 16); vp[6 * 72] = (bf16_t)(vv.w & 0xffff); vp[7 * 72] = (bf16_t)(vv.w >> 16);
    }
    __syncthreads();
    const int fr = lane & 15, fq = lane >> 4;
    float* Cit = Cbuf + (size_t)item * 257 * 128;
#pragma unroll
    for (int et2 = 0; et2 < 2; ++et2) {
        const int et = 2 * wave + et2;
        const bf16x8 v0 = *(const LAS bf16x8*)(VT + (et * 16 + fr) * 72 + 8 * fq), v1 = *(const LAS bf16x8*)(VT + (et * 16 + fr) * 72 + 32 + 8 * fq);
#pragma unroll
        for (int dt = 0; dt < 8; ++dt) {
            const bf16x8 k0 = *(const LAS bf16x8*)(KT + (dt * 16 + fr) * 72 + 8 * fq), k1 = *(const LAS bf16x8*)(KT + (dt * 16 + fr) * 72 + 32 + 8 * fq);
            f32x4 z = {0.f, 0.f, 0.f, 0.f};
            z = __builtin_amdgcn_mfma_f32_16x16x32_bf16(k0, v0, z, 0, 0, 0);
            z = __builtin_amdgcn_mfma_f32_16x16x32_bf16(k1, v1, z, 0, 0, 0);
            *(f32x4*)(Cit + (size_t)(et * 16 + fr) * 128 + dt * 16 + 4 * fq) = z;
        }
    }
    if (wave == 0) {
        const bf16x8 v0 = *(const LAS bf16x8*)(VT + (256 + fr) * 72 + 8 * fq), v1 = *(const LAS bf16x8*)(VT + (256 + fr) * 72 + 32 + 8 * fq);
#pragma unroll
        for (int dt = 0; dt < 8; ++dt) {
            const bf16x8 k0 = *(const LAS bf16x8*)(KT + (dt * 16 + fr) * 72 + 8 * fq), k1 = *(const LAS bf16x8*)(KT + (dt * 16 + fr) * 72 + 32 + 8 * fq);
            f32x4 z = {0.f, 0.f, 0.f, 0.f};
            z = __builtin_amdgcn_mfma_f32_16x16x32_bf16(k0, v0, z, 0, 0, 0);
            z = __builtin_amdgcn_mfma_f32_16x16x32_bf16(k1, v1, z, 0, 0, 0);
            if (fr == 0) *(f32x4*)(Cit + (size_t)256 * 128 + dt * 16 + 4 * fq) = z;
        }
    }
    __syncthreads();
}

__device__ __forceinline__ void m2_scan(const float* Cbuf, bf16_t* Cin, float* scal, int gtid, int gthreads) {
    constexpr int PER_BH = 257 * 32, TOTAL = 8 * PER_BH;
    constexpr size_t CSTRIDE = (size_t)257 * 128;
    for (int w = gtid; w < TOTAL; w += gthreads) {
        const int bh = w / PER_BH, rem = w % PER_BH, e = rem >> 5, d4 = (rem & 31) * 4;
        const size_t off = ((size_t)bh * 128 * 257 + e) * 128 + d4;
        const float* ptr = Cbuf + off; bf16_t* optr = Cin + off;
        const bool lead = (rem == 0);
        f32x4 C = {0.f, 0.f, 0.f, 0.f}; float m = -1e30f;
        for (int c0 = 0; c0 < 128; c0 += 8) {
            f32x4 cl[8]; float gm[8], bl[8];
#pragma unroll
            for (int u = 0; u < 8; ++u) { cl[u] = *(const f32x4*)(ptr + (size_t)(c0 + u) * CSTRIDE); gm[u] = scal[(bh * 128 + c0 + u) * 4]; bl[u] = scal[(bh * 128 + c0 + u) * 4 + 1]; }
#pragma unroll
            for (int u = 0; u < 8; ++u) {
                u32x2 o; o.x = cvt_pk_bf16(C[0], C[1]); o.y = cvt_pk_bf16(C[2], C[3]);
                *(u32x2*)(optr + (size_t)(c0 + u) * CSTRIDE) = o;
                if (lead) scal[(bh * 128 + c0 + u) * 4 + 2] = m;
                const float mn = fmaxf(bl[u] + m, gm[u]);
                const float a = expf(bl[u] + m - mn), sc = expf(gm[u] - mn);
                C = C * a + cl[u] * sc; m = mn;
            }
        }
    }
}

__device__ __forceinline__ void m3_item(int item, bf16_t* P, const bf16_t* QK, const float* gif, const float* b_ig, const float* b_fg, const bf16_t* Cbuf, const float* scal,
                                        const float* norm_g, LAS unsigned char* lds, int tid, int wave, int lane) {
    const int c = item & 127, h = (item >> 7) & 3, b = item >> 9;
    const int r0 = b * T_ + c * 64;
    LAS bf16_t* VT = (LAS bf16_t*)lds;
    LAS float* tb = (LAS float*)(lds + 36864);
    LAS float* red = tb + 256;
    if (wave == 0) {
        const int row = r0 + lane;
        const float fpre = gif[(size_t)row * 8 + 4 + h] + b_fg[h], ipre = gif[(size_t)row * 8 + h] + b_ig[h];
        float bc = log_sigmoid(fpre);
#pragma unroll
        for (int o = 1; o < 64; o <<= 1) { const float t = __shfl_up(bc, o); if (lane >= o) bc += t; }
        const float gs = ipre - bc;
        float mxs = gs;
#pragma unroll
        for (int o = 1; o < 64; o <<= 1) { const float t = __shfl_up(mxs, o); if (lane >= o) mxs = fmaxf(mxs, t); }
        const float m_in = scal[item * 4 + 2];
        const float alog = bc + m_in;
        const float mt = fmaxf(alog, bc + mxs);
        tb[lane] = bc; tb[64 + lane] = gs; tb[128 + lane] = mt; tb[192 + lane] = expf(alog - mt);
    }
#pragma unroll
    for (int i = 0; i < 4; ++i) {
        const int task = tid + 512 * i, tl = task & 63, ce = task >> 6;
        const u32x4 vv = *(const u32x4*)(P + (size_t)(r0 + tl) * PP + PC_MV + h * 256 + ce * 8);
        const int pos = (tl & 32) + kperm32(tl & 31);
        LAS bf16_t* vp = VT + (ce * 8) * 72 + pos;
        vp[0 * 72] = (bf16_t)(vv.x & 0xffff); vp[1 * 72] = (bf16_t)(vv.x >> 16); vp[2 * 72] = (bf16_t)(vv.y & 0xffff); vp[3 * 72] = (bf16_t)(vv.y >> 16);
        vp[4 * 72] = (bf16_t)(vv.z & 0xffff); vp[5 * 72] = (bf16_t)(vv.z >> 16); vp[6 * 72] = (bf16_t)(vv.w & 0xffff); vp[7 * 72] = (bf16_t)(vv.w >> 16);
    }
    __syncthreads();
    const int fr = lane & 15, fq = lane >> 4, tt = wave & 3, eh = wave >> 2;
    const int t = tt * 16 + fr;
    const bf16_t* qp = QK + (size_t)(r0 + t) * 1024 + h * 128 + 8 * fq;
    bf16x8 bq[4];
#pragma unroll
    for (int ks = 0; ks < 4; ++ks) bq[ks] = *(const bf16x8*)(qp + ks * 32);
    f32x4 sacc[4];
#pragma unroll
    for (int st = 0; st < 4; ++st) {
        const bf16_t* kp = QK + (size_t)(r0 + st * 16 + fr) * 1024 + 512 + h * 128 + 8 * fq;
        f32x4 z = {0.f, 0.f, 0.f, 0.f};
#pragma unroll
        for (int ks = 0; ks < 4; ++ks) z = __builtin_amdgcn_mfma_f32_16x16x32_bf16(*(const bf16x8*)(kp + ks * 32), bq[ks], z, 0, 0, 0);
        sacc[st] = z;
    }
    const float bc_t = tb[t], mt_t = tb[128 + t], inter_t = tb[192 + t];
    float dsum = 0.f;
#pragma unroll
    for (int st = 0; st < 4; ++st)
#pragma unroll
        for (int r = 0; r < 4; ++r) {
            const int s = st * 16 + 4 * fq + r;
            const float wgt = (s <= t) ? __expf(bc_t + tb[64 + s] - mt_t) : 0.f;
            const float qk = sacc[st][r] * wgt; sacc[st][r] = qk; dsum += qk;
        }
    dsum += __shfl_xor(dsum, 16); dsum += __shfl_xor(dsum, 32);
    bf16x8 bp[2];
    bp[0] = pack8(sacc[0], sacc[1]); bp[1] = pack8(sacc[2], sacc[3]);
    const bf16_t* Cin = Cbuf + (size_t)item * 257 * 128;
    f32x4 acc[8];
#pragma unroll
    for (int et = 0; et < 8; ++et) {
        const bf16_t* cp = Cin + (size_t)((eh * 8 + et) * 16 + fr) * 128 + 8 * fq;
        f32x4 z = {0.f, 0.f, 0.f, 0.f};
#pragma unroll
        for (int ks = 0; ks < 4; ++ks) z = __builtin_amdgcn_mfma_f32_16x16x32_bf16(*(const bf16x8*)(cp + ks * 32), bq[ks], z, 0, 0, 0);
        acc[et] = z;
    }
    float qn;
    {
        const bf16_t* np = Cin + (size_t)256 * 128 + 8 * fq;
        f32x4 z = {0.f, 0.f, 0.f, 0.f};
#pragma unroll
        for (int ks = 0; ks < 4; ++ks) z = __builtin_amdgcn_mfma_f32_16x16x32_bf16(*(const bf16x8*)(np + ks * 32), bq[ks], z, 0, 0, 0);
        qn = z[0];
    }
#pragma unroll
    for (int et = 0; et < 8; ++et) {
        f32x4 z = acc[et] * inter_t;
#pragma unroll
        for (int g = 0; g < 2; ++g) z = __builtin_amdgcn_mfma_f32_16x16x32_bf16(*(const LAS bf16x8*)(VT + ((eh * 8 + et) * 16 + fr) * 72 + g * 32 + 8 * fq), bp[g], z, 0, 0, 0);
        acc[et] = z;
    }
    const float den = inter_t * qn + dsum;
    const float inv = 1.0f / fmaxf(fabsf(den), expf(-mt_t));
    float ss = 0.f;
#pragma unroll
    for (int et = 0; et < 8; ++et) { acc[et] = acc[et] * inv; ss += (acc[et][0] * acc[et][0] + acc[et][1] * acc[et][1]) + (acc[et][2] * acc[et][2] + acc[et][3] * acc[et][3]); }
    ss += __shfl_xor(ss, 16); ss += __shfl_xor(ss, 32);
    if (fq == 0) red[eh * 64 + t] = ss;
    __syncthreads();
    const float rstd = 1.0f / sqrtf((red[t] + red[64 + t]) * (1.0f / 256.0f) + EPS);
    bf16_t* prow = P + (size_t)(r0 + t) * PP;
#pragma unroll
    for (int et = 0; et < 8; ++et) {
        const int e0 = h * 256 + (eh * 8 + et) * 16 + 4 * fq;
        const f32x4 gn = *(const f32x4*)(norm_g + e0);
        const u32x2 mo = *(const u32x2*)(prow + PC_MO + e0);
        const f32x4 o = acc[et] * rstd * gn;
        u32x2 w; w.x = cvt_pk_bf16(o[0] * bflo(mo.x), o[1] * bfhi(mo.x)); w.y = cvt_pk_bf16(o[2] * bflo(mo.y), o[3] * bfhi(mo.y));
        *(u32x2*)(prow + PC_MV + e0) = w;
    }
    __syncthreads();
}


#define XB_TMO      128
#define XB_XCNT(j)  (256  + 64 * (j))
#define XB_XSUB(j)  (1280 + 64 * (j))
#define XB_XGEN(j)  (2304 + 64 * (j))
#define XB_TOP      3328
#define XB_TOPGEN   3392
#define XCD_BAR_WORDS 3456
#define XB_SPIN_CAP (1u << 20)
__device__ __forceinline__ unsigned xb_ld(unsigned* p)              { return __hip_atomic_load(p, __ATOMIC_RELAXED, __HIP_MEMORY_SCOPE_AGENT); }
__device__ __forceinline__ unsigned xb_add(unsigned* p, unsigned v) { return __hip_atomic_fetch_add(p, v, __ATOMIC_RELAXED, __HIP_MEMORY_SCOPE_AGENT); }
__device__ __forceinline__ unsigned xb_xcc_id() { return (unsigned)__builtin_amdgcn_s_getreg((3 << 11) | 20) & 0xFu; }
#define XB_SPIN(cond, bar) do { unsigned _sp = 0; while (cond) { __builtin_amdgcn_s_sleep(1); \
    if ((++_sp & 255u) == 0u) { if (xb_ld(&(bar)[XB_TMO])) break; if (_sp > XB_SPIN_CAP) { atomicAdd(&(bar)[XB_TMO], 1u); break; } } } } while (0)
struct XcdBarrier { unsigned* bar; unsigned x; volatile LAS unsigned* st; };
__device__ __forceinline__ XcdBarrier xcd_barrier_post(unsigned* bar, volatile LAS unsigned* st) {
    XcdBarrier b; b.bar = bar; b.x = xb_xcc_id(); b.st = st;
    if (threadIdx.x == 0) (void)xb_add(&bar[XB_XCNT(b.x)], 1u);
    return b;
}
__device__ __forceinline__ void xcd_barrier_complete(unsigned* bar, unsigned x, unsigned& nloc, unsigned& nx) {
    const unsigned G = gridDim.x * gridDim.y * gridDim.z;
    unsigned sum, cnt, mine, sp = 0u;
    for (;;) {
        sum = 0u; cnt = 0u; mine = 0u;
#pragma unroll
        for (unsigned j = 0; j < 16; ++j) { const unsigned c = xb_ld(&bar[XB_XCNT(j)]); sum += c; cnt += (c > 0u) ? 1u : 0u; mine = (j == x) ? c : mine; }
        if (sum == G) break;
        __builtin_amdgcn_s_sleep(1);
        if ((++sp & 255u) == 0u) { if (xb_ld(&bar[XB_TMO])) break; if (sp > XB_SPIN_CAP) { atomicAdd(&bar[XB_TMO], 1u); break; } }
    }
    nloc = mine > 0u ? mine : 1u; nx = cnt > 0u ? cnt : 1u;
}
__device__ __forceinline__ void xcd_barrier(const XcdBarrier& b) {
    asm volatile("s_waitcnt vmcnt(0)" ::: "memory");
    __syncthreads();
    if (threadIdx.x == 0) {
        unsigned* bar = b.bar;
        __builtin_amdgcn_s_waitcnt(0);
        unsigned nloc = b.st[0], nx = b.st[1];
        if (nloc == 0u) { xcd_barrier_complete(bar, b.x, nloc, nx); b.st[0] = nloc; b.st[1] = nx; }
        const unsigned old = xb_add(&bar[XB_XSUB(b.x)], 1u);
        const unsigned gen = old / nloc;
        if (old + 1u == (gen + 1u) * nloc) {
            __builtin_amdgcn_fence(__ATOMIC_RELEASE, "agent");
            asm volatile("s_waitcnt vmcnt(0)" ::: "memory");
            const unsigned og = xb_add(&bar[XB_TOP], 1u);
            const unsigned tg = og / nx;
            if (og + 1u == (tg + 1u) * nx) xb_add(&bar[XB_TOPGEN], 1u);
            else XB_SPIN(xb_ld(&bar[XB_TOPGEN]) == tg, bar);
            __builtin_amdgcn_fence(__ATOMIC_ACQUIRE, "agent");
            xb_add(&bar[XB_XGEN(b.x)], 1u);
            asm volatile("s_waitcnt vmcnt(0)" ::: "memory");
        } else {
            XB_SPIN(xb_ld(&bar[XB_XGEN(b.x)]) == gen, bar);
            __builtin_amdgcn_fence(__ATOMIC_ACQUIRE, "agent");
            asm volatile("s_waitcnt vmcnt(0)" ::: "memory");
        }
    }
    __syncthreads();
}

constexpr int N_PHASES = 15;
__global__ void __launch_bounds__(512, 2) fwd_kernel(Args a) {
    extern __shared__ __attribute__((aligned(16))) unsigned char lds_raw[];
    LAS unsigned char* lds = (LAS unsigned char*)lds_raw;
    const int tid = threadIdx.x, lane = tid & 63, wave = __builtin_amdgcn_readfirstlane(tid >> 6);
    const int G = gridDim.x;
    unsigned char* ws = a.ws;
    float* mod = (float*)(ws + WS_MOD); float* rope = (float*)(ws + WS_ROPE); float* gif = (float*)(ws + WS_GIF); float* scal = (float*)(ws + WS_SCAL);
    bf16_t* WinT = (bf16_t*)(ws + WS_WIN); bf16_t* WattT = (bf16_t*)(ws + WS_WATT); bf16_t* WmlT = (bf16_t*)(ws + WS_WML); bf16_t* WoutT = (bf16_t*)(ws + WS_WOUT);
    bf16_t* U = (bf16_t*)(ws + WS_U); bf16_t* QK = U;
    bf16_t* WfinT = (bf16_t*)(ws + WS_WFIN); bf16_t* WfoutT = (bf16_t*)(ws + WS_WFOUT); bf16_t* ACT = (bf16_t*)(ws + WS_ACT);
    bf16_t* P = (bf16_t*)(ws + WS_P); float* Cbuf = (float*)(ws + WS_CBUF); bf16_t* CinB = (bf16_t*)(ws + WS_CIN);
    float* H = a.out;
    const int lo = a.ph_lo, hi = a.ph_hi;
    const int gw = blockIdx.x * 8 + wave, ngw = G * 8;
#define IN(k) (lo <= (k) && (k) < hi)
#if MK_MULTI
#define SEAM(k) do {} while (0)
#else
#define SEAM(k) do { if (IN(k) && IN((k) + 1)) { xcd_barrier(xbar); } } while (0)
    volatile LAS unsigned* xst = (volatile LAS unsigned*)(lds + 131072);
    if (tid == 0) { xst[0] = 0u; xst[1] = 0u; }
    if (blockIdx.x == 0) for (int i = tid; i < XCD_BAR_WORDS; i += 512) __hip_atomic_store((unsigned*)(ws + WS_BAR) + i, 0u, __ATOMIC_RELAXED, __HIP_MEMORY_SCOPE_AGENT);
    for (int i = blockIdx.x * 512 + tid; i < 2 * NMOD; i += G * 512) __hip_atomic_store((unsigned*)mod + i, 0u, __ATOMIC_RELAXED, __HIP_MEMORY_SCOPE_AGENT);
    __threadfence();
    cg::this_grid().sync();
    const XcdBarrier xbar = xcd_barrier_post((unsigned*)(ws + WS_BAR), xst);
#endif
    if (IN(0)) {
        LAS float* scr = (LAS float*)(lds + wave * 16384);
        transpose_all<1>(a.f1_in, D_, 2 * DFF, 2 * DFF, WfinT, scr, gw, ngw, lane);
        transpose_all<0>(a.f1_out, DFF, D_, D_, WfoutT, scr, gw, ngw, lane);
        transpose_all<2>(a.w_in, D_, PROJ_OUT, PP, WinT, scr, gw, ngw, lane);
        transpose_all<0>(a.w_att, 1024, D_, D_, WattT, scr, gw, ngw, lane);
        transpose_all<0>(a.w_ml, 1024, D_, D_, WmlT, scr, gw, ngw, lane);
        transpose_all<0>(a.w_out, D_, D_, D_, WoutT, scr, gw, ngw, lane);
        for (int it = gw; it < 72 * 32; it += ngw) {
            const int cgp = it % 72, kc = it / 72, col = cgp * 256 + 4 * lane;
            f32x4 s0 = {0.f, 0.f, 0.f, 0.f}, s1 = {0.f, 0.f, 0.f, 0.f};
#pragma unroll 8
            for (int kk = 0; kk < 64; ++kk) {
                const int k = kc * 64 + kk;
                const float c0 = a.c[k], c1 = a.c[D_ + k];
                const float e0 = c0 * sigm(c0), e1 = c1 * sigm(c1);
                const f32x4 w4 = *(const f32x4*)(a.w_ada + (size_t)k * NMOD + col);
                s0 += w4 * e0; s1 += w4 * e1;
            }
            if (kc == 0) { const f32x4 bb = *(const f32x4*)(a.b_ada + col); s0 += bb; s1 += bb; }
#pragma unroll
            for (int e = 0; e < 4; ++e) { atomicAdd(mod + col + e, s0[e]); atomicAdd(mod + NMOD + col + e, s1[e]); }
        }
        for (int i = blockIdx.x * 512 + tid; i < M_ * 8; i += G * 512) {
            const int row = i >> 3, j = i & 7;
            const float invf = (j == 0) ? 1.0f : (j == 1) ? 0.19392274f : (j == 2) ? 0.03760603f : (j == 3) ? 0.0072926646f : (j == 4) ? 0.0014142136f : (j == 5) ? 0.0002742482f : (j == 6) ? 5.3182957e-05f : 1.0313385e-05f;
            const float ang = (float)a.pos[row] * invf;
            double f = (double)ang * 0.15915494309189535; f -= rint(f);
            rope[(size_t)row * 16 + j] = __builtin_amdgcn_cosf((float)f);
            rope[(size_t)row * 16 + 8 + j] = __builtin_amdgcn_sinf((float)f);
        }
        __syncthreads();
    }
    SEAM(0);
    if (IN(1)) norm_phase<false>(a.x, a.norm1_g, mod, 0, 2048, U, nullptr, nullptr, lds, tid, wave, lane);
    SEAM(1);
    if (IN(2)) { pg8::Gemm g{U, WfinT, M_, 2 * DFF, D_, D_}; pg8::StaticOrder S; S.init(M_, 2 * DFF, G, (int)blockIdx.x); EpiSwiglu E{ACT}; pg8::gemm_phase(lds, g, S, E); }
    SEAM(2);
    if (IN(3)) { pg8::Gemm g{ACT, WfoutT, M_, D_, DFF, DFF}; pg8::StaticOrder S; S.init(M_, D_, G, (int)blockIdx.x, 4); EpiResid E{a.x, H, mod + 4096, 0.5f}; pg8::gemm_phase(lds, g, S, E); }
    SEAM(3);
    if (IN(4)) norm_phase<true>(H, a.norm2_g, mod, 6144, 8192, U, gif, a.w_in, lds, tid, wave, lane);
    SEAM(4);
    if (IN(5)) { pg8::Gemm g{U, WinT, M_, PP, D_, D_}; pg8::StaticOrder S; S.init(M_, PP, G, (int)blockIdx.x); EpiProj E{P, rope}; pg8::gemm_phase(lds, g, S, E); }
    SEAM(5);
    if (IN(6)) {
        for (int it = blockIdx.x; it < 256; it += G) attn_item(it, P, a.sinks, lds, tid, wave, lane);
        for (int it = blockIdx.x; it < 1024; it += G) m1_item(it, P, QK, gif, a.conv_w, a.conv_b, a.b_ig, a.b_fg, Cbuf, scal, lds, tid, wave, lane);
    }
    SEAM(6);
    if (IN(7)) m2_scan(Cbuf, CinB, scal, blockIdx.x * 512 + tid, G * 512);
    SEAM(7);
    if (IN(8)) for (int it = blockIdx.x; it < 1024; it += G) m3_item(it, P, QK, gif, a.b_ig, a.b_fg, CinB, scal, a.mnorm_g, lds, tid, wave, lane);
    SEAM(8);
    if (IN(9)) {
        { pg8::Gemm g{P + PC_Q, WattT, M_, D_, 1024, PP}; pg8::StaticOrder S; S.init(M_, D_, G, (int)blockIdx.x, 4); EpiMerge E{P, 1}; pg8::gemm_phase(lds, g, S, E); }
        { pg8::Gemm g{P + PC_MV, WmlT, M_, D_, 1024, PP}; pg8::StaticOrder S; S.init(M_, D_, G, (int)blockIdx.x, 4); EpiMerge E{P, 0}; pg8::gemm_phase(lds, g, S, E); }
    }
    SEAM(9);
    if (IN(10)) { pg8::Gemm g{P + PC_G, WoutT, M_, D_, D_, PP}; pg8::StaticOrder S; S.init(M_, D_, G, (int)blockIdx.x, 4); EpiResid E{H, H, mod + 10240, 1.0f}; pg8::gemm_phase(lds, g, S, E); }
    SEAM(10);
    if (IN(11)) {
        LAS float* scr = (LAS float*)(lds + wave * 16384);
        transpose_all<1>(a.f2_in, D_, 2 * DFF, 2 * DFF, WfinT, scr, gw, ngw, lane);
        transpose_all<0>(a.f2_out, DFF, D_, D_, WfoutT, scr, gw, ngw, lane);
        norm_phase<false>(H, a.norm3_g, mod, 12288, 14336, U, nullptr, nullptr, lds, tid, wave, lane);
    }
    SEAM(11);
    if (IN(12)) { pg8::Gemm g{U, WfinT, M_, 2 * DFF, D_, D_}; pg8::StaticOrder S; S.init(M_, 2 * DFF, G, (int)blockIdx.x); EpiSwiglu E{ACT}; pg8::gemm_phase(lds, g, S, E); }
    SEAM(12);
    if (IN(13)) { pg8::Gemm g{ACT, WfoutT, M_, D_, DFF, DFF}; pg8::StaticOrder S; S.init(M_, D_, G, (int)blockIdx.x, 4); EpiResid E{H, H, mod + 16384, 0.5f}; pg8::gemm_phase(lds, g, S, E); }
    SEAM(13);
    if (IN(14)) {
        for (int row = gw; row < M_; row += ngw) {
            f32x4* xr = (f32x4*)(H + (size_t)row * D_) + lane;
            f32x4 v[8]; float ss = 0.f;
#pragma unroll
            for (int j = 0; j < 8; ++j) { v[j] = xr[64 * j]; ss += (v[j][0] * v[j][0] + v[j][1] * v[j][1]) + (v[j][2] * v[j][2] + v[j][3] * v[j][3]); }
            const float rstd = 1.0f / sqrtf(wave_sum(ss) * (1.0f / D_) + EPS);
#pragma unroll
            for (int j = 0; j < 8; ++j) { const f32x4 g4 = *(const f32x4*)(a.final_g + 256 * j + 4 * lane); xr[64 * j] = (v[j] * rstd) * g4; }
        }
    }
#undef IN
#undef SEAM
}

extern "C" void kernel_launch(void* const* d_in, const int* in_sizes, int n_in, void* d_out, int out_size, void* d_ws, size_t ws_size, hipStream_t stream) {
    static int grid = 0;
    if (grid == 0) {
        if (n_in != 23 || out_size != M_ * D_ || ws_size < WS_END) { fprintf(stderr, "kernel_launch: unexpected shapes (n_in %d, out %d, ws %zu < %zu)\n", n_in, out_size, ws_size, (size_t)WS_END); grid = -1; return; }
        int dev = 0, cus = 0, per_cu = 0;
        (void)hipGetDevice(&dev);
        (void)hipDeviceGetAttribute(&cus, hipDeviceAttributeMultiprocessorCount, dev);
        (void)hipFuncSetAttribute((const void*)fwd_kernel, hipFuncAttributeMaxDynamicSharedMemorySize, LDS_BYTES);
        (void)hipOccupancyMaxActiveBlocksPerMultiprocessor(&per_cu, (const void*)fwd_kernel, 512, LDS_BYTES);
        if (per_cu < 1) per_cu = 1;
        (void)hipGetLastError();
        grid = cus * per_cu;
    }
    if (grid < 0) return;
#if MK_MULTI
    (void)hipMemsetAsync((char*)d_ws + WS_MOD, 0, CTL_ZERO_BYTES, stream);
#endif
    Args a{};
    a.x = (const float*)d_in[0]; a.c = (const float*)d_in[1]; a.pos = (const int*)d_in[2]; a.w_ada = (const float*)d_in[3]; a.b_ada = (const float*)d_in[4];
    a.norm1_g = (const float*)d_in[5]; a.f1_in = (const float*)d_in[6]; a.f1_out = (const float*)d_in[7]; a.norm2_g = (const float*)d_in[8]; a.w_in = (const float*)d_in[9];
    a.conv_w = (const float*)d_in[10]; a.conv_b = (const float*)d_in[11]; a.b_ig = (const float*)d_in[12]; a.b_fg = (const float*)d_in[13]; a.sinks = (const float*)d_in[14];
    a.mnorm_g = (const float*)d_in[15]; a.w_att = (const float*)d_in[16]; a.w_ml = (const float*)d_in[17]; a.w_out = (const float*)d_in[18]; a.norm3_g = (const float*)d_in[19];
    a.f2_in = (const float*)d_in[20]; a.f2_out = (const float*)d_in[21]; a.final_g = (const float*)d_in[22];
    a.out = (float*)d_out; a.ws = (unsigned char*)d_ws;
#if MK_MULTI
    for (int p = 0; p < N_PHASES; ++p) { a.ph_lo = p; a.ph_hi = p + 1; hipLaunchKernelGGL(fwd_kernel, dim3(grid), dim3(512), LDS_BYTES, stream, a); }
#else
    a.ph_lo = 0; a.ph_hi = N_PHASES;
    void* args[] = {&a};
    hipError_t e = hipLaunchCooperativeKernel((const void*)fwd_kernel, dim3(grid), dim3(512), args, LDS_BYTES, stream);
    if (e != hipSuccess) fprintf(stderr, "cooperative launch failed: %s (grid %d)\n", hipGetErrorString(e), grid);
#endif
}
```

```cpp
#include <hip/hip_runtime.h>
#include <hip/hip_cooperative_groups.h>
#include <cstdio>
#include <cstdint>
namespace cg = cooperative_groups;

#ifndef MK_MULTI
#define MK_MULTI 0
#endif

#ifndef PROBE_A
#define PROBE_A -1
#define PROBE_B -1
#endif
#define PROBE_FULL_US 1000.0f
#define PROBE (PROBE_A >= 0)
#define LAS __attribute__((address_space(3)))
typedef unsigned short bf16_t;
typedef short bf16x8 __attribute__((ext_vector_type(8)));
typedef float f32x4 __attribute__((ext_vector_type(4)));
typedef float f32x2 __attribute__((ext_vector_type(2)));
typedef unsigned u32x4 __attribute__((ext_vector_type(4)));
typedef unsigned u32x2 __attribute__((ext_vector_type(2)));

constexpr int M_ = 16384, D_ = 2048, T_ = 8192, DFF = 5632, NMOD = 18432, PROJ_OUT = 8456;
constexpr int PP = 8448;
constexpr int PC_Q = 0, PC_K = 1024, PC_V = 1152, PC_MQK = 1280, PC_MV = 2304, PC_MO = 3328, PC_G = 4352;
constexpr float EPS = 1e-6f;
constexpr size_t MiB = 1u << 20;
constexpr size_t WS_MOD = 0, MOD_BYTES = 2 * NMOD * 4, WS_BAR = 192 * 1024, CTL_ZERO_BYTES = 256 * 1024;
constexpr size_t WS_TS = 3 * MiB;
constexpr size_t WS_CNT = 224 * 1024;
constexpr size_t WS_XBUF = 3 * MiB + 512 * 1024;
constexpr size_t WS_CNT2 = 240 * 1024, WS_XBUF2 = 576 * MiB, WS_QK = 577 * MiB, WS_NEED = WS_QK + 32 * MiB;
constexpr size_t WS_ROPE = 1 * MiB, WS_GIF = 2 * MiB, WS_SCAL = 2 * MiB + 512 * 1024;
constexpr size_t WS_WIN = 4 * MiB, WS_WATT = 37 * MiB, WS_WML = 41 * MiB, WS_WOUT = 45 * MiB;
constexpr size_t WS_U = 53 * MiB;
constexpr size_t WS_R = 117 * MiB;
constexpr size_t WS_WFIN = WS_R, WS_WFOUT = WS_R + 44 * MiB, WS_ACT = WS_R + 66 * MiB;
constexpr size_t WS_P = WS_R, WS_CBUF = WS_R + 264 * MiB;
constexpr size_t WS_CIN = WS_CBUF + (size_t)1024 * 257 * 128 * 4;
constexpr size_t WS_END = WS_CIN + (size_t)1024 * 257 * 128 * 2;
constexpr int LDS_BYTES = 147456;

namespace pg8 {
constexpr int BM = 256, BK = 64, HALF = 128, HTB = HALF * BK * 2, STAGE_BYTES = 8 * HTB, NXCD = 8, WGM = 8;
__host__ __device__ __forceinline__ int lds_byte(int r, int c) { const int st = (r >> 4) * 2 + (c >> 5), rr = r & 15, cc = c & 31, ob = rr * 64 + cc * 2; return st * 1024 + (ob ^ (((ob >> 9) & 1) << 5)); }
__host__ __device__ __forceinline__ void stage_rc(int b, int& R, int& C) { const int st = b / 1024, sb = b % 1024, swz = sb ^ (((sb >> 9) & 1) << 5); R = (st >> 1) * 16 + swz / 64; C = (st & 1) * 32 + (swz % 64) / 2; }
__host__ __device__ __forceinline__ int perm32(int rho) { const int n = rho >> 4, i = rho & 15; return 8 * (i >> 2) + 4 * n + (i & 3); }
struct Unit { int pm, pn; };
struct Gemm { const bf16_t* A; const bf16_t* Bt; int M, N, K, lda; size_t kstepA, tstepA; int ksplit; size_t ajump; };
__host__ __device__ __forceinline__ Gemm mk_gemm(const bf16_t* A, const bf16_t* Bt, int M, int N, int K, int lda) { return Gemm{A, Bt, M, N, K, lda, (size_t)(BK * 2), (size_t)BM * lda * 2, 1 << 30, 0}; }
__host__ __device__ __forceinline__ Gemm mk_gemm_tiledA(const bf16_t* A, const bf16_t* Bt, int M, int N, int K) { return Gemm{A, Bt, M, N, K, BK, (size_t)BM * BK * 2, (size_t)(K / BK) * BM * BK * 2, 1 << 30, 0}; }
struct StaticOrder {
    int nM, nN, nwg, G, c, wgm;
    __host__ __device__ void init(int M, int N, int G_, int c_, int wgm_ = WGM) { nM = M / BM; nN = N / BM; nwg = nM * nN; G = G_; c = c_; wgm = wgm_; }
    __host__ __device__ bool next(int i, Unit& u) const {
        const long L = (long)i * G + c; if (L >= nwg) return false;
        int wgid = (int)L; { const int q = nwg / NXCD, r = nwg % NXCD, xcd = wgid % NXCD, off = wgid / NXCD; wgid = (xcd < r ? xcd * (q + 1) : r * (q + 1) + (xcd - r) * q) + off; }
        const int nig = wgm * nN, gid = wgid / nig, fm = gid * wgm, gsz = (nM - fm) < wgm ? (nM - fm) : wgm;
        u.pm = fm + ((wgid % nig) % gsz); u.pn = (wgid % nig) / gsz; return true;
    }
};
__device__ __forceinline__ unsigned cvt_pk_bf16(float lo, float hi) { unsigned r; asm volatile("v_cvt_pk_bf16_f32 %0, %1, %2" : "=v"(r) : "v"(lo), "v"(hi)); return r; }

template <class Epi>
__device__ __forceinline__ void gemm_phase(LAS unsigned char* lds, const Gemm g, const StaticOrder& S, const Epi& E) {
    const int tid = threadIdx.x, wid = __builtin_amdgcn_readfirstlane(tid >> 6), lane = tid & 63, wr = wid >> 2, wc = wid & 3, fr = lane & 15, fq = lane >> 4;
    const int K = g.K, nt = K / BK, lda = g.lda;
    unsigned voffA[2], voffB[2];
#pragma unroll
    for (int i = 0; i < 2; ++i) { int R, C; stage_rc(tid * 16 + i * 8192, R, C); const int Rb = (R & ~31) + perm32(R & 31);
        voffA[i] = (unsigned)(R * lda + C) * 2u; voffB[i] = (unsigned)(Rb * K + C) * 2u; }
    const size_t kstep = (size_t)(BK * 2);
    const size_t hstepA = (size_t)HALF * lda * 2, hstepB = (size_t)HALF * K * 2;
    const size_t tstepA = g.tstepA, tstepB = 2 * hstepB, kstepA = g.kstepA;
    const unsigned ldsw = (unsigned)wid * 1024u;
    const int aoff = lds_byte(wr * 64 + fr, fq * 8), boff = lds_byte(wc * 32 + fr, fq * 8);
#define PG8_SA(b, h) (((b) * 2 + (h)) * HTB)
#define PG8_SB(b, h) ((4 + (b) * 2 + (h)) * HTB)
#define PG8_STAGE(bufoff, gbase, voff) do { _Pragma("unroll") for (int _i = 0; _i < 2; ++_i) \
        __builtin_amdgcn_global_load_lds((const unsigned*)((const char*)(gbase) + (voff)[_i]), (LAS unsigned*)(lds + (bufoff) + ldsw + _i * 8192), 16, 0, 0); } while (0)
#define PG8_LDA(dst, b, h) do { _Pragma("unroll") for (int m = 0; m < 4; ++m) _Pragma("unroll") for (int k = 0; k < 2; ++k) dst[m][k] = *(const LAS bf16x8*)(lds + PG8_SA(b, h) + aoff + m * 2048 + k * 1024); } while (0)
#define PG8_LDB(dst, b, h) do { _Pragma("unroll") for (int n = 0; n < 2; ++n) _Pragma("unroll") for (int k = 0; k < 2; ++k) dst[n][k] = *(const LAS bf16x8*)(lds + PG8_SB(b, h) + boff + n * 2048 + k * 1024); } while (0)
#define PG8_MMA(ai, bj, At, Bt) do { __builtin_amdgcn_s_setprio(1); _Pragma("unroll") for (int m = 0; m < 4; ++m) _Pragma("unroll") for (int n = 0; n < 2; ++n) _Pragma("unroll") for (int k = 0; k < 2; ++k) \
        acc[ai][bj][m][n] = __builtin_amdgcn_mfma_f32_16x16x32_bf16(Bt[n][k], At[m][k], acc[ai][bj][m][n], 0, 0, 0); __builtin_amdgcn_s_setprio(0); } while (0)
#define PG8_WAIT_V(n) asm volatile("s_waitcnt vmcnt(" #n ")" ::: "memory")
#define PG8_WAIT_L(n) asm volatile("s_waitcnt lgkmcnt(" #n ")" ::: "memory")
#define PG8_BAR __builtin_amdgcn_s_barrier()
#define PG8_SCHED __builtin_amdgcn_sched_barrier(0)
    Unit cur, nxt; int ui = 0;
    if (!S.next(0, cur)) return;
    f32x4 acc[2][2][4][2];
#pragma unroll
    for (int a = 0; a < 2; ++a)
#pragma unroll
        for (int b = 0; b < 2; ++b)
#pragma unroll
            for (int m = 0; m < 4; ++m)
#pragma unroll
                for (int n = 0; n < 2; ++n) acc[a][b][m][n] = (f32x4){0.f, 0.f, 0.f, 0.f};
    bf16x8 At[4][2], B0[2][2], B1[2][2];
    const char* cA = (const char*)g.A + (size_t)cur.pm * tstepA; const char* cB = (const char*)g.Bt + (size_t)cur.pn * tstepB;
    PG8_STAGE(PG8_SB(0, 0), cB, voffB); PG8_STAGE(PG8_SB(0, 1), cB + hstepB, voffB); PG8_STAGE(PG8_SA(0, 0), cA, voffA); PG8_STAGE(PG8_SA(0, 1), cA + hstepA, voffA);
    if (wr == 1) PG8_BAR;
    PG8_WAIT_V(2); PG8_BAR;
    PG8_STAGE(PG8_SB(1, 0), cB + kstep, voffB); PG8_STAGE(PG8_SA(1, 0), cA + kstepA, voffA); PG8_STAGE(PG8_SB(1, 1), cB + hstepB + kstep, voffB);
    PG8_WAIT_V(6); PG8_BAR;
    for (;;) {
        const bool has_next = S.next(ui + 1, nxt);
        const char* nA = has_next ? (const char*)g.A + (size_t)nxt.pm * tstepA : cA; const char* nB = has_next ? (const char*)g.Bt + (size_t)nxt.pn * tstepB : cB;
        for (int t = 0; t < nt; t += 2) {
            const bool last = (t == nt - 2);
            const char* a1 = cA + (size_t)(t + 1) * kstepA + ((t + 1) >= g.ksplit ? g.ajump : 0);
            const char* a2 = last ? nA : cA + (size_t)(t + 2) * kstepA + ((t + 2) >= g.ksplit ? g.ajump : 0); const char* b2 = last ? nB : cB + (size_t)(t + 2) * kstep;
            const char* a3 = last ? nA + kstepA : cA + (size_t)(t + 3) * kstepA + ((t + 3) >= g.ksplit ? g.ajump : 0); const char* b3 = b2 + kstep;
            if constexpr (Epi::HAS_MID) { if (t == g.ksplit) E.mid(acc, cur, wr, wc, fr, fq); }
            PG8_LDB(B0, 0, 0); PG8_LDB(B1, 0, 1); PG8_SCHED; PG8_LDA(At, 0, 0); PG8_STAGE(PG8_SA(1, 1), a1 + hstepA, voffA);
            PG8_WAIT_V(8); PG8_WAIT_L(0); PG8_BAR; PG8_MMA(0, 0, At, B0); PG8_MMA(0, 1, At, B1); PG8_BAR; PG8_SCHED;
            PG8_LDA(At, 0, 1); PG8_STAGE(PG8_SB(0, 0), b2, voffB); PG8_STAGE(PG8_SB(0, 1), b2 + hstepB, voffB); PG8_STAGE(PG8_SA(0, 0), a2, voffA);
            PG8_WAIT_V(8); PG8_WAIT_L(0); PG8_BAR; PG8_MMA(1, 0, At, B0); PG8_MMA(1, 1, At, B1); PG8_BAR; PG8_SCHED;
            PG8_LDB(B0, 1, 0); PG8_LDB(B1, 1, 1); PG8_SCHED; PG8_LDA(At, 1, 0); PG8_STAGE(PG8_SA(0, 1), a2 + hstepA, voffA);
            PG8_WAIT_V(8); PG8_WAIT_L(0); PG8_BAR; PG8_MMA(0, 0, At, B0); PG8_MMA(0, 1, At, B1); PG8_BAR; PG8_SCHED;
            PG8_LDA(At, 1, 1); PG8_STAGE(PG8_SB(1, 0), b3, voffB); PG8_STAGE(PG8_SB(1, 1), b3 + hstepB, voffB); PG8_STAGE(PG8_SA(1, 0), a3, voffA);
            PG8_WAIT_V(8); PG8_WAIT_L(0); PG8_BAR; PG8_MMA(1, 0, At, B0); PG8_MMA(1, 1, At, B1); PG8_BAR; PG8_SCHED;
        }
        if (wr == 0) PG8_BAR;
        E(acc, cur, wr, wc, fr, fq);
        if (!has_next) break;
#pragma unroll
        for (int a = 0; a < 2; ++a)
#pragma unroll
            for (int b = 0; b < 2; ++b)
#pragma unroll
                for (int m = 0; m < 4; ++m)
#pragma unroll
                    for (int n = 0; n < 2; ++n) acc[a][b][m][n] = (f32x4){0.f, 0.f, 0.f, 0.f};
        cur = nxt; cA = nA; cB = nB; ++ui;
        if (wr == 1) PG8_BAR;
    }
    PG8_WAIT_V(0);
    PG8_BAR;
#undef PG8_SA
#undef PG8_SB
#undef PG8_STAGE
#undef PG8_LDA
#undef PG8_LDB
#undef PG8_MMA
#undef PG8_WAIT_V
#undef PG8_WAIT_L
#undef PG8_BAR
#undef PG8_SCHED
}
}
using pg8::cvt_pk_bf16;
using pg8::Unit;

__device__ __forceinline__ float bf2f(unsigned short h) { return __uint_as_float((unsigned)h << 16); }
__device__ __forceinline__ float bflo(unsigned w) { return __uint_as_float(w << 16); }
__device__ __forceinline__ float bfhi(unsigned w) { return __uint_as_float(w & 0xffff0000u); }
__device__ __forceinline__ unsigned short f2bf(float f) { return (unsigned short)(cvt_pk_bf16(f, 0.f) & 0xffffu); }
__device__ __forceinline__ float sigm(float x) { return __builtin_amdgcn_rcpf(1.f + __expf(-x)); }
__device__ __forceinline__ float wave_sum(float v) {
#pragma unroll
    for (int o = 1; o < 64; o <<= 1) v += __shfl_xor(v, o);
    return v;
}
__device__ __forceinline__ float wave_max(float v) {
#pragma unroll
    for (int o = 1; o < 64; o <<= 1) v = fmaxf(v, __shfl_xor(v, o));
    return v;
}
__device__ __forceinline__ float log_sigmoid(float x) { return fminf(x, 0.f) - log1pf(expf(-fabsf(x))); }
__device__ __forceinline__ bf16x8 pack8(f32x4 a, f32x4 b) {
    u32x4 w; w.x = cvt_pk_bf16(a[0], a[1]); w.y = cvt_pk_bf16(a[2], a[3]); w.z = cvt_pk_bf16(b[0], b[1]); w.w = cvt_pk_bf16(b[2], b[3]);
    return __builtin_bit_cast(bf16x8, w);
}
__device__ __forceinline__ int kperm32(int kl) { return 8 * ((kl & 15) >> 2) + (kl & 3) + 4 * (kl >> 4); }

struct EpiSwiglu { static constexpr bool HAS_MID = false;
    bf16_t* O;
    __device__ __forceinline__ void operator()(const f32x4 (&acc)[2][2][4][2], const Unit& u, int wr, int wc, int fr, int fq) const {
        const int row0 = u.pm * 256 + wr * 64 + fr, col0 = u.pn * 128 + wc * 32 + 8 * fq;
#pragma unroll
        for (int ai = 0; ai < 2; ++ai)
#pragma unroll
            for (int m = 0; m < 4; ++m) {
                const int row = row0 + ai * 128 + m * 16;
                bf16_t* rowp = O + (((size_t)u.pm * (DFF / 64) + (col0 >> 6)) * 256 + (row & 255)) * 64 + (col0 & 63);
                float v[8];
#pragma unroll
                for (int n = 0; n < 2; ++n)
#pragma unroll
                    for (int e = 0; e < 4; ++e) { const float a = acc[ai][0][m][n][e], b = acc[ai][1][m][n][e]; v[n * 4 + e] = a * sigm(a) * b; }
                u32x4 w; w.x = cvt_pk_bf16(v[0], v[1]); w.y = cvt_pk_bf16(v[2], v[3]); w.z = cvt_pk_bf16(v[4], v[5]); w.w = cvt_pk_bf16(v[6], v[7]);
                *(u32x4*)rowp = w;
            }
    }
};
struct EpiResid { static constexpr bool HAS_MID = false;
    const float* base; float* out; const float* gate; float scale;
    __device__ __forceinline__ void operator()(const f32x4 (&acc)[2][2][4][2], const Unit& u, int wr, int wc, int fr, int fq) const {
        const int row0 = u.pm * 256 + wr * 64 + fr, col0 = u.pn * 256 + wc * 32 + 8 * fq;
        const float* gp = gate + (size_t)(u.pm >> 5) * NMOD + col0;
        f32x4 gv[2][2];
#pragma unroll
        for (int bj = 0; bj < 2; ++bj)
#pragma unroll
            for (int n = 0; n < 2; ++n) gv[bj][n] = *(const f32x4*)(gp + bj * 128 + 4 * n) * scale;
#pragma unroll
        for (int ai = 0; ai < 2; ++ai) {
            f32x4 bs[4][2][2];
#pragma unroll
            for (int m = 0; m < 4; ++m) {
                const size_t off = (size_t)(row0 + ai * 128 + m * 16) * D_ + col0;
#pragma unroll
                for (int bj = 0; bj < 2; ++bj)
#pragma unroll
                    for (int n = 0; n < 2; ++n) bs[m][bj][n] = *(const f32x4*)(base + off + bj * 128 + 4 * n);
            }
            asm volatile("" ::: "memory");
#pragma unroll
            for (int m = 0; m < 4; ++m) {
                const size_t off = (size_t)(row0 + ai * 128 + m * 16) * D_ + col0;
#pragma unroll
                for (int bj = 0; bj < 2; ++bj)
#pragma unroll
                    for (int n = 0; n < 2; ++n) *(f32x4*)(out + off + bj * 128 + 4 * n) = bs[m][bj][n] + gv[bj][n] * acc[ai][bj][m][n];
            }
            asm volatile("" ::: "memory");
        }
    }
};
struct EpiFinal { static constexpr bool HAS_MID = false;
    const float* base; float* out; const float* gate; const float* gfin; float* xbuf; unsigned* cnt; LAS unsigned char* xl;
    __device__ __forceinline__ void operator()(f32x4 (&acc)[2][2][4][2], const Unit& u, int wr, int wc, int fr, int fq) const {
        constexpr float scale = 0.5f;
        const int row0 = u.pm * 256 + wr * 64 + fr, col0 = u.pn * 256 + wc * 32 + 8 * fq;
        const float* gp = gate + (size_t)(u.pm >> 5) * NMOD + col0;
        LAS float* Pst = (LAS float*)xl;
        LAS float* S = Pst + 1024;
        {
            f32x4 gv[2][2];
#pragma unroll
            for (int bj = 0; bj < 2; ++bj)
#pragma unroll
                for (int n = 0; n < 2; ++n) gv[bj][n] = *(const f32x4*)(gp + bj * 128 + 4 * n) * scale;
#pragma unroll
            for (int ai = 0; ai < 2; ++ai)
#pragma unroll
                for (int mh = 0; mh < 2; ++mh) {
                    f32x4 bs[2][2][2];
#pragma unroll
                    for (int m2 = 0; m2 < 2; ++m2) {
                        const size_t off = (size_t)(row0 + ai * 128 + (mh * 2 + m2) * 16) * D_ + col0;
#pragma unroll
                        for (int bj = 0; bj < 2; ++bj)
#pragma unroll
                            for (int n = 0; n < 2; ++n) bs[m2][bj][n] = *(const f32x4*)(base + off + bj * 128 + 4 * n);
                    }
                    asm volatile("" ::: "memory");
#pragma unroll
                    for (int m2 = 0; m2 < 2; ++m2) {
                        const int m = mh * 2 + m2;
                        float sq = 0.f;
#pragma unroll
                        for (int bj = 0; bj < 2; ++bj)
#pragma unroll
                            for (int n = 0; n < 2; ++n) { const f32x4 hv = bs[m2][bj][n] + gv[bj][n] * acc[ai][bj][m][n]; acc[ai][bj][m][n] = hv; sq += (hv[0] * hv[0] + hv[1] * hv[1]) + (hv[2] * hv[2] + hv[3] * hv[3]); }
                        sq += __shfl_xor(sq, 16); sq += __shfl_xor(sq, 32);
                        if (fq == 0) Pst[(ai * 128 + wr * 64 + m * 16 + fr) * 4 + wc] = sq;
                    }
                    asm volatile("" ::: "memory");
                }
        }
        asm volatile("s_waitcnt lgkmcnt(0)" ::: "memory"); __builtin_amdgcn_s_barrier(); asm volatile("" ::: "memory");
        const int tid = threadIdx.x;
        if (tid < 256) { const f32x4 p4 = *(const LAS f32x4*)(Pst + tid * 4);
            __hip_atomic_store(xbuf + ((size_t)u.pm * 256 + tid) * 8 + u.pn, (p4[0] + p4[1]) + (p4[2] + p4[3]), __ATOMIC_RELAXED, __HIP_MEMORY_SCOPE_AGENT); }
        asm volatile("s_waitcnt vmcnt(0) lgkmcnt(0)" ::: "memory"); __builtin_amdgcn_s_barrier(); asm volatile("" ::: "memory");
        if (tid == 0) {
            unsigned* cw = cnt + 64 * u.pm;
            __hip_atomic_fetch_add(cw, 1u, __ATOMIC_RELAXED, __HIP_MEMORY_SCOPE_AGENT);
            unsigned sp = 0;
            while (__hip_atomic_load(cw, __ATOMIC_RELAXED, __HIP_MEMORY_SCOPE_AGENT) < 8u) { __builtin_amdgcn_s_sleep(2); if (++sp > (1u << 22)) break; }
        }
        asm volatile("s_waitcnt vmcnt(0) lgkmcnt(0)" ::: "memory"); __builtin_amdgcn_s_barrier(); asm volatile("" ::: "memory");
        if (tid < 256) {
            const float* xp = xbuf + ((size_t)u.pm * 256 + tid) * 8; float tot = 0.f;
#pragma unroll
            for (int t = 0; t < 8; ++t) tot += __hip_atomic_load(xp + t, __ATOMIC_RELAXED, __HIP_MEMORY_SCOPE_AGENT);
            S[tid] = 1.0f / sqrtf(tot * (1.0f / D_) + EPS);
        }
        asm volatile("s_waitcnt vmcnt(0) lgkmcnt(0)" ::: "memory"); __builtin_amdgcn_s_barrier(); asm volatile("" ::: "memory");
        f32x4 gf[2][2];
#pragma unroll
        for (int bj = 0; bj < 2; ++bj)
#pragma unroll
            for (int n = 0; n < 2; ++n) gf[bj][n] = *(const f32x4*)(gfin + col0 + bj * 128 + 4 * n);
#pragma unroll
        for (int ai = 0; ai < 2; ++ai)
#pragma unroll
            for (int m = 0; m < 4; ++m) {
                const float r = S[ai * 128 + wr * 64 + m * 16 + fr];
                const size_t off = (size_t)(row0 + ai * 128 + m * 16) * D_ + col0;
#pragma unroll
                for (int bj = 0; bj < 2; ++bj)
#pragma unroll
                    for (int n = 0; n < 2; ++n) *(f32x4*)(out + off + bj * 128 + 4 * n) = (acc[ai][bj][m][n] * r) * gf[bj][n];
            }
        asm volatile("s_waitcnt lgkmcnt(0)" ::: "memory"); __builtin_amdgcn_s_barrier(); asm volatile("" ::: "memory");
    }
};
struct EpiNormU { static constexpr bool HAS_MID = false;
    const float* base; float* out; const float* gate; const float* gn; const float* shp; const float* scp; bf16_t* U; float* xbuf; unsigned* cnt; LAS unsigned char* xl;
    __device__ __forceinline__ void operator()(f32x4 (&acc)[2][2][4][2], const Unit& u, int wr, int wc, int fr, int fq) const {
        constexpr float scale = 1.0f;
        const int row0 = u.pm * 256 + wr * 64 + fr, col0 = u.pn * 256 + wc * 32 + 8 * fq;
        const float* gp = gate + (size_t)(u.pm >> 5) * NMOD + col0;
        LAS float* Pst = (LAS float*)xl;
        LAS float* S = Pst + 1024;
        {
            f32x4 gv[2][2];
#pragma unroll
            for (int bj = 0; bj < 2; ++bj)
#pragma unroll
                for (int n = 0; n < 2; ++n) gv[bj][n] = *(const f32x4*)(gp + bj * 128 + 4 * n) * scale;
#pragma unroll
            for (int ai = 0; ai < 2; ++ai)
#pragma unroll
                for (int mh = 0; mh < 2; ++mh) {
                    f32x4 bs[2][2][2];
#pragma unroll
                    for (int m2 = 0; m2 < 2; ++m2) {
                        const size_t off = (size_t)(row0 + ai * 128 + (mh * 2 + m2) * 16) * D_ + col0;
#pragma unroll
                        for (int bj = 0; bj < 2; ++bj)
#pragma unroll
                            for (int n = 0; n < 2; ++n) bs[m2][bj][n] = *(const f32x4*)(base + off + bj * 128 + 4 * n);
                    }
                    asm volatile("" ::: "memory");
#pragma unroll
                    for (int m2 = 0; m2 < 2; ++m2) {
                        const int m = mh * 2 + m2;
                        float sq = 0.f;
#pragma unroll
                        for (int bj = 0; bj < 2; ++bj)
#pragma unroll
                            for (int n = 0; n < 2; ++n) { const f32x4 hv = bs[m2][bj][n] + gv[bj][n] * acc[ai][bj][m][n]; acc[ai][bj][m][n] = hv; sq += (hv[0] * hv[0] + hv[1] * hv[1]) + (hv[2] * hv[2] + hv[3] * hv[3]);
                                *(f32x4*)(out + (size_t)(row0 + ai * 128 + m * 16) * D_ + col0 + bj * 128 + 4 * n) = hv; }
                        sq += __shfl_xor(sq, 16); sq += __shfl_xor(sq, 32);
                        if (fq == 0) Pst[(ai * 128 + wr * 64 + m * 16 + fr) * 4 + wc] = sq;
                    }
                    asm volatile("" ::: "memory");
                }
        }
        asm volatile("s_waitcnt lgkmcnt(0)" ::: "memory"); __builtin_amdgcn_s_barrier(); asm volatile("" ::: "memory");
        const int tid = threadIdx.x;
        if (tid < 256) { const f32x4 p4 = *(const LAS f32x4*)(Pst + tid * 4);
            __hip_atomic_store(xbuf + ((size_t)u.pm * 256 + tid) * 8 + u.pn, (p4[0] + p4[1]) + (p4[2] + p4[3]), __ATOMIC_RELAXED, __HIP_MEMORY_SCOPE_AGENT); }
        asm volatile("s_waitcnt vmcnt(0) lgkmcnt(0)" ::: "memory"); __builtin_amdgcn_s_barrier(); asm volatile("" ::: "memory");
        if (tid == 0) {
            unsigned* cw = cnt + 64 * u.pm;
            __hip_atomic_fetch_add(cw, 1u, __ATOMIC_RELAXED, __HIP_MEMORY_SCOPE_AGENT);
            unsigned sp = 0;
            while (__hip_atomic_load(cw, __ATOMIC_RELAXED, __HIP_MEMORY_SCOPE_AGENT) < 8u) { __builtin_amdgcn_s_sleep(2); if (++sp > (1u << 22)) break; }
        }
        asm volatile("s_waitcnt vmcnt(0) lgkmcnt(0)" ::: "memory"); __builtin_amdgcn_s_barrier(); asm volatile("" ::: "memory");
        if (tid < 256) {
            const float* xp = xbuf + ((size_t)u.pm * 256 + tid) * 8; float tot = 0.f;
#pragma unroll
            for (int t = 0; t < 8; ++t) tot += __hip_atomic_load(xp + t, __ATOMIC_RELAXED, __HIP_MEMORY_SCOPE_AGENT);
            S[tid] = 1.0f / sqrtf(tot * (1.0f / D_) + EPS);
        }
        asm volatile("s_waitcnt vmcnt(0) lgkmcnt(0)" ::: "memory"); __builtin_amdgcn_s_barrier(); asm volatile("" ::: "memory");
        const size_t bo = (size_t)(u.pm >> 5) * NMOD;
#pragma unroll
        for (int bj = 0; bj < 2; ++bj) {
            f32x4 ga[2], gb[2];
#pragma unroll
            for (int n = 0; n < 2; ++n) { const int cc = col0 + bj * 128 + 4 * n; ga[n] = *(const f32x4*)(gn + cc) * (*(const f32x4*)(scp + bo + cc) + 1.0f); gb[n] = *(const f32x4*)(shp + bo + cc); }
#pragma unroll
            for (int ai = 0; ai < 2; ++ai)
#pragma unroll
                for (int m = 0; m < 4; ++m) {
                    const float r = S[ai * 128 + wr * 64 + m * 16 + fr];
                    const f32x4 y0 = (acc[ai][bj][m][0] * r) * ga[0] + gb[0], y1 = (acc[ai][bj][m][1] * r) * ga[1] + gb[1];
                    u32x4 w; w.x = cvt_pk_bf16(y0[0], y0[1]); w.y = cvt_pk_bf16(y0[2], y0[3]); w.z = cvt_pk_bf16(y1[0], y1[1]); w.w = cvt_pk_bf16(y1[2], y1[3]);
                    *(u32x4*)(U + (size_t)(row0 + ai * 128 + m * 16) * D_ + col0 + bj * 128) = w;
                }
        }
        asm volatile("s_waitcnt lgkmcnt(0)" ::: "memory"); __builtin_amdgcn_s_barrier(); asm volatile("" ::: "memory");
    }
};
struct EpiProj { static constexpr bool HAS_MID = false;
    bf16_t* P; const float* rope;
    __device__ __forceinline__ void operator()(const f32x4 (&acc)[2][2][4][2], const Unit& u, int wr, int wc, int fr, int fq) const {
        const int row0 = u.pm * 256 + wr * 64 + fr, col0 = u.pn * 256 + wc * 32 + 8 * fq;
        const bool sig = u.pn >= 13;
        const bool ropelane = ((wc & 1) == 0) && (fq < 2) && (u.pn <= 4);
#pragma unroll
        for (int ai = 0; ai < 2; ++ai)
#pragma unroll
            for (int m = 0; m < 4; ++m) {
                const int row = row0 + ai * 128 + m * 16;
                f32x4 cs = {1.f, 1.f, 1.f, 1.f}, sn = {0.f, 0.f, 0.f, 0.f};
                if (ropelane) { cs = *(const f32x4*)(rope + (size_t)row * 16 + fq * 4); sn = *(const f32x4*)(rope + (size_t)row * 16 + 8 + fq * 4); }
#pragma unroll
                for (int bj = 0; bj < 2; ++bj) {
                    f32x4 v0 = acc[ai][bj][m][0], v1 = acc[ai][bj][m][1];
                    if (ropelane && (u.pn < 4 || bj == 0)) { const f32x4 x1 = v0, x2 = v1; v0 = x1 * cs - x2 * sn; v1 = x2 * cs + x1 * sn; }
                    if (sig) {
#pragma unroll
                        for (int e = 0; e < 4; ++e) { v0[e] = sigm(v0[e]); v1[e] = sigm(v1[e]); }
                    }
                    u32x4 w; w.x = cvt_pk_bf16(v0[0], v0[1]); w.y = cvt_pk_bf16(v0[2], v0[3]); w.z = cvt_pk_bf16(v1[0], v1[1]); w.w = cvt_pk_bf16(v1[2], v1[3]);
                    *(u32x4*)(P + (size_t)row * PP + col0 + bj * 128) = w;
                }
            }
    }
};
struct EpiMerge {
    static constexpr bool HAS_MID = true;
    bf16_t* P;
    __device__ __forceinline__ void mid(f32x4 (&acc)[2][2][4][2], const Unit& u, int wr, int wc, int fr, int fq) const {
        int row0 = u.pm * 256 + wr * 64 + fr, col0 = u.pn * 256 + wc * 32 + 8 * fq;
        asm volatile("" : "+v"(row0), "+v"(col0));
#pragma unroll
        for (int ai = 0; ai < 2; ++ai)
#pragma unroll
            for (int mh = 0; mh < 2; ++mh) {
                u32x4 ga[2][2], gm[2][2];
#pragma unroll
                for (int m2 = 0; m2 < 2; ++m2)
#pragma unroll
                    for (int bj = 0; bj < 2; ++bj) {
                        const bf16_t* gp = P + (size_t)(row0 + ai * 128 + (mh * 2 + m2) * 16) * PP + PC_G + col0 + bj * 128;
                        ga[m2][bj] = *(const u32x4*)gp; gm[m2][bj] = *(const u32x4*)(gp + 2048);
                    }
                asm volatile("" ::: "memory");
#pragma unroll
                for (int m2 = 0; m2 < 2; ++m2)
#pragma unroll
                    for (int bj = 0; bj < 2; ++bj) {
                        const int m = mh * 2 + m2;
                        const u32x4 a = ga[m2][bj], g = gm[m2][bj];
                        f32x4 r0, r1;
                        r0[0] = bflo(a.x) * __builtin_amdgcn_rcpf(bflo(g.x)); r0[1] = bfhi(a.x) * __builtin_amdgcn_rcpf(bfhi(g.x)); r0[2] = bflo(a.y) * __builtin_amdgcn_rcpf(bflo(g.y)); r0[3] = bfhi(a.y) * __builtin_amdgcn_rcpf(bfhi(g.y));
                        r1[0] = bflo(a.z) * __builtin_amdgcn_rcpf(bflo(g.z)); r1[1] = bfhi(a.z) * __builtin_amdgcn_rcpf(bfhi(g.z)); r1[2] = bflo(a.w) * __builtin_amdgcn_rcpf(bflo(g.w)); r1[3] = bfhi(a.w) * __builtin_amdgcn_rcpf(bfhi(g.w));
                        acc[ai][bj][m][0] *= r0; acc[ai][bj][m][1] *= r1;
                    }
                asm volatile("" ::: "memory");
            }
    }
    __device__ __forceinline__ void operator()(const f32x4 (&acc)[2][2][4][2], const Unit& u, int wr, int wc, int fr, int fq) const {
        const int row0 = u.pm * 256 + wr * 64 + fr, col0 = u.pn * 256 + wc * 32 + 8 * fq;
#pragma unroll
        for (int ai = 0; ai < 2; ++ai) {
            u32x4 gm[4][2];
#pragma unroll
            for (int m = 0; m < 4; ++m)
#pragma unroll
                for (int bj = 0; bj < 2; ++bj) gm[m][bj] = *(const u32x4*)(P + (size_t)(row0 + ai * 128 + m * 16) * PP + PC_G + 2048 + col0 + bj * 128);
            asm volatile("" ::: "memory");
#pragma unroll
            for (int m = 0; m < 4; ++m)
#pragma unroll
                for (int bj = 0; bj < 2; ++bj) {
                    bf16_t* zp = P + (size_t)(row0 + ai * 128 + m * 16) * PP + PC_G + col0 + bj * 128;
                    const u32x4 g = gm[m][bj];
                    const f32x4 a0 = acc[ai][bj][m][0], a1 = acc[ai][bj][m][1];
                    u32x4 w; w.x = cvt_pk_bf16(bflo(g.x) * a0[0], bfhi(g.x) * a0[1]); w.y = cvt_pk_bf16(bflo(g.y) * a0[2], bfhi(g.y) * a0[3]);
                    w.z = cvt_pk_bf16(bflo(g.z) * a1[0], bfhi(g.z) * a1[1]); w.w = cvt_pk_bf16(bflo(g.w) * a1[2], bfhi(g.w) * a1[3]);
                    *(u32x4*)zp = w;
                }
            asm volatile("" ::: "memory");
        }
    }
};

struct Args {
    const float* x; const float* c; const int* pos; const float* w_ada; const float* b_ada; const float* norm1_g;
    const float* f1_in; const float* f1_out; const float* norm2_g; const float* w_in; const float* conv_w; const float* conv_b;
    const float* b_ig; const float* b_fg; const float* sinks; const float* mnorm_g; const float* w_att; const float* w_ml;
    const float* w_out; const float* norm3_g; const float* f2_in; const float* f2_out; const float* final_g;
    float* out; unsigned char* ws; int ph_lo, ph_hi;
};

template <int KIND> __device__ __forceinline__ int srccol(int n) {
    if (KIND == 0) return n;
    if (KIND == 1) { const int pn = n >> 8, bj = (n >> 7) & 1, i = n & 127; return bj * DFF + pn * 128 + i; }
    if (n < PC_V) { const int d = n & 63; if (d < 16) { const int g = d >> 2; const int dd = (g == 1) ? d + 4 : (g == 2) ? d - 4 : d; return (n & ~63) + dd; } return n; }
    if (n < PC_MO) return n;
    return n + 8;
}
template <int KIND> __device__ __forceinline__ void transpose_item(const float* W, int K, int N, bf16_t* WT, int ldw, LAS float* scr, int item, int lane, int nblk) {
    const int kb = item / nblk, nb = item % nblk, k0 = 64 * kb, n0 = 32 * nb;
    const int sc = srccol<KIND>(n0 + (lane & 31));
#pragma unroll 8
    for (int i = 0; i < 32; ++i) { const int kk = 2 * i + (lane >> 5); scr[kk * 33 + (lane & 31)] = W[(size_t)(k0 + kk) * N + sc]; }
    asm volatile("s_waitcnt lgkmcnt(0)" ::: "memory");
    const int c = lane & 7;
#pragma unroll
    for (int j = 0; j < 4; ++j) { const int n = (lane >> 3) + 8 * j; const LAS float* s = scr + (8 * c) * 33 + n;
        u32x4 o; o.x = cvt_pk_bf16(s[0 * 33], s[1 * 33]); o.y = cvt_pk_bf16(s[2 * 33], s[3 * 33]); o.z = cvt_pk_bf16(s[4 * 33], s[5 * 33]); o.w = cvt_pk_bf16(s[6 * 33], s[7 * 33]);
        *(u32x4*)(WT + (size_t)(n0 + n) * ldw + k0 + 8 * c) = o; }
    asm volatile("s_waitcnt lgkmcnt(0)" ::: "memory");
}
template <int KIND> __device__ __forceinline__ void transpose_all(const float* W, int K, int N, int Nout, bf16_t* WT, int ldw, LAS float* scr, int gw, int ngw, int lane) {
    const int nblk = Nout / 32, items = (K / 64) * nblk;
    for (int it = gw; it < items; it += ngw) transpose_item<KIND>(W, K, N, WT, ldw, scr, it, lane, nblk);
}

template <bool GATES> __device__ __forceinline__ void norm_phase(const float* hin, const float* g, const float* mod, int sh_off, int sc_off, bf16_t* uout,
                                                                 float* gif, const float* w_in, LAS unsigned char* lds, int tid, int wave, int lane) {
    LAS float* wgT = (LAS float*)lds;
    if (GATES) {
        for (int idx = tid; idx < 2048 * 8; idx += 512) { const int k = idx >> 3, j = idx & 7; wgT[j * 2048 + k] = w_in[(size_t)k * PROJ_OUT + 3328 + j]; }
        __syncthreads();
    }
    const int gw = blockIdx.x * 8 + wave, ngw = gridDim.x * 8;
    for (int rowa = gw; rowa < M_; rowa += 2 * ngw) {
        f32x4 v[2][8]; float rs[2];
#pragma unroll
        for (int q = 0; q < 2; ++q) {
            const int row = min(rowa + q * ngw, M_ - 1);
            const f32x4* xr = (const f32x4*)(hin + (size_t)row * D_) + lane;
#pragma unroll
            for (int j = 0; j < 8; ++j) v[q][j] = xr[64 * j];
        }
#pragma unroll
        for (int q = 0; q < 2; ++q) {
            float ss = 0.f;
#pragma unroll
            for (int j = 0; j < 8; ++j) ss += (v[q][j][0] * v[q][j][0] + v[q][j][1] * v[q][j][1]) + (v[q][j][2] * v[q][j][2] + v[q][j][3] * v[q][j][3]);
            rs[q] = 1.0f / sqrtf(wave_sum(ss) * (1.0f / D_) + EPS);
        }
#pragma unroll
        for (int q = 0; q < 2; ++q) {
            const int row = rowa + q * ngw;
            if (row < M_) {
                const int b = row >> 13;
                const float rstd = rs[q];
                float ga[8];
#pragma unroll
                for (int i = 0; i < 8; ++i) ga[i] = 0.f;
#pragma unroll
                for (int j = 0; j < 8; ++j) {
                    const int col = 256 * j + 4 * lane;
                    const f32x4 g4 = *(const f32x4*)(g + col), sc4 = *(const f32x4*)(mod + (size_t)b * NMOD + sc_off + col), sh4 = *(const f32x4*)(mod + (size_t)b * NMOD + sh_off + col);
                    const f32x4 y = (v[q][j] * rstd) * g4 * (sc4 + 1.0f) + sh4;
                    u32x2 w; w.x = cvt_pk_bf16(y[0], y[1]); w.y = cvt_pk_bf16(y[2], y[3]);
                    *(u32x2*)(uout + (size_t)row * D_ + col) = w;
                    if (GATES) {
#pragma unroll
                        for (int i = 0; i < 8; ++i) { const f32x4 w4 = *(const LAS f32x4*)(wgT + i * 2048 + col); ga[i] += (y[0] * w4[0] + y[1] * w4[1]) + (y[2] * w4[2] + y[3] * w4[3]); }
                    }
                }
                if (GATES) {
#pragma unroll
                    for (int i = 0; i < 8; ++i) ga[i] = wave_sum(ga[i]);
                    if (lane == 0) { *(f32x4*)(gif + (size_t)row * 8) = (f32x4){ga[0], ga[1], ga[2], ga[3]}; *(f32x4*)(gif + (size_t)row * 8 + 4) = (f32x4){ga[4], ga[5], ga[6], ga[7]}; }
                }
            }
        }
    }
    if (GATES) __syncthreads();
}

__device__ __forceinline__ void attn_item(int item, bf16_t* P, const float* sinks, LAS unsigned char* lds, int tid, int wave, int lane) {
    const int kvh = item & 1, nb = (item >> 1) & 63, b = item >> 7;
    const int r0 = b * T_ + nb * 128;
    LAS bf16_t* Ksh = (LAS bf16_t*)lds;
    LAS bf16_t* VT = (LAS bf16_t*)(lds + 36864);
    {
        u32x4 kva[4], vva[4];
#pragma unroll
        for (int i = 0; i < 4; ++i) {
            const int chunk = tid + 512 * i, key = chunk >> 3, c8 = chunk & 7;
            const bool valid = (nb > 0) || (key >= 128);
            kva[i] = (u32x4){0u, 0u, 0u, 0u}; vva[i] = (u32x4){0u, 0u, 0u, 0u};
            if (valid) { const bf16_t* rp = P + (size_t)(r0 - 128 + key) * PP; kva[i] = *(const u32x4*)(rp + PC_K + kvh * 64 + c8 * 8); vva[i] = *(const u32x4*)(rp + PC_V + kvh * 64 + c8 * 8); }
        }
        asm volatile("" ::: "memory");
#pragma unroll
        for (int i = 0; i < 4; ++i) {
            const int chunk = tid + 512 * i, key = chunk >> 3, c8 = chunk & 7;
            const u32x4 kv = kva[i], vv = vva[i];
            *(LAS u32x4*)(Ksh + key * 72 + c8 * 8) = kv;
            const int pos = (key & ~31) + kperm32(key & 31);
            LAS bf16_t* vp = VT + (c8 * 8) * 264 + pos;
            vp[0 * 264] = (bf16_t)(vv.x & 0xffff); vp[1 * 264] = (bf16_t)(vv.x >> 16); vp[2 * 264] = (bf16_t)(vv.y & 0xffff); vp[3 * 264] = (bf16_t)(vv.y >> 16);
            vp[4 * 264] = (bf16_t)(vv.z & 0xffff); vp[5 * 264] = (bf16_t)(vv.z >> 16); vp[6 * 264] = (bf16_t)(vv.w & 0xffff); vp[7 * 264] = (bf16_t)(vv.w >> 16);
        }
    }
    const int h = kvh * 8 + wave, fr = lane & 15, fq = lane >> 4;
    const float sink = sinks[h];
    bf16x8 nq0, nq1;
    { const bf16_t* qp0 = P + (size_t)(r0 + fr) * PP + h * 64 + 8 * fq; nq0 = *(const bf16x8*)qp0; nq1 = *(const bf16x8*)(qp0 + 32); }
    __syncthreads();
    for (int qg = 0; qg < 8; ++qg) {
        const int qrow = r0 + qg * 16 + fr;
        bf16_t* qp = P + (size_t)qrow * PP + h * 64;
        const bf16x8 bq0 = nq0, bq1 = nq1;
        { const bf16_t* qpn = qp + (size_t)(qg < 7 ? 16 : 0) * PP + 8 * fq; nq0 = *(const bf16x8*)qpn; nq1 = *(const bf16x8*)(qpn + 32); }
        const int t0e = qg & ~1;
        f32x4 s[10];
#pragma unroll
        for (int tt = 0; tt < 10; ++tt) {
            const int t = min(t0e + tt, 15);
            const LAS bf16_t* kp = Ksh + (t * 16 + fr) * 72 + 8 * fq;
            const bf16x8 a0 = *(const LAS bf16x8*)kp, a1 = *(const LAS bf16x8*)(kp + 32);
            f32x4 z = {0.f, 0.f, 0.f, 0.f};
            z = __builtin_amdgcn_mfma_f32_16x16x32_bf16(a0, bq0, z, 0, 0, 0);
            s[tt] = __builtin_amdgcn_mfma_f32_16x16x32_bf16(a1, bq1, z, 0, 0, 0);
        }
        const int qi = 128 + qg * 16 + fr;
        float mx = -1e30f;
#pragma unroll
        for (int tt = 0; tt < 10; ++tt)
#pragma unroll
            for (int r = 0; r < 4; ++r) {
                const int kj = (t0e + tt) * 16 + 4 * fq + r;
                const bool ok = (kj <= qi) && (kj > qi - 128) && ((nb > 0) || (kj >= 128));
                const float sv = ok ? s[tt][r] * 0.125f : -1e30f;
                s[tt][r] = sv; mx = fmaxf(mx, sv);
            }
        mx = fmaxf(mx, __shfl_xor(mx, 16)); mx = fmaxf(mx, __shfl_xor(mx, 32)); mx = fmaxf(mx, sink);
        float sum = 0.f;
#pragma unroll
        for (int tt = 0; tt < 10; ++tt)
#pragma unroll
            for (int r = 0; r < 4; ++r) { const float p = __expf(s[tt][r] - mx); s[tt][r] = p; sum += p; }
        sum += __shfl_xor(sum, 16); sum += __shfl_xor(sum, 32);
        const float inv = 1.0f / (sum + __expf(sink - mx));
        bf16x8 bp[5];
#pragma unroll
        for (int g = 0; g < 5; ++g) bp[g] = pack8(s[2 * g], s[2 * g + 1]);
#pragma unroll
        for (int dt = 0; dt < 4; ++dt) {
            f32x4 o = {0.f, 0.f, 0.f, 0.f};
#pragma unroll
            for (int g = 0; g < 5; ++g) {
                const int grp = min((t0e >> 1) + g, 7);
                const bf16x8 a = *(const LAS bf16x8*)(VT + (dt * 16 + fr) * 264 + grp * 32 + 8 * fq);
                o = __builtin_amdgcn_mfma_f32_16x16x32_bf16(a, bp[g], o, 0, 0, 0);
            }
            u32x2 w; w.x = cvt_pk_bf16(o[0] * inv, o[1] * inv); w.y = cvt_pk_bf16(o[2] * inv, o[3] * inv);
            *(u32x2*)(qp + dt * 16 + 4 * fq) = w;
        }
    }
    __syncthreads();
}


typedef __bf16 bf16x2_t __attribute__((ext_vector_type(2)));
__device__ __forceinline__ unsigned cvtpk_c(float lo, float hi) { f32x2 v = {lo, hi}; bf16x2_t b = __builtin_convertvector(v, bf16x2_t); return __builtin_bit_cast(unsigned, b); }
__device__ __forceinline__ void proj_tail(int blk, const bf16_t* U, const bf16_t* WinT, bf16_t* P, LAS unsigned char* lds, int tid, int wave, int lane) {
    const int row0 = blk * 64;
    const bf16_t* Wt = WinT + (size_t)8192 * D_;
    const int sr = tid >> 4, sc = (tid & 15) * 8;
    const bf16_t* ap = U + (size_t)(row0 + sr) * D_ + sc;
    const bf16_t* bp = Wt + (size_t)sr * D_ + sc;
    LAS bf16_t* As = (LAS bf16_t*)lds;
    LAS bf16_t* Bs = As + 64 * 136;
    const int fr = lane & 15, fq = lane >> 4;
    f32x4 acc[4][2];
#pragma unroll
    for (int m = 0; m < 4; ++m)
#pragma unroll
        for (int n = 0; n < 2; ++n) acc[m][n] = (f32x4){0.f, 0.f, 0.f, 0.f};
    u32x4 ra[2][2], rb[2][8];
#pragma unroll
    for (int s2 = 0; s2 < 2; ++s2) {
#pragma unroll
        for (int i = 0; i < 2; ++i) ra[s2][i] = *(const u32x4*)(ap + (size_t)(32 * i) * D_ + s2 * 128);
#pragma unroll
        for (int i = 0; i < 8; ++i) rb[s2][i] = *(const u32x4*)(bp + (size_t)(32 * i) * D_ + s2 * 128);
    }
    for (int kt0 = 0; kt0 < 16; kt0 += 2) {
#pragma unroll
        for (int s2 = 0; s2 < 2; ++s2) {
            const int kt = kt0 + s2;
            __syncthreads();
#pragma unroll
            for (int i = 0; i < 2; ++i) *(LAS u32x4*)(As + (sr + 32 * i) * 136 + sc) = ra[s2][i];
#pragma unroll
            for (int i = 0; i < 8; ++i) *(LAS u32x4*)(Bs + (sr + 32 * i) * 136 + sc) = rb[s2][i];
            if (kt + 2 < 16) {
#pragma unroll
                for (int i = 0; i < 2; ++i) ra[s2][i] = *(const u32x4*)(ap + (size_t)(32 * i) * D_ + (kt + 2) * 128);
#pragma unroll
                for (int i = 0; i < 8; ++i) rb[s2][i] = *(const u32x4*)(bp + (size_t)(32 * i) * D_ + (kt + 2) * 128);
            }
            __syncthreads();
#pragma unroll
            for (int ks = 0; ks < 4; ++ks) {
                bf16x8 af[4], bf[2];
#pragma unroll
                for (int m = 0; m < 4; ++m) af[m] = *(const LAS bf16x8*)(As + (m * 16 + fr) * 136 + ks * 32 + 8 * fq);
#pragma unroll
                for (int n = 0; n < 2; ++n) bf[n] = *(const LAS bf16x8*)(Bs + (wave * 32 + n * 16 + fr) * 136 + ks * 32 + 8 * fq);
#pragma unroll
                for (int m = 0; m < 4; ++m)
#pragma unroll
                    for (int n = 0; n < 2; ++n) acc[m][n] = __builtin_amdgcn_mfma_f32_16x16x32_bf16(bf[n], af[m], acc[m][n], 0, 0, 0);
            }
        }
    }
#pragma unroll
    for (int m = 0; m < 4; ++m)
#pragma unroll
        for (int n = 0; n < 2; ++n) {
            const f32x4 z = acc[m][n];
            u32x2 w; w.x = cvtpk_c(sigm(z[0]), sigm(z[1])); w.y = cvtpk_c(sigm(z[2]), sigm(z[3]));
            *(u32x2*)(P + (size_t)(row0 + m * 16 + fr) * PP + 8192 + wave * 32 + n * 16 + 4 * fq) = w;
        }
    __syncthreads();
}

__device__ __forceinline__ void m1_pair(int pr, const bf16_t* P, bf16_t* QK, const float* gif, const float* conv_w, const float* conv_b, const float* b_ig, const float* b_fg,
                                        float* Cbuf, float* scal, LAS unsigned char* lds, int tid, int wave, int lane) {
    const int half = wave >> 2, w4 = wave & 3, item = 2 * pr + half, htid = tid & 255;
    const int c = item & 127, h = (item >> 7) & 3, b = item >> 9;
    const int r0 = b * T_ + c * 64;
    LAS bf16_t* VT = (LAS bf16_t*)(lds + half * 58368);
    LAS bf16_t* KT = (LAS bf16_t*)(lds + half * 58368 + 39168);
    LAS float* wl = (LAS float*)(lds + half * 58368 + 57600);
    if (w4 == 0) {
        const int row = r0 + lane;
        const float fpre = gif[(size_t)row * 8 + 4 + h] + b_fg[h], ipre = gif[(size_t)row * 8 + h] + b_ig[h];
        float bc = log_sigmoid(fpre);
#pragma unroll
        for (int o = 1; o < 64; o <<= 1) { const float t = __shfl_up(bc, o); if (lane >= o) bc += t; }
        const float blast = __shfl(bc, 63);
        const float gg = blast - bc + ipre;
        const float gmax = wave_max(gg);
        wl[lane] = expf(gg - gmax);
        if (lane == 0) { scal[item * 4 + 0] = gmax; scal[item * 4 + 1] = blast; }
    }
    for (int idx = htid; idx < 16 * 72; idx += 256) VT[256 * 72 + idx] = (idx < 64) ? (bf16_t)0x3F80 : (bf16_t)0;
    const int ch8 = htid & 31, tg = htid >> 5, qk = ch8 >> 4, j0 = (ch8 & 15) * 8;
    const int chan = qk * 512 + h * 128 + j0;
    float y[8][8];
    {
        u32x4 xr[11];
#pragma unroll
        for (int i = 0; i < 11; ++i) {
            const int ts = c * 64 + tg * 8 - 3 + i;
            xr[i] = (u32x4){0u, 0u, 0u, 0u};
            if (ts >= 0) xr[i] = *(const u32x4*)(P + (size_t)(b * T_ + ts) * PP + PC_MQK + chan);
        }
        f32x4 wv[4][2];
#pragma unroll
        for (int kk = 0; kk < 4; ++kk) { wv[kk][0] = *(const f32x4*)(conv_w + kk * 1024 + chan); wv[kk][1] = *(const f32x4*)(conv_w + kk * 1024 + chan + 4); }
        const f32x4 cb0 = *(const f32x4*)(conv_b + chan), cb1 = *(const f32x4*)(conv_b + chan + 4);
        const float ksc = qk ? 0.08838834764831845f : 1.0f;
#pragma unroll
        for (int j = 0; j < 8; ++j) {
            float a[8] = {cb0[0], cb0[1], cb0[2], cb0[3], cb1[0], cb1[1], cb1[2], cb1[3]};
#pragma unroll
            for (int kk = 0; kk < 4; ++kk) {
                const u32x4 x8 = xr[j + kk];
                a[0] += wv[kk][0][0] * bflo(x8.x); a[1] += wv[kk][0][1] * bfhi(x8.x); a[2] += wv[kk][0][2] * bflo(x8.y); a[3] += wv[kk][0][3] * bfhi(x8.y);
                a[4] += wv[kk][1][0] * bflo(x8.z); a[5] += wv[kk][1][1] * bfhi(x8.z); a[6] += wv[kk][1][2] * bflo(x8.w); a[7] += wv[kk][1][3] * bfhi(x8.w);
            }
#pragma unroll
            for (int e = 0; e < 8; ++e) y[j][e] = a[e] * sigm(a[e]) * ksc;
            u32x4 w; w.x = cvt_pk_bf16(y[j][0], y[j][1]); w.y = cvt_pk_bf16(y[j][2], y[j][3]); w.z = cvt_pk_bf16(y[j][4], y[j][5]); w.w = cvt_pk_bf16(y[j][6], y[j][7]);
            *(u32x4*)(QK + (size_t)(r0 + tg * 8 + j) * 1024 + chan) = w;
        }
    }
    {
        u32x4 vva[8];
#pragma unroll
        for (int i = 0; i < 8; ++i) { const int task = htid + 256 * i, tl = task & 63, ce = task >> 6; vva[i] = *(const u32x4*)(P + (size_t)(r0 + tl) * PP + PC_MV + h * 256 + ce * 8); }
        asm volatile("" ::: "memory");
#pragma unroll
        for (int i = 0; i < 8; ++i) {
            const int task = htid + 256 * i, tl = task & 63, ce = task >> 6;
            const u32x4 vv = vva[i];
            LAS bf16_t* vp = VT + (ce * 8) * 72 + tl;
            vp[0 * 72] = (bf16_t)(vv.x & 0xffff); vp[1 * 72] = (bf16_t)(vv.x >> 16); vp[2 * 72] = (bf16_t)(vv.y & 0xffff); vp[3 * 72] = (bf16_t)(vv.y >> 16);
            vp[4 * 72] = (bf16_t)(vv.z & 0xffff); vp[5 * 72] = (bf16_t)(vv.z >> 16); vp[6 * 72] = (bf16_t)(vv.w & 0xffff); vp[7 * 72] = (bf16_t)(vv.w >> 16);
        }
    }
    __syncthreads();
    if (qk) {
#pragma unroll
        for (int j = 0; j < 8; ++j) {
            const int tl = tg * 8 + j; const float wt = wl[tl];
#pragma unroll
            for (int e = 0; e < 8; ++e) KT[(j0 + e) * 72 + tl] = f2bf(y[j][e] * wt);
        }
    }
    __syncthreads();
    const int fr = lane & 15, fq = lane >> 4;
    float* Cit = Cbuf + (size_t)item * 257 * 128;
#pragma unroll
    for (int et4 = 0; et4 < 4; ++et4) {
        const int et = 4 * w4 + et4;
        const bf16x8 v0 = *(const LAS bf16x8*)(VT + (et * 16 + fr) * 72 + 8 * fq), v1 = *(const LAS bf16x8*)(VT + (et * 16 + fr) * 72 + 32 + 8 * fq);
#pragma unroll
        for (int dt = 0; dt < 8; ++dt) {
            const bf16x8 k0 = *(const LAS bf16x8*)(KT + (dt * 16 + fr) * 72 + 8 * fq), k1 = *(const LAS bf16x8*)(KT + (dt * 16 + fr) * 72 + 32 + 8 * fq);
            f32x4 z = {0.f, 0.f, 0.f, 0.f};
            z = __builtin_amdgcn_mfma_f32_16x16x32_bf16(k0, v0, z, 0, 0, 0);
            z = __builtin_amdgcn_mfma_f32_16x16x32_bf16(k1, v1, z, 0, 0, 0);
            *(f32x4*)(Cit + (size_t)(et * 16 + fr) * 128 + dt * 16 + 4 * fq) = z;
        }
    }
    if (w4 == 0) {
        const bf16x8 v0 = *(const LAS bf16x8*)(VT + (256 + fr) * 72 + 8 * fq), v1 = *(const LAS bf16x8*)(VT + (256 + fr) * 72 + 32 + 8 * fq);
#pragma unroll
        for (int dt = 0; dt < 8; ++dt) {
            const bf16x8 k0 = *(const LAS bf16x8*)(KT + (dt * 16 + fr) * 72 + 8 * fq), k1 = *(const LAS bf16x8*)(KT + (dt * 16 + fr) * 72 + 32 + 8 * fq);
            f32x4 z = {0.f, 0.f, 0.f, 0.f};
            z = __builtin_amdgcn_mfma_f32_16x16x32_bf16(k0, v0, z, 0, 0, 0);
            z = __builtin_amdgcn_mfma_f32_16x16x32_bf16(k1, v1, z, 0, 0, 0);
            if (fr == 0) *(f32x4*)(Cit + (size_t)256 * 128 + dt * 16 + 4 * fq) = z;
        }
    }
    __syncthreads();
}

__device__ __forceinline__ void m2_scan(const float* Cbuf, bf16_t* Cin, float* scal, int gtid, int gthreads) {
    constexpr int PER_BH = 256 * 64, TOTAL = 8 * PER_BH;
    constexpr size_t CSTRIDE = (size_t)257 * 128;
    for (int w = gtid; w < TOTAL; w += gthreads) {
        const int bh = w / PER_BH, rem = w % PER_BH, e = rem >> 6, d2 = (rem & 63) * 2;
        const size_t off = ((size_t)bh * 128 * 257 + e) * 128 + d2;
        const float* ptr = Cbuf + off; bf16_t* optr = Cin + off;
        const bool lead = (rem == 0), has_n = (e == 0);
        const size_t noff = (size_t)256 * 128;
        f32x2 C = {0.f, 0.f}, Nn = {0.f, 0.f}; float m = -1e30f;
        for (int c0 = 0; c0 < 128; c0 += 8) {
            f32x2 cl[8], nl[8]; float gm[8], bl[8];
#pragma unroll
            for (int u = 0; u < 8; ++u) { cl[u] = *(const f32x2*)(ptr + (size_t)(c0 + u) * CSTRIDE); gm[u] = scal[(bh * 128 + c0 + u) * 4]; bl[u] = scal[(bh * 128 + c0 + u) * 4 + 1]; nl[u] = (f32x2){0.f, 0.f}; }
            if (has_n) {
#pragma unroll
                for (int u = 0; u < 8; ++u) nl[u] = *(const f32x2*)(ptr + noff + (size_t)(c0 + u) * CSTRIDE);
            }
#pragma unroll
            for (int u = 0; u < 8; ++u) {
                *(unsigned*)(optr + (size_t)(c0 + u) * CSTRIDE) = cvt_pk_bf16(C[0], C[1]);
                if (has_n) *(unsigned*)(optr + noff + (size_t)(c0 + u) * CSTRIDE) = cvt_pk_bf16(Nn[0], Nn[1]);
                if (lead) scal[(bh * 128 + c0 + u) * 4 + 2] = m;
                const float mn = fmaxf(bl[u] + m, gm[u]);
                const float a = expf(bl[u] + m - mn), sc = expf(gm[u] - mn);
                C = C * a + cl[u] * sc; Nn = Nn * a + nl[u] * sc; m = mn;
            }
        }
    }
}

__device__ __forceinline__ void m3_pair(int pr, bf16_t* P, const bf16_t* QK, const float* gif, const float* b_ig, const float* b_fg, const bf16_t* Cbuf, const float* scal,
                                        const float* norm_g, LAS unsigned char* lds, int tid, int wave, int lane) {
    const int half = wave >> 2, tt = wave & 3, item = 2 * pr + half;
    const int c = item & 127, h = (item >> 7) & 3, b = item >> 9;
    const int r0 = b * T_ + c * 64;
    LAS bf16_t* VT = (LAS bf16_t*)(lds + half * 40960);
    LAS float* tb = (LAS float*)(lds + half * 40960 + 36864);
    if (tt == 0) {
        const int row = r0 + lane;
        const float fpre = gif[(size_t)row * 8 + 4 + h] + b_fg[h], ipre = gif[(size_t)row * 8 + h] + b_ig[h];
        float bc = log_sigmoid(fpre);
#pragma unroll
        for (int o = 1; o < 64; o <<= 1) { const float t = __shfl_up(bc, o); if (lane >= o) bc += t; }
        const float gs = ipre - bc;
        float mxs = gs;
#pragma unroll
        for (int o = 1; o < 64; o <<= 1) { const float t = __shfl_up(mxs, o); if (lane >= o) mxs = fmaxf(mxs, t); }
        const float m_in = scal[item * 4 + 2];
        const float alog = bc + m_in;
        const float mt = fmaxf(alog, bc + mxs);
        tb[lane] = bc; tb[64 + lane] = gs; tb[128 + lane] = mt; tb[192 + lane] = expf(alog - mt);
    }
    const int htid = tid & 255;
    {
        u32x4 vva[8];
#pragma unroll
        for (int i = 0; i < 8; ++i) { const int task = htid + 256 * i, tl = task & 63, ce = task >> 6; vva[i] = *(const u32x4*)(P + (size_t)(r0 + tl) * PP + PC_MV + h * 256 + ce * 8); }
        asm volatile("" ::: "memory");
#pragma unroll
        for (int i = 0; i < 8; ++i) {
            const int task = htid + 256 * i, tl = task & 63, ce = task >> 6;
            const u32x4 vv = vva[i];
            const int pos = (tl & 32) + kperm32(tl & 31);
            LAS bf16_t* vp = VT + (ce * 8) * 72 + pos;
            vp[0 * 72] = (bf16_t)(vv.x & 0xffff); vp[1 * 72] = (bf16_t)(vv.x >> 16); vp[2 * 72] = (bf16_t)(vv.y & 0xffff); vp[3 * 72] = (bf16_t)(vv.y >> 16);
            vp[4 * 72] = (bf16_t)(vv.z & 0xffff); vp[5 * 72] = (bf16_t)(vv.z >> 16); vp[6 * 72] = (bf16_t)(vv.w & 0xffff); vp[7 * 72] = (bf16_t)(vv.w >> 16);
        }
    }
    const int fr = lane & 15, fq = lane >> 4;
    const int t = tt * 16 + fr;
    const bf16_t* qp = QK + (size_t)(r0 + t) * 1024 + h * 128 + 8 * fq;
    bf16x8 bq[4];
#pragma unroll
    for (int ks = 0; ks < 4; ++ks) bq[ks] = *(const bf16x8*)(qp + ks * 32);
    const bf16_t* Cin = Cbuf + (size_t)item * 257 * 128;
    bf16x8 kfr[4][4], nfr[4];
#pragma unroll
    for (int st = 0; st < 4; ++st)
#pragma unroll
        for (int ks = 0; ks < 4; ++ks) kfr[st][ks] = *(const bf16x8*)(QK + (size_t)(r0 + st * 16 + fr) * 1024 + 512 + h * 128 + 8 * fq + ks * 32);
#pragma unroll
    for (int ks = 0; ks < 4; ++ks) nfr[ks] = *(const bf16x8*)(Cin + (size_t)256 * 128 + 8 * fq + ks * 32);
    bf16_t* prow = P + (size_t)(r0 + t) * PP;
    u32x2 moa[16];
#pragma unroll
    for (int et = 0; et < 16; ++et) moa[et] = *(const u32x2*)(prow + PC_MO + h * 256 + et * 16 + 4 * fq);
    __syncthreads();
    f32x4 sacc[4];
#pragma unroll
    for (int st = 0; st < 4; ++st) {
        f32x4 z = {0.f, 0.f, 0.f, 0.f};
#pragma unroll
        for (int ks = 0; ks < 4; ++ks) z = __builtin_amdgcn_mfma_f32_16x16x32_bf16(kfr[st][ks], bq[ks], z, 0, 0, 0);
        sacc[st] = z;
    }
    const float bc_t = tb[t], mt_t = tb[128 + t], inter_t = tb[192 + t];
    float dsum = 0.f;
#pragma unroll
    for (int st = 0; st < 4; ++st)
#pragma unroll
        for (int r = 0; r < 4; ++r) {
            const int sidx = st * 16 + 4 * fq + r;
            const float wgt = (sidx <= t) ? __expf(bc_t + tb[64 + sidx] - mt_t) : 0.f;
            const float qk = sacc[st][r] * wgt; sacc[st][r] = qk; dsum += qk;
        }
    dsum += __shfl_xor(dsum, 16); dsum += __shfl_xor(dsum, 32);
    bf16x8 bp[2];
    bp[0] = pack8(sacc[0], sacc[1]); bp[1] = pack8(sacc[2], sacc[3]);
    float qn;
    {
        f32x4 z = {0.f, 0.f, 0.f, 0.f};
#pragma unroll
        for (int ks = 0; ks < 4; ++ks) z = __builtin_amdgcn_mfma_f32_16x16x32_bf16(nfr[ks], bq[ks], z, 0, 0, 0);
        qn = z[0];
    }
    const float den = inter_t * qn + dsum;
    const float inv = 1.0f / fmaxf(fabsf(den), expf(-mt_t));
    f32x4 acc[16];
    float ss = 0.f;
#pragma unroll
    for (int eb = 0; eb < 4; ++eb) {
        bf16x8 cf[4][4];
#pragma unroll
        for (int i = 0; i < 4; ++i)
#pragma unroll
            for (int ks = 0; ks < 4; ++ks) cf[i][ks] = *(const bf16x8*)(Cin + (size_t)((eb * 4 + i) * 16 + fr) * 128 + 8 * fq + ks * 32);
        asm volatile("" ::: "memory");
#pragma unroll
        for (int i = 0; i < 4; ++i) {
            const int et = eb * 4 + i;
            f32x4 z = {0.f, 0.f, 0.f, 0.f};
#pragma unroll
            for (int ks = 0; ks < 4; ++ks) z = __builtin_amdgcn_mfma_f32_16x16x32_bf16(cf[i][ks], bq[ks], z, 0, 0, 0);
            z = z * inter_t;
#pragma unroll
            for (int g = 0; g < 2; ++g) z = __builtin_amdgcn_mfma_f32_16x16x32_bf16(*(const LAS bf16x8*)(VT + (et * 16 + fr) * 72 + g * 32 + 8 * fq), bp[g], z, 0, 0, 0);
            z = z * inv;
            ss += (z[0] * z[0] + z[1] * z[1]) + (z[2] * z[2] + z[3] * z[3]);
            acc[et] = z;
        }
    }
    ss += __shfl_xor(ss, 16); ss += __shfl_xor(ss, 32);
    const float rstd = 1.0f / sqrtf(ss * (1.0f / 256.0f) + EPS);
#pragma unroll
    for (int et = 0; et < 16; ++et) {
        const int e0 = h * 256 + et * 16 + 4 * fq;
        const f32x4 gn = *(const f32x4*)(norm_g + e0);
        const u32x2 mo = moa[et];
        const f32x4 o = acc[et] * rstd * gn;
        u32x2 w; w.x = cvt_pk_bf16(o[0] * bflo(mo.x), o[1] * bfhi(mo.x)); w.y = cvt_pk_bf16(o[2] * bflo(mo.y), o[3] * bfhi(mo.y));
        *(u32x2*)(prow + PC_MV + e0) = w;
    }
    __syncthreads();
}

#define XB_TMO      128
#define XB_XCNT(j)  (256  + 64 * (j))
#define XB_XSUB(j)  (1280 + 64 * (j))
#define XB_XGEN(j)  (2304 + 64 * (j))
#define XB_TOP      3328
#define XB_TOPGEN   3392
#define XCD_BAR_WORDS 3456
#define XB_SPIN_CAP (1u << 20)
__device__ __forceinline__ unsigned xb_ld(unsigned* p)              { return __hip_atomic_load(p, __ATOMIC_RELAXED, __HIP_MEMORY_SCOPE_AGENT); }
__device__ __forceinline__ unsigned xb_add(unsigned* p, unsigned v) { return __hip_atomic_fetch_add(p, v, __ATOMIC_RELAXED, __HIP_MEMORY_SCOPE_AGENT); }
__device__ __forceinline__ unsigned xb_xcc_id() { return (unsigned)__builtin_amdgcn_s_getreg((3 << 11) | 20) & 0xFu; }
#define XB_SPIN(cond, bar) do { unsigned _sp = 0; while (cond) { __builtin_amdgcn_s_sleep(1); \
    if ((++_sp & 255u) == 0u) { if (xb_ld(&(bar)[XB_TMO])) break; if (_sp > XB_SPIN_CAP) { atomicAdd(&(bar)[XB_TMO], 1u); break; } } } } while (0)
struct XcdBarrier { unsigned* bar; unsigned x; volatile LAS unsigned* st; };
__device__ __forceinline__ XcdBarrier xcd_barrier_post(unsigned* bar, volatile LAS unsigned* st) {
    XcdBarrier b; b.bar = bar; b.x = xb_xcc_id(); b.st = st;
    if (threadIdx.x == 0) (void)xb_add(&bar[XB_XCNT(b.x)], 1u);
    return b;
}
__device__ __forceinline__ void xcd_barrier_complete(unsigned* bar, unsigned x, unsigned& nloc, unsigned& nx) {
    const unsigned G = gridDim.x * gridDim.y * gridDim.z;
    unsigned sum, cnt, mine, sp = 0u;
    for (;;) {
        sum = 0u; cnt = 0u; mine = 0u;
#pragma unroll
        for (unsigned j = 0; j < 16; ++j) { const unsigned c = xb_ld(&bar[XB_XCNT(j)]); sum += c; cnt += (c > 0u) ? 1u : 0u; mine = (j == x) ? c : mine; }
        if (sum == G) break;
        __builtin_amdgcn_s_sleep(1);
        if ((++sp & 255u) == 0u) { if (xb_ld(&bar[XB_TMO])) break; if (sp > XB_SPIN_CAP) { atomicAdd(&bar[XB_TMO], 1u); break; } }
    }
    nloc = mine > 0u ? mine : 1u; nx = cnt > 0u ? cnt : 1u;
}
__device__ __forceinline__ void xcd_barrier(const XcdBarrier& b) {
    asm volatile("s_waitcnt vmcnt(0)" ::: "memory");
    __syncthreads();
    if (threadIdx.x == 0) {
        unsigned* bar = b.bar;
        __builtin_amdgcn_s_waitcnt(0);
        unsigned nloc = b.st[0], nx = b.st[1];
        if (nloc == 0u) { xcd_barrier_complete(bar, b.x, nloc, nx); b.st[0] = nloc; b.st[1] = nx; }
        const unsigned old = xb_add(&bar[XB_XSUB(b.x)], 1u);
        const unsigned gen = old / nloc;
        if (old + 1u == (gen + 1u) * nloc) {
            __builtin_amdgcn_fence(__ATOMIC_RELEASE, "agent");
            asm volatile("s_waitcnt vmcnt(0)" ::: "memory");
            const unsigned og = xb_add(&bar[XB_TOP], 1u);
            const unsigned tg = og / nx;
            if (og + 1u == (tg + 1u) * nx) xb_add(&bar[XB_TOPGEN], 1u);
            else XB_SPIN(xb_ld(&bar[XB_TOPGEN]) == tg, bar);
            __builtin_amdgcn_fence(__ATOMIC_ACQUIRE, "agent");
            xb_add(&bar[XB_XGEN(b.x)], 1u);
            asm volatile("s_waitcnt vmcnt(0)" ::: "memory");
        } else {
            XB_SPIN(xb_ld(&bar[XB_XGEN(b.x)]) == gen, bar);
            __builtin_amdgcn_fence(__ATOMIC_ACQUIRE, "agent");
            asm volatile("s_waitcnt vmcnt(0)" ::: "memory");
        }
    }
    __syncthreads();
}

constexpr int N_PHASES = 15;
__global__ void __launch_bounds__(512, 2) fwd_kernel(Args a) {
    extern __shared__ __attribute__((aligned(16))) unsigned char lds_raw[];
    LAS unsigned char* lds = (LAS unsigned char*)lds_raw;
    const int tid = threadIdx.x, lane = tid & 63, wave = __builtin_amdgcn_readfirstlane(tid >> 6);
    const int G = gridDim.x;
    unsigned char* ws = a.ws;
    float* mod = (float*)(ws + WS_MOD); float* rope = (float*)(ws + WS_ROPE); float* gif = (float*)(ws + WS_GIF); float* scal = (float*)(ws + WS_SCAL);
    bf16_t* WinT = (bf16_t*)(ws + WS_WIN); bf16_t* WattT = (bf16_t*)(ws + WS_WATT); bf16_t* WmlT = (bf16_t*)(ws + WS_WML); bf16_t* WoutT = (bf16_t*)(ws + WS_WOUT);
    bf16_t* U = (bf16_t*)(ws + WS_U); bf16_t* QK = (bf16_t*)(ws + WS_QK);
    bf16_t* WfinT = (bf16_t*)(ws + WS_WFIN); bf16_t* WfoutT = (bf16_t*)(ws + WS_WFOUT); bf16_t* ACT = (bf16_t*)(ws + WS_ACT);
    bf16_t* P = (bf16_t*)(ws + WS_P); float* Cbuf = (float*)(ws + WS_CBUF); bf16_t* CinB = (bf16_t*)(ws + WS_CIN);
    bf16_t* WfinT2 = (bf16_t*)(ws + WS_CBUF); bf16_t* WfoutT2 = (bf16_t*)(ws + WS_CBUF + 44 * MiB);
    float* H = a.out;
    const int lo = a.ph_lo, hi = a.ph_hi;
    const int gw = blockIdx.x * 8 + wave, ngw = G * 8;
#define IN(k) (lo <= (k) && (k) < hi)
#if MK_MULTI
#define SEAM(k) do {} while (0)
#else
#define SEAM(k) do { if (IN(k) && IN((k) + 1)) { xcd_barrier(xbar); if (PROBE && blockIdx.x == 0 && tid == 0) tsb[(k) + 1] = __builtin_amdgcn_s_memrealtime(); } } while (0)
    unsigned long long* tsb = (unsigned long long*)(ws + WS_TS);
    volatile LAS unsigned* xst = (volatile LAS unsigned*)(lds + 131072);
    if (tid == 0) { xst[0] = 0u; xst[1] = 0u; }
    if (blockIdx.x == 0) for (int i = tid; i < XCD_BAR_WORDS; i += 512) __hip_atomic_store((unsigned*)(ws + WS_BAR) + i, 0u, __ATOMIC_RELAXED, __HIP_MEMORY_SCOPE_AGENT);
    if (blockIdx.x == 1) for (int i = tid; i < 2 * 64 * 64; i += 512) __hip_atomic_store((unsigned*)(ws + WS_CNT) + i, 0u, __ATOMIC_RELAXED, __HIP_MEMORY_SCOPE_AGENT);
    for (int i = blockIdx.x * 512 + tid; i < 2 * NMOD; i += G * 512) __hip_atomic_store((unsigned*)mod + i, 0u, __ATOMIC_RELAXED, __HIP_MEMORY_SCOPE_AGENT);
    __threadfence();
    cg::this_grid().sync();
    const XcdBarrier xbar = xcd_barrier_post((unsigned*)(ws + WS_BAR), xst);
    if (PROBE && blockIdx.x == 0 && tid == 0) tsb[0] = __builtin_amdgcn_s_memrealtime();
#endif
    const bool fuse_final = (G == 256) && !MK_MULTI && lo == 0 && hi == N_PHASES;
    if (IN(0)) {
        LAS float* scr = (LAS float*)(lds + wave * 16384);
        transpose_all<1>(a.f1_in, D_, 2 * DFF, 2 * DFF, WfinT, D_, scr, gw, ngw, lane);
        transpose_all<0>(a.f1_out, DFF, D_, D_, WfoutT, DFF, scr, gw, ngw, lane);
        transpose_all<2>(a.w_in, D_, PROJ_OUT, PP, WinT, D_, scr, gw, ngw, lane);
        for (int it = gw; it < 72 * 32; it += ngw) {
            const int cgp = it % 72, kc = it / 72, col = cgp * 256 + 4 * lane;
            f32x4 s0 = {0.f, 0.f, 0.f, 0.f}, s1 = {0.f, 0.f, 0.f, 0.f};
#pragma unroll 8
            for (int kk = 0; kk < 64; ++kk) {
                const int k = kc * 64 + kk;
                const float c0 = a.c[k], c1 = a.c[D_ + k];
                const float e0 = c0 * sigm(c0), e1 = c1 * sigm(c1);
                const f32x4 w4 = *(const f32x4*)(a.w_ada + (size_t)k * NMOD + col);
                s0 += w4 * e0; s1 += w4 * e1;
            }
            if (kc == 0) { const f32x4 bb = *(const f32x4*)(a.b_ada + col); s0 += bb; s1 += bb; }
#pragma unroll
            for (int e = 0; e < 4; ++e) { atomicAdd(mod + col + e, s0[e]); atomicAdd(mod + NMOD + col + e, s1[e]); }
        }
        for (int i = blockIdx.x * 512 + tid; i < M_ * 8; i += G * 512) {
            const int row = i >> 3, j = i & 7;
            const float invf = (j == 0) ? 1.0f : (j == 1) ? 0.19392274f : (j == 2) ? 0.03760603f : (j == 3) ? 0.0072926646f : (j == 4) ? 0.0014142136f : (j == 5) ? 0.0002742482f : (j == 6) ? 5.3182957e-05f : 1.0313385e-05f;
            const float ang = (float)a.pos[row] * invf;
            double f = (double)ang * 0.15915494309189535; f -= rint(f);
            rope[(size_t)row * 16 + j] = __builtin_amdgcn_cosf((float)f);
            rope[(size_t)row * 16 + 8 + j] = __builtin_amdgcn_sinf((float)f);
        }
        __syncthreads();
    }
    SEAM(0);
    if (IN(1)) norm_phase<false>(a.x, a.norm1_g, mod, 0, 2048, U, nullptr, nullptr, lds, tid, wave, lane);
    SEAM(1);
    if (IN(2)) { pg8::Gemm g = pg8::mk_gemm(U, WfinT, M_, 2 * DFF, D_, D_); pg8::StaticOrder S; S.init(M_, 2 * DFF, G, (int)blockIdx.x); EpiSwiglu E{ACT}; pg8::gemm_phase(lds, g, S, E); }
    SEAM(2);
    if (IN(3)) { pg8::Gemm g = pg8::mk_gemm_tiledA(ACT, WfoutT, M_, D_, DFF); pg8::StaticOrder S; S.init(M_, D_, G, (int)blockIdx.x, 4); EpiResid E{a.x, H, mod + 4096, 0.5f}; pg8::gemm_phase(lds, g, S, E); }
    SEAM(3);
    if (IN(4)) norm_phase<true>(H, a.norm2_g, mod, 6144, 8192, U, gif, a.w_in, lds, tid, wave, lane);
    SEAM(4);
    if (IN(5)) { pg8::Gemm g = pg8::mk_gemm(U, WinT, M_, 8192, D_, D_); pg8::StaticOrder S; S.init(M_, 8192, G, (int)blockIdx.x); EpiProj E{P, rope}; pg8::gemm_phase(lds, g, S, E); }
    SEAM(5);
    if (IN(6)) {
        for (int blk = blockIdx.x; blk < 256; blk += G) proj_tail(blk, U, WinT, P, lds, tid, wave, lane);
        for (int it = blockIdx.x; it < 256; it += G) attn_item(it, P, a.sinks, lds, tid, wave, lane);
        for (int pr = blockIdx.x; pr < 512; pr += G) m1_pair(pr, P, QK, gif, a.conv_w, a.conv_b, a.b_ig, a.b_fg, Cbuf, scal, lds, tid, wave, lane);
    }
    SEAM(6);
    if (IN(7)) {
        m2_scan(Cbuf, CinB, scal, blockIdx.x * 512 + tid, G * 512);
        LAS float* scr = (LAS float*)(lds + wave * 16384);
        transpose_all<0>(a.w_att, 1024, D_, D_, WattT, 2048, scr, gw, ngw, lane);
        transpose_all<0>(a.w_ml, 1024, D_, D_, WattT + 1024, 2048, scr, gw, ngw, lane);
        transpose_all<0>(a.w_out, D_, D_, D_, WoutT, D_, scr, gw, ngw, lane);
    }
    SEAM(7);
    if (IN(8)) {
        LAS float* scr = (LAS float*)(lds + wave * 16384);
        const bool tfirst = (blockIdx.x & 1) != 0;
        if (tfirst) {
            transpose_all<1>(a.f2_in, D_, 2 * DFF, 2 * DFF, WfinT2, D_, scr, gw, ngw, lane);
            transpose_all<0>(a.f2_out, DFF, D_, D_, WfoutT2, DFF, scr, gw, ngw, lane);
            __syncthreads();
        }
        for (int pr = blockIdx.x; pr < 512; pr += G) m3_pair(pr, P, QK, gif, a.b_ig, a.b_fg, CinB, scal, a.mnorm_g, lds, tid, wave, lane);
        if (!tfirst) {
            transpose_all<1>(a.f2_in, D_, 2 * DFF, 2 * DFF, WfinT2, D_, scr, gw, ngw, lane);
            transpose_all<0>(a.f2_out, DFF, D_, D_, WfoutT2, DFF, scr, gw, ngw, lane);
        }
    }
    SEAM(8);
    if (IN(9)) {
        pg8::Gemm g = pg8::mk_gemm(P + PC_Q, WattT, M_, D_, D_, PP); g.ksplit = 16; g.ajump = (size_t)(PC_MV - PC_Q - 1024) * 2;
        pg8::StaticOrder S; S.init(M_, D_, G, (int)blockIdx.x, 4); EpiMerge E{P}; pg8::gemm_phase(lds, g, S, E);
    }
    SEAM(9);
    if (IN(10)) {
        pg8::Gemm g = pg8::mk_gemm(P + PC_G, WoutT, M_, D_, D_, PP); pg8::StaticOrder S; S.init(M_, D_, G, (int)blockIdx.x, 4);
        if (fuse_final) { EpiNormU E{H, H, mod + 10240, a.norm3_g, mod + 12288, mod + 14336, U, (float*)(ws + WS_XBUF2), (unsigned*)(ws + WS_CNT2), lds + 131072 + 64}; pg8::gemm_phase(lds, g, S, E); }
        else { EpiResid E{H, H, mod + 10240, 1.0f}; pg8::gemm_phase(lds, g, S, E); }
    }
    SEAM(10);
    if (!fuse_final) {
        if (IN(11)) norm_phase<false>(H, a.norm3_g, mod, 12288, 14336, U, nullptr, nullptr, lds, tid, wave, lane);
        SEAM(11);
    }
    if (IN(12)) { pg8::Gemm g = pg8::mk_gemm(U, WfinT2, M_, 2 * DFF, D_, D_); pg8::StaticOrder S; S.init(M_, 2 * DFF, G, (int)blockIdx.x); EpiSwiglu E{ACT}; pg8::gemm_phase(lds, g, S, E); }
    SEAM(12);
    if (IN(13)) {
        pg8::Gemm g = pg8::mk_gemm_tiledA(ACT, WfoutT2, M_, D_, DFF); pg8::StaticOrder S; S.init(M_, D_, G, (int)blockIdx.x, 4);
        if (fuse_final) { EpiFinal E{H, H, mod + 16384, a.final_g, (float*)(ws + WS_XBUF), (unsigned*)(ws + WS_CNT), lds + 131072 + 64}; pg8::gemm_phase(lds, g, S, E); }
        else { EpiResid E{H, H, mod + 16384, 0.5f}; pg8::gemm_phase(lds, g, S, E); }
    }
    if (!fuse_final) SEAM(13);
    if (IN(14) && !fuse_final) {
        for (int rowa = gw; rowa < M_; rowa += 2 * ngw) {
            f32x4 v[2][8]; float rs[2];
#pragma unroll
            for (int q = 0; q < 2; ++q) {
                const int row = min(rowa + q * ngw, M_ - 1);
                const f32x4* xr = (const f32x4*)(H + (size_t)row * D_) + lane;
#pragma unroll
                for (int j = 0; j < 8; ++j) v[q][j] = xr[64 * j];
            }
#pragma unroll
            for (int q = 0; q < 2; ++q) {
                float ss = 0.f;
#pragma unroll
                for (int j = 0; j < 8; ++j) ss += (v[q][j][0] * v[q][j][0] + v[q][j][1] * v[q][j][1]) + (v[q][j][2] * v[q][j][2] + v[q][j][3] * v[q][j][3]);
                rs[q] = 1.0f / sqrtf(wave_sum(ss) * (1.0f / D_) + EPS);
            }
#pragma unroll
            for (int q = 0; q < 2; ++q) {
                const int row = rowa + q * ngw;
                if (row < M_) {
                    f32x4* xr = (f32x4*)(H + (size_t)row * D_) + lane;
#pragma unroll
                    for (int j = 0; j < 8; ++j) { const f32x4 g4 = *(const f32x4*)(a.final_g + 256 * j + 4 * lane); xr[64 * j] = (v[q][j] * rs[q]) * g4; }
                }
            }
        }
    }
#if PROBE
    xcd_barrier(xbar);
    if (blockIdx.x == 0 && tid == 0) tsb[15] = __builtin_amdgcn_s_memrealtime();
    xcd_barrier(xbar);
    { const float tau = (float)(tsb[PROBE_B] - tsb[PROBE_A]) * 0.01f / PROBE_FULL_US; float pdelta = 0.01f * sqrtf(tau); if (lane & 1) pdelta = -pdelta;
      if (gw < 512) { f32x4* xr = (f32x4*)(H + (size_t)gw * D_) + lane;
#pragma unroll
        for (int j = 0; j < 8; ++j) xr[64 * j] = xr[64 * j] + pdelta; } }
#endif
#undef IN
#undef SEAM
}

extern "C" void kernel_launch(void* const* d_in, const int* in_sizes, int n_in, void* d_out, int out_size, void* d_ws, size_t ws_size, hipStream_t stream) {
    static int grid = 0;
    if (grid == 0) {
        if (n_in != 23 || out_size != M_ * D_ || ws_size < WS_NEED) { fprintf(stderr, "kernel_launch: unexpected shapes (n_in %d, out %d, ws %zu < %zu)\n", n_in, out_size, ws_size, (size_t)WS_END); grid = -1; return; }
        int dev = 0, cus = 0, per_cu = 0;
        (void)hipGetDevice(&dev);
        (void)hipDeviceGetAttribute(&cus, hipDeviceAttributeMultiprocessorCount, dev);
        (void)hipFuncSetAttribute((const void*)fwd_kernel, hipFuncAttributeMaxDynamicSharedMemorySize, LDS_BYTES);
        (void)hipOccupancyMaxActiveBlocksPerMultiprocessor(&per_cu, (const void*)fwd_kernel, 512, LDS_BYTES);
        if (per_cu < 1) per_cu = 1;
        (void)hipGetLastError();
        grid = cus * per_cu;
    }
    if (grid < 0) return;
#if MK_MULTI
    (void)hipMemsetAsync((char*)d_ws + WS_MOD, 0, CTL_ZERO_BYTES, stream);
#endif
    Args a{};
    a.x = (const float*)d_in[0]; a.c = (const float*)d_in[1]; a.pos = (const int*)d_in[2]; a.w_ada = (const float*)d_in[3]; a.b_ada = (const float*)d_in[4];
    a.norm1_g = (const float*)d_in[5]; a.f1_in = (const float*)d_in[6]; a.f1_out = (const float*)d_in[7]; a.norm2_g = (const float*)d_in[8]; a.w_in = (const float*)d_in[9];
    a.conv_w = (const float*)d_in[10]; a.conv_b = (const float*)d_in[11]; a.b_ig = (const float*)d_in[12]; a.b_fg = (const float*)d_in[13]; a.sinks = (const float*)d_in[14];
    a.mnorm_g = (const float*)d_in[15]; a.w_att = (const float*)d_in[16]; a.w_ml = (const float*)d_in[17]; a.w_out = (const float*)d_in[18]; a.norm3_g = (const float*)d_in[19];
    a.f2_in = (const float*)d_in[20]; a.f2_out = (const float*)d_in[21]; a.final_g = (const float*)d_in[22];
    a.out = (float*)d_out; a.ws = (unsigned char*)d_ws;
#if MK_MULTI
    for (int p = 0; p < N_PHASES; ++p) { a.ph_lo = p; a.ph_hi = p + 1; hipLaunchKernelGGL(fwd_kernel, dim3(grid), dim3(512), LDS_BYTES, stream, a); }
#else
    a.ph_lo = 0; a.ph_hi = N_PHASES;
    void* args[] = {&a};
    hipError_t e = hipLaunchCooperativeKernel((const void*)fwd_kernel, dim3(grid), dim3(512), args, LDS_BYTES, stream);
    if (e != hipSuccess) fprintf(stderr, "cooperative launch failed: %s (grid %d)\n", hipGetErrorString(e), grid);
#endif
}
```

```cpp
#include <hip/hip_runtime.h>
#include <hip/hip_cooperative_groups.h>
#include <cstdio>
#include <cstdint>
namespace cg = cooperative_groups;

#ifndef MK_MULTI
#define MK_MULTI 0
#endif

#ifndef PROBE_A
#define PROBE_A -1
#define PROBE_B -1
#endif
#define PROBE_FULL_US 1000.0f
#define PROBE (PROBE_A >= 0)
#define LAS __attribute__((address_space(3)))
typedef unsigned short bf16_t;
typedef short bf16x8 __attribute__((ext_vector_type(8)));
typedef float f32x4 __attribute__((ext_vector_type(4)));
typedef float f32x2 __attribute__((ext_vector_type(2)));
typedef unsigned u32x4 __attribute__((ext_vector_type(4)));
typedef unsigned u32x2 __attribute__((ext_vector_type(2)));

constexpr int M_ = 16384, D_ = 2048, T_ = 8192, DFF = 5632, NMOD = 18432, PROJ_OUT = 8456;
constexpr int PP = 8448;
constexpr int PC_Q = 0, PC_K = 1024, PC_V = 1152, PC_MQK = 1280, PC_MV = 2304, PC_MO = 3328, PC_G = 4352;
constexpr float EPS = 1e-6f;
constexpr size_t MiB = 1u << 20;
constexpr size_t WS_MOD = 0, MOD_BYTES = 2 * NMOD * 4, WS_BAR = 192 * 1024, CTL_ZERO_BYTES = 256 * 1024;
constexpr size_t WS_TS = 3 * MiB;
constexpr size_t WS_CNT = 224 * 1024;
constexpr size_t WS_XBUF = 3 * MiB + 512 * 1024;
constexpr size_t WS_CNT2 = 240 * 1024, WS_XBUF2 = 576 * MiB, WS_NEED = WS_XBUF2 + 512 * 1024;
constexpr size_t WS_ROPE = 1 * MiB, WS_GIF = 2 * MiB, WS_SCAL = 2 * MiB + 512 * 1024;
constexpr size_t WS_WIN = 4 * MiB, WS_WATT = 37 * MiB, WS_WML = 41 * MiB, WS_WOUT = 45 * MiB;
constexpr size_t WS_U = 53 * MiB;
constexpr size_t WS_R = 117 * MiB;
constexpr size_t WS_WFIN = WS_R, WS_WFOUT = WS_R + 44 * MiB, WS_ACT = WS_R + 66 * MiB;
constexpr size_t WS_P = WS_R, WS_CBUF = WS_R + 264 * MiB;
constexpr size_t WS_CIN = WS_CBUF + (size_t)1024 * 257 * 128 * 4;
constexpr size_t WS_END = WS_CIN + (size_t)1024 * 257 * 128 * 2;
constexpr int LDS_BYTES = 147456;

namespace pg8 {
constexpr int BM = 256, BK = 64, HALF = 128, HTB = HALF * BK * 2, STAGE_BYTES = 8 * HTB, NXCD = 8, WGM = 8;
__host__ __device__ __forceinline__ int lds_byte(int r, int c) { const int st = (r >> 4) * 2 + (c >> 5), rr = r & 15, cc = c & 31, ob = rr * 64 + cc * 2; return st * 1024 + (ob ^ (((ob >> 9) & 1) << 5)); }
__host__ __device__ __forceinline__ void stage_rc(int b, int& R, int& C) { const int st = b / 1024, sb = b % 1024, swz = sb ^ (((sb >> 9) & 1) << 5); R = (st >> 1) * 16 + swz / 64; C = (st & 1) * 32 + (swz % 64) / 2; }
__host__ __device__ __forceinline__ int perm32(int rho) { const int n = rho >> 4, i = rho & 15; return 8 * (i >> 2) + 4 * n + (i & 3); }
struct Unit { int pm, pn; };
struct Gemm { const bf16_t* A; const bf16_t* Bt; int M, N, K, lda; size_t kstepA, tstepA; int ksplit; size_t ajump; };
__host__ __device__ __forceinline__ Gemm mk_gemm(const bf16_t* A, const bf16_t* Bt, int M, int N, int K, int lda) { return Gemm{A, Bt, M, N, K, lda, (size_t)(BK * 2), (size_t)BM * lda * 2, 1 << 30, 0}; }
__host__ __device__ __forceinline__ Gemm mk_gemm_tiledA(const bf16_t* A, const bf16_t* Bt, int M, int N, int K) { return Gemm{A, Bt, M, N, K, BK, (size_t)BM * BK * 2, (size_t)(K / BK) * BM * BK * 2, 1 << 30, 0}; }
struct StaticOrder {
    int nM, nN, nwg, G, c, wgm;
    __host__ __device__ void init(int M, int N, int G_, int c_, int wgm_ = WGM) { nM = M / BM; nN = N / BM; nwg = nM * nN; G = G_; c = c_; wgm = wgm_; }
    __host__ __device__ bool next(int i, Unit& u) const {
        const long L = (long)i * G + c; if (L >= nwg) return false;
        int wgid = (int)L; { const int q = nwg / NXCD, r = nwg % NXCD, xcd = wgid % NXCD, off = wgid / NXCD; wgid = (xcd < r ? xcd * (q + 1) : r * (q + 1) + (xcd - r) * q) + off; }
        const int nig = wgm * nN, gid = wgid / nig, fm = gid * wgm, gsz = (nM - fm) < wgm ? (nM - fm) : wgm;
        u.pm = fm + ((wgid % nig) % gsz); u.pn = (wgid % nig) / gsz; return true;
    }
};
__device__ __forceinline__ unsigned cvt_pk_bf16(float lo, float hi) { unsigned r; asm volatile("v_cvt_pk_bf16_f32 %0, %1, %2" : "=v"(r) : "v"(lo), "v"(hi)); return r; }

template <class Epi>
__device__ __forceinline__ void gemm_phase(LAS unsigned char* lds, const Gemm g, const StaticOrder& S, const Epi& E) {
    const int tid = threadIdx.x, wid = __builtin_amdgcn_readfirstlane(tid >> 6), lane = tid & 63, wr = wid >> 2, wc = wid & 3, fr = lane & 15, fq = lane >> 4;
    const int K = g.K, nt = K / BK, lda = g.lda;
    unsigned voffA[2], voffB[2];
#pragma unroll
    for (int i = 0; i < 2; ++i) { int R, C; stage_rc(tid * 16 + i * 8192, R, C); const int Rb = (R & ~31) + perm32(R & 31);
        voffA[i] = (unsigned)(R * lda + C) * 2u; voffB[i] = (unsigned)(Rb * K + C) * 2u; }
    const size_t kstep = (size_t)(BK * 2);
    const size_t hstepA = (size_t)HALF * lda * 2, hstepB = (size_t)HALF * K * 2;
    const size_t tstepA = g.tstepA, tstepB = 2 * hstepB, kstepA = g.kstepA;
    const unsigned ldsw = (unsigned)wid * 1024u;
    const int aoff = lds_byte(wr * 64 + fr, fq * 8), boff = lds_byte(wc * 32 + fr, fq * 8);
#define PG8_SA(b, h) (((b) * 2 + (h)) * HTB)
#define PG8_SB(b, h) ((4 + (b) * 2 + (h)) * HTB)
#define PG8_STAGE(bufoff, gbase, voff) do { _Pragma("unroll") for (int _i = 0; _i < 2; ++_i) \
        __builtin_amdgcn_global_load_lds((const unsigned*)((const char*)(gbase) + (voff)[_i]), (LAS unsigned*)(lds + (bufoff) + ldsw + _i * 8192), 16, 0, 0); } while (0)
#define PG8_LDA(dst, b, h) do { _Pragma("unroll") for (int m = 0; m < 4; ++m) _Pragma("unroll") for (int k = 0; k < 2; ++k) dst[m][k] = *(const LAS bf16x8*)(lds + PG8_SA(b, h) + aoff + m * 2048 + k * 1024); } while (0)
#define PG8_LDB(dst, b, h) do { _Pragma("unroll") for (int n = 0; n < 2; ++n) _Pragma("unroll") for (int k = 0; k < 2; ++k) dst[n][k] = *(const LAS bf16x8*)(lds + PG8_SB(b, h) + boff + n * 2048 + k * 1024); } while (0)
#define PG8_MMA(ai, bj, At, Bt) do { __builtin_amdgcn_s_setprio(1); _Pragma("unroll") for (int m = 0; m < 4; ++m) _Pragma("unroll") for (int n = 0; n < 2; ++n) _Pragma("unroll") for (int k = 0; k < 2; ++k) \
        acc[ai][bj][m][n] = __builtin_amdgcn_mfma_f32_16x16x32_bf16(Bt[n][k], At[m][k], acc[ai][bj][m][n], 0, 0, 0); __builtin_amdgcn_s_setprio(0); } while (0)
#define PG8_WAIT_V(n) asm volatile("s_waitcnt vmcnt(" #n ")" ::: "memory")
#define PG8_WAIT_L(n) asm volatile("s_waitcnt lgkmcnt(" #n ")" ::: "memory")
#define PG8_BAR __builtin_amdgcn_s_barrier()
#define PG8_SCHED __builtin_amdgcn_sched_barrier(0)
    Unit cur, nxt; int ui = 0;
    if (!S.next(0, cur)) return;
    f32x4 acc[2][2][4][2];
#pragma unroll
    for (int a = 0; a < 2; ++a)
#pragma unroll
        for (int b = 0; b < 2; ++b)
#pragma unroll
            for (int m = 0; m < 4; ++m)
#pragma unroll
                for (int n = 0; n < 2; ++n) acc[a][b][m][n] = (f32x4){0.f, 0.f, 0.f, 0.f};
    bf16x8 At[4][2], B0[2][2], B1[2][2];
    const char* cA = (const char*)g.A + (size_t)cur.pm * tstepA; const char* cB = (const char*)g.Bt + (size_t)cur.pn * tstepB;
    PG8_STAGE(PG8_SB(0, 0), cB, voffB); PG8_STAGE(PG8_SB(0, 1), cB + hstepB, voffB); PG8_STAGE(PG8_SA(0, 0), cA, voffA); PG8_STAGE(PG8_SA(0, 1), cA + hstepA, voffA);
    if (wr == 1) PG8_BAR;
    PG8_WAIT_V(2); PG8_BAR;
    PG8_STAGE(PG8_SB(1, 0), cB + kstep, voffB); PG8_STAGE(PG8_SA(1, 0), cA + kstepA, voffA); PG8_STAGE(PG8_SB(1, 1), cB + hstepB + kstep, voffB);
    PG8_WAIT_V(6); PG8_BAR;
    for (;;) {
        const bool has_next = S.next(ui + 1, nxt);
        const char* nA = has_next ? (const char*)g.A + (size_t)nxt.pm * tstepA : cA; const char* nB = has_next ? (const char*)g.Bt + (size_t)nxt.pn * tstepB : cB;
        for (int t = 0; t < nt; t += 2) {
            const bool last = (t == nt - 2);
            const char* a1 = cA + (size_t)(t + 1) * kstepA + ((t + 1) >= g.ksplit ? g.ajump : 0);
            const char* a2 = last ? nA : cA + (size_t)(t + 2) * kstepA + ((t + 2) >= g.ksplit ? g.ajump : 0); const char* b2 = last ? nB : cB + (size_t)(t + 2) * kstep;
            const char* a3 = last ? nA + kstepA : cA + (size_t)(t + 3) * kstepA + ((t + 3) >= g.ksplit ? g.ajump : 0); const char* b3 = b2 + kstep;
            if constexpr (Epi::HAS_MID) { if (t == g.ksplit) E.mid(acc, cur, wr, wc, fr, fq); }
            PG8_LDB(B0, 0, 0); PG8_LDB(B1, 0, 1); PG8_SCHED; PG8_LDA(At, 0, 0); PG8_STAGE(PG8_SA(1, 1), a1 + hstepA, voffA);
            PG8_WAIT_V(8); PG8_WAIT_L(0); PG8_BAR; PG8_MMA(0, 0, At, B0); PG8_MMA(0, 1, At, B1); PG8_BAR; PG8_SCHED;
            PG8_LDA(At, 0, 1); PG8_STAGE(PG8_SB(0, 0), b2, voffB); PG8_STAGE(PG8_SB(0, 1), b2 + hstepB, voffB); PG8_STAGE(PG8_SA(0, 0), a2, voffA);
            PG8_WAIT_V(8); PG8_WAIT_L(0); PG8_BAR; PG8_MMA(1, 0, At, B0); PG8_MMA(1, 1, At, B1); PG8_BAR; PG8_SCHED;
            PG8_LDB(B0, 1, 0); PG8_LDB(B1, 1, 1); PG8_SCHED; PG8_LDA(At, 1, 0); PG8_STAGE(PG8_SA(0, 1), a2 + hstepA, voffA);
            PG8_WAIT_V(8); PG8_WAIT_L(0); PG8_BAR; PG8_MMA(0, 0, At, B0); PG8_MMA(0, 1, At, B1); PG8_BAR; PG8_SCHED;
            PG8_LDA(At, 1, 1); PG8_STAGE(PG8_SB(1, 0), b3, voffB); PG8_STAGE(PG8_SB(1, 1), b3 + hstepB, voffB); PG8_STAGE(PG8_SA(1, 0), a3, voffA);
            PG8_WAIT_V(8); PG8_WAIT_L(0); PG8_BAR; PG8_MMA(1, 0, At, B0); PG8_MMA(1, 1, At, B1); PG8_BAR; PG8_SCHED;
        }
        if (wr == 0) PG8_BAR;
        E(acc, cur, wr, wc, fr, fq);
        if (!has_next) break;
#pragma unroll
        for (int a = 0; a < 2; ++a)
#pragma unroll
            for (int b = 0; b < 2; ++b)
#pragma unroll
                for (int m = 0; m < 4; ++m)
#pragma unroll
                    for (int n = 0; n < 2; ++n) acc[a][b][m][n] = (f32x4){0.f, 0.f, 0.f, 0.f};
        cur = nxt; cA = nA; cB = nB; ++ui;
        if (wr == 1) PG8_BAR;
    }
    PG8_WAIT_V(0);
    PG8_BAR;
#undef PG8_SA
#undef PG8_SB
#undef PG8_STAGE
#undef PG8_LDA
#undef PG8_LDB
#undef PG8_MMA
#undef PG8_WAIT_V
#undef PG8_WAIT_L
#undef PG8_BAR
#undef PG8_SCHED
}
}
using pg8::cvt_pk_bf16;
using pg8::Unit;

__device__ __forceinline__ float bf2f(unsigned short h) { return __uint_as_float((unsigned)h << 16); }
__device__ __forceinline__ float bflo(unsigned w) { return __uint_as_float(w << 16); }
__device__ __forceinline__ float bfhi(unsigned w) { return __uint_as_float(w & 0xffff0000u); }
__device__ __forceinline__ unsigned short f2bf(float f) { return (unsigned short)(cvt_pk_bf16(f, 0.f) & 0xffffu); }
__device__ __forceinline__ float sigm(float x) { return __builtin_amdgcn_rcpf(1.f + __expf(-x)); }
__device__ __forceinline__ float wave_sum(float v) {
#pragma unroll
    for (int o = 1; o < 64; o <<= 1) v += __shfl_xor(v, o);
    return v;
}
__device__ __forceinline__ float wave_max(float v) {
#pragma unroll
    for (int o = 1; o < 64; o <<= 1) v = fmaxf(v, __shfl_xor(v, o));
    return v;
}
__device__ __forceinline__ float log_sigmoid(float x) { return fminf(x, 0.f) - log1pf(expf(-fabsf(x))); }
__device__ __forceinline__ bf16x8 pack8(f32x4 a, f32x4 b) {
    u32x4 w; w.x = cvt_pk_bf16(a[0], a[1]); w.y = cvt_pk_bf16(a[2], a[3]); w.z = cvt_pk_bf16(b[0], b[1]); w.w = cvt_pk_bf16(b[2], b[3]);
    return __builtin_bit_cast(bf16x8, w);
}
__device__ __forceinline__ int kperm32(int kl) { return 8 * ((kl & 15) >> 2) + (kl & 3) + 4 * (kl >> 4); }

struct EpiSwiglu { static constexpr bool HAS_MID = false;
    bf16_t* O;
    __device__ __forceinline__ void operator()(const f32x4 (&acc)[2][2][4][2], const Unit& u, int wr, int wc, int fr, int fq) const {
        const int row0 = u.pm * 256 + wr * 64 + fr, col0 = u.pn * 128 + wc * 32 + 8 * fq;
#pragma unroll
        for (int ai = 0; ai < 2; ++ai)
#pragma unroll
            for (int m = 0; m < 4; ++m) {
                const int row = row0 + ai * 128 + m * 16;
                bf16_t* rowp = O + (((size_t)u.pm * (DFF / 64) + (col0 >> 6)) * 256 + (row & 255)) * 64 + (col0 & 63);
                float v[8];
#pragma unroll
                for (int n = 0; n < 2; ++n)
#pragma unroll
                    for (int e = 0; e < 4; ++e) { const float a = acc[ai][0][m][n][e], b = acc[ai][1][m][n][e]; v[n * 4 + e] = a * sigm(a) * b; }
                u32x4 w; w.x = cvt_pk_bf16(v[0], v[1]); w.y = cvt_pk_bf16(v[2], v[3]); w.z = cvt_pk_bf16(v[4], v[5]); w.w = cvt_pk_bf16(v[6], v[7]);
                *(u32x4*)rowp = w;
            }
    }
};
struct EpiResid { static constexpr bool HAS_MID = false;
    const float* base; float* out; const float* gate; float scale;
    __device__ __forceinline__ void operator()(const f32x4 (&acc)[2][2][4][2], const Unit& u, int wr, int wc, int fr, int fq) const {
        const int row0 = u.pm * 256 + wr * 64 + fr, col0 = u.pn * 256 + wc * 32 + 8 * fq;
        const float* gp = gate + (size_t)(u.pm >> 5) * NMOD + col0;
#pragma unroll
        for (int ai = 0; ai < 2; ++ai) {
            f32x4 bs[4][2][2];
#pragma unroll
            for (int m = 0; m < 4; ++m) {
                const size_t off = (size_t)(row0 + ai * 128 + m * 16) * D_ + col0;
#pragma unroll
                for (int bj = 0; bj < 2; ++bj)
#pragma unroll
                    for (int n = 0; n < 2; ++n) bs[m][bj][n] = *(const f32x4*)(base + off + bj * 128 + 4 * n);
            }
            asm volatile("" ::: "memory");
#pragma unroll
            for (int m = 0; m < 4; ++m) {
                const size_t off = (size_t)(row0 + ai * 128 + m * 16) * D_ + col0;
#pragma unroll
                for (int bj = 0; bj < 2; ++bj)
#pragma unroll
                    for (int n = 0; n < 2; ++n) *(f32x4*)(out + off + bj * 128 + 4 * n) = bs[m][bj][n] + (*(const f32x4*)(gp + bj * 128 + 4 * n) * scale) * acc[ai][bj][m][n];
            }
            asm volatile("" ::: "memory");
        }
    }
};
struct EpiFinal { static constexpr bool HAS_MID = false;
    const float* base; float* out; const float* gate; const float* gfin; float* xbuf; unsigned* cnt; LAS unsigned char* xl;
    __device__ __forceinline__ void operator()(f32x4 (&acc)[2][2][4][2], const Unit& u, int wr, int wc, int fr, int fq) const {
        constexpr float scale = 0.5f;
        const int row0 = u.pm * 256 + wr * 64 + fr, col0 = u.pn * 256 + wc * 32 + 8 * fq;
        const float* gp = gate + (size_t)(u.pm >> 5) * NMOD + col0;
        LAS float* Pst = (LAS float*)xl;
        LAS float* S = Pst + 1024;
        {
            f32x4 gv[2][2];
#pragma unroll
            for (int bj = 0; bj < 2; ++bj)
#pragma unroll
                for (int n = 0; n < 2; ++n) gv[bj][n] = *(const f32x4*)(gp + bj * 128 + 4 * n) * scale;
#pragma unroll
            for (int ai = 0; ai < 2; ++ai)
#pragma unroll
                for (int mh = 0; mh < 2; ++mh) {
                    f32x4 bs[2][2][2];
#pragma unroll
                    for (int m2 = 0; m2 < 2; ++m2) {
                        const size_t off = (size_t)(row0 + ai * 128 + (mh * 2 + m2) * 16) * D_ + col0;
#pragma unroll
                        for (int bj = 0; bj < 2; ++bj)
#pragma unroll
                            for (int n = 0; n < 2; ++n) bs[m2][bj][n] = *(const f32x4*)(base + off + bj * 128 + 4 * n);
                    }
                    asm volatile("" ::: "memory");
#pragma unroll
                    for (int m2 = 0; m2 < 2; ++m2) {
                        const int m = mh * 2 + m2;
                        float sq = 0.f;
#pragma unroll
                        for (int bj = 0; bj < 2; ++bj)
#pragma unroll
                            for (int n = 0; n < 2; ++n) { const f32x4 hv = bs[m2][bj][n] + gv[bj][n] * acc[ai][bj][m][n]; acc[ai][bj][m][n] = hv; sq += (hv[0] * hv[0] + hv[1] * hv[1]) + (hv[2] * hv[2] + hv[3] * hv[3]); }
                        sq += __shfl_xor(sq, 16); sq += __shfl_xor(sq, 32);
                        if (fq == 0) Pst[(ai * 128 + wr * 64 + m * 16 + fr) * 4 + wc] = sq;
                    }
                    asm volatile("" ::: "memory");
                }
        }
        asm volatile("s_waitcnt lgkmcnt(0)" ::: "memory"); __builtin_amdgcn_s_barrier(); asm volatile("" ::: "memory");
        const int tid = threadIdx.x;
        if (tid < 256) { const f32x4 p4 = *(const LAS f32x4*)(Pst + tid * 4);
            __hip_atomic_store(xbuf + ((size_t)u.pm * 256 + tid) * 8 + u.pn, (p4[0] + p4[1]) + (p4[2] + p4[3]), __ATOMIC_RELAXED, __HIP_MEMORY_SCOPE_AGENT); }
        asm volatile("s_waitcnt vmcnt(0) lgkmcnt(0)" ::: "memory"); __builtin_amdgcn_s_barrier(); asm volatile("" ::: "memory");
        if (tid == 0) {
            unsigned* cw = cnt + 64 * u.pm;
            __hip_atomic_fetch_add(cw, 1u, __ATOMIC_RELAXED, __HIP_MEMORY_SCOPE_AGENT);
            unsigned sp = 0;
            while (__hip_atomic_load(cw, __ATOMIC_RELAXED, __HIP_MEMORY_SCOPE_AGENT) < 8u) { __builtin_amdgcn_s_sleep(2); if (++sp > (1u << 22)) break; }
        }
        asm volatile("s_waitcnt vmcnt(0) lgkmcnt(0)" ::: "memory"); __builtin_amdgcn_s_barrier(); asm volatile("" ::: "memory");
        if (tid < 256) {
            const float* xp = xbuf + ((size_t)u.pm * 256 + tid) * 8; float tot = 0.f;
#pragma unroll
            for (int t = 0; t < 8; ++t) tot += __hip_atomic_load(xp + t, __ATOMIC_RELAXED, __HIP_MEMORY_SCOPE_AGENT);
            S[tid] = 1.0f / sqrtf(tot * (1.0f / D_) + EPS);
        }
        asm volatile("s_waitcnt vmcnt(0) lgkmcnt(0)" ::: "memory"); __builtin_amdgcn_s_barrier(); asm volatile("" ::: "memory");
        f32x4 gf[2][2];
#pragma unroll
        for (int bj = 0; bj < 2; ++bj)
#pragma unroll
            for (int n = 0; n < 2; ++n) gf[bj][n] = *(const f32x4*)(gfin + col0 + bj * 128 + 4 * n);
#pragma unroll
        for (int ai = 0; ai < 2; ++ai)
#pragma unroll
            for (int m = 0; m < 4; ++m) {
                const float r = S[ai * 128 + wr * 64 + m * 16 + fr];
                const size_t off = (size_t)(row0 + ai * 128 + m * 16) * D_ + col0;
#pragma unroll
                for (int bj = 0; bj < 2; ++bj)
#pragma unroll
                    for (int n = 0; n < 2; ++n) *(f32x4*)(out + off + bj * 128 + 4 * n) = (acc[ai][bj][m][n] * r) * gf[bj][n];
            }
        asm volatile("s_waitcnt lgkmcnt(0)" ::: "memory"); __builtin_amdgcn_s_barrier(); asm volatile("" ::: "memory");
    }
};
struct EpiNormU { static constexpr bool HAS_MID = false;
    const float* base; float* out; const float* gate; const float* gn; const float* shp; const float* scp; bf16_t* U; float* xbuf; unsigned* cnt; LAS unsigned char* xl;
    __device__ __forceinline__ void operator()(f32x4 (&acc)[2][2][4][2], const Unit& u, int wr, int wc, int fr, int fq) const {
        constexpr float scale = 1.0f;
        const int row0 = u.pm * 256 + wr * 64 + fr, col0 = u.pn * 256 + wc * 32 + 8 * fq;
        const float* gp = gate + (size_t)(u.pm >> 5) * NMOD + col0;
        LAS float* Pst = (LAS float*)xl;
        LAS float* S = Pst + 1024;
        {
            f32x4 gv[2][2];
#pragma unroll
            for (int bj = 0; bj < 2; ++bj)
#pragma unroll
                for (int n = 0; n < 2; ++n) gv[bj][n] = *(const f32x4*)(gp + bj * 128 + 4 * n) * scale;
#pragma unroll
            for (int ai = 0; ai < 2; ++ai)
#pragma unroll
                for (int mh = 0; mh < 2; ++mh) {
                    f32x4 bs[2][2][2];
#pragma unroll
                    for (int m2 = 0; m2 < 2; ++m2) {
                        const size_t off = (size_t)(row0 + ai * 128 + (mh * 2 + m2) * 16) * D_ + col0;
#pragma unroll
                        for (int bj = 0; bj < 2; ++bj)
#pragma unroll
                            for (int n = 0; n < 2; ++n) bs[m2][bj][n] = *(const f32x4*)(base + off + bj * 128 + 4 * n);
                    }
                    asm volatile("" ::: "memory");
#pragma unroll
                    for (int m2 = 0; m2 < 2; ++m2) {
                        const int m = mh * 2 + m2;
                        float sq = 0.f;
#pragma unroll
                        for (int bj = 0; bj < 2; ++bj)
#pragma unroll
                            for (int n = 0; n < 2; ++n) { const f32x4 hv = bs[m2][bj][n] + gv[bj][n] * acc[ai][bj][m][n]; acc[ai][bj][m][n] = hv; sq += (hv[0] * hv[0] + hv[1] * hv[1]) + (hv[2] * hv[2] + hv[3] * hv[3]);
                                *(f32x4*)(out + (size_t)(row0 + ai * 128 + m * 16) * D_ + col0 + bj * 128 + 4 * n) = hv; }
                        sq += __shfl_xor(sq, 16); sq += __shfl_xor(sq, 32);
                        if (fq == 0) Pst[(ai * 128 + wr * 64 + m * 16 + fr) * 4 + wc] = sq;
                    }
                    asm volatile("" ::: "memory");
                }
        }
        asm volatile("s_waitcnt lgkmcnt(0)" ::: "memory"); __builtin_amdgcn_s_barrier(); asm volatile("" ::: "memory");
        const int tid = threadIdx.x;
        if (tid < 256) { const f32x4 p4 = *(const LAS f32x4*)(Pst + tid * 4);
            __hip_atomic_store(xbuf + ((size_t)u.pm * 256 + tid) * 8 + u.pn, (p4[0] + p4[1]) + (p4[2] + p4[3]), __ATOMIC_RELAXED, __HIP_MEMORY_SCOPE_AGENT); }
        asm volatile("s_waitcnt vmcnt(0) lgkmcnt(0)" ::: "memory"); __builtin_amdgcn_s_barrier(); asm volatile("" ::: "memory");
        if (tid == 0) {
            unsigned* cw = cnt + 64 * u.pm;
            __hip_atomic_fetch_add(cw, 1u, __ATOMIC_RELAXED, __HIP_MEMORY_SCOPE_AGENT);
            unsigned sp = 0;
            while (__hip_atomic_load(cw, __ATOMIC_RELAXED, __HIP_MEMORY_SCOPE_AGENT) < 8u) { __builtin_amdgcn_s_sleep(2); if (++sp > (1u << 22)) break; }
        }
        asm volatile("s_waitcnt vmcnt(0) lgkmcnt(0)" ::: "memory"); __builtin_amdgcn_s_barrier(); asm volatile("" ::: "memory");
        if (tid < 256) {
            const float* xp = xbuf + ((size_t)u.pm * 256 + tid) * 8; float tot = 0.f;
#pragma unroll
            for (int t = 0; t < 8; ++t) tot += __hip_atomic_load(xp + t, __ATOMIC_RELAXED, __HIP_MEMORY_SCOPE_AGENT);
            S[tid] = 1.0f / sqrtf(tot * (1.0f / D_) + EPS);
        }
        asm volatile("s_waitcnt vmcnt(0) lgkmcnt(0)" ::: "memory"); __builtin_amdgcn_s_barrier(); asm volatile("" ::: "memory");
        const size_t bo = (size_t)(u.pm >> 5) * NMOD;
#pragma unroll
        for (int bj = 0; bj < 2; ++bj) {
            f32x4 ga[2], gb[2];
#pragma unroll
            for (int n = 0; n < 2; ++n) { const int cc = col0 + bj * 128 + 4 * n; ga[n] = *(const f32x4*)(gn + cc) * (*(const f32x4*)(scp + bo + cc) + 1.0f); gb[n] = *(const f32x4*)(shp + bo + cc); }
#pragma unroll
            for (int ai = 0; ai < 2; ++ai)
#pragma unroll
                for (int m = 0; m < 4; ++m) {
                    const float r = S[ai * 128 + wr * 64 + m * 16 + fr];
                    const f32x4 y0 = (acc[ai][bj][m][0] * r) * ga[0] + gb[0], y1 = (acc[ai][bj][m][1] * r) * ga[1] + gb[1];
                    u32x4 w; w.x = cvt_pk_bf16(y0[0], y0[1]); w.y = cvt_pk_bf16(y0[2], y0[3]); w.z = cvt_pk_bf16(y1[0], y1[1]); w.w = cvt_pk_bf16(y1[2], y1[3]);
                    *(u32x4*)(U + (size_t)(row0 + ai * 128 + m * 16) * D_ + col0 + bj * 128) = w;
                }
        }
        asm volatile("s_waitcnt lgkmcnt(0)" ::: "memory"); __builtin_amdgcn_s_barrier(); asm volatile("" ::: "memory");
    }
};
struct EpiProj { static constexpr bool HAS_MID = false;
    bf16_t* P; const float* rope;
    __device__ __forceinline__ void operator()(const f32x4 (&acc)[2][2][4][2], const Unit& u, int wr, int wc, int fr, int fq) const {
        const int row0 = u.pm * 256 + wr * 64 + fr, col0 = u.pn * 256 + wc * 32 + 8 * fq;
        const bool sig = u.pn >= 13;
        const bool ropelane = ((wc & 1) == 0) && (fq < 2) && (u.pn <= 4);
#pragma unroll
        for (int ai = 0; ai < 2; ++ai) {
            f32x4 csa[4], sna[4];
#pragma unroll
            for (int m = 0; m < 4; ++m) {
                csa[m] = (f32x4){1.f, 1.f, 1.f, 1.f}; sna[m] = (f32x4){0.f, 0.f, 0.f, 0.f};
                if (ropelane) { const float* rp = rope + (size_t)(row0 + ai * 128 + m * 16) * 16 + fq * 4; csa[m] = *(const f32x4*)rp; sna[m] = *(const f32x4*)(rp + 8); }
            }
            asm volatile("" ::: "memory");
#pragma unroll
            for (int m = 0; m < 4; ++m) {
                const int row = row0 + ai * 128 + m * 16;
                const f32x4 cs = csa[m], sn = sna[m];
#pragma unroll
                for (int bj = 0; bj < 2; ++bj) {
                    f32x4 v0 = acc[ai][bj][m][0], v1 = acc[ai][bj][m][1];
                    if (ropelane && (u.pn < 4 || bj == 0)) { const f32x4 x1 = v0, x2 = v1; v0 = x1 * cs - x2 * sn; v1 = x2 * cs + x1 * sn; }
                    if (sig) {
#pragma unroll
                        for (int e = 0; e < 4; ++e) { v0[e] = sigm(v0[e]); v1[e] = sigm(v1[e]); }
                    }
                    u32x4 w; w.x = cvt_pk_bf16(v0[0], v0[1]); w.y = cvt_pk_bf16(v0[2], v0[3]); w.z = cvt_pk_bf16(v1[0], v1[1]); w.w = cvt_pk_bf16(v1[2], v1[3]);
                    *(u32x4*)(P + (size_t)row * PP + col0 + bj * 128) = w;
                }
            }
        }
    }
};
struct EpiMerge {
    static constexpr bool HAS_MID = true;
    bf16_t* P;
    __device__ __forceinline__ void mid(f32x4 (&acc)[2][2][4][2], const Unit& u, int wr, int wc, int fr, int fq) const {
        int row0 = u.pm * 256 + wr * 64 + fr, col0 = u.pn * 256 + wc * 32 + 8 * fq;
        asm volatile("" : "+v"(row0), "+v"(col0));
#pragma unroll
        for (int ai = 0; ai < 2; ++ai)
#pragma unroll
            for (int mh = 0; mh < 2; ++mh) {
                u32x4 ga[2][2], gm[2][2];
#pragma unroll
                for (int m2 = 0; m2 < 2; ++m2)
#pragma unroll
                    for (int bj = 0; bj < 2; ++bj) {
                        const bf16_t* gp = P + (size_t)(row0 + ai * 128 + (mh * 2 + m2) * 16) * PP + PC_G + col0 + bj * 128;
                        ga[m2][bj] = *(const u32x4*)gp; gm[m2][bj] = *(const u32x4*)(gp + 2048);
                    }
                asm volatile("" ::: "memory");
#pragma unroll
                for (int m2 = 0; m2 < 2; ++m2)
#pragma unroll
                    for (int bj = 0; bj < 2; ++bj) {
                        const int m = mh * 2 + m2;
                        const u32x4 a = ga[m2][bj], g = gm[m2][bj];
                        f32x4 r0, r1;
                        r0[0] = bflo(a.x) * __builtin_amdgcn_rcpf(bflo(g.x)); r0[1] = bfhi(a.x) * __builtin_amdgcn_rcpf(bfhi(g.x)); r0[2] = bflo(a.y) * __builtin_amdgcn_rcpf(bflo(g.y)); r0[3] = bfhi(a.y) * __builtin_amdgcn_rcpf(bfhi(g.y));
                        r1[0] = bflo(a.z) * __builtin_amdgcn_rcpf(bflo(g.z)); r1[1] = bfhi(a.z) * __builtin_amdgcn_rcpf(bfhi(g.z)); r1[2] = bflo(a.w) * __builtin_amdgcn_rcpf(bflo(g.w)); r1[3] = bfhi(a.w) * __builtin_amdgcn_rcpf(bfhi(g.w));
                        acc[ai][bj][m][0] *= r0; acc[ai][bj][m][1] *= r1;
                    }
                asm volatile("" ::: "memory");
            }
    }
    __device__ __forceinline__ void operator()(const f32x4 (&acc)[2][2][4][2], const Unit& u, int wr, int wc, int fr, int fq) const {
        const int row0 = u.pm * 256 + wr * 64 + fr, col0 = u.pn * 256 + wc * 32 + 8 * fq;
#pragma unroll
        for (int ai = 0; ai < 2; ++ai) {
            u32x4 gm[4][2];
#pragma unroll
            for (int m = 0; m < 4; ++m)
#pragma unroll
                for (int bj = 0; bj < 2; ++bj) gm[m][bj] = *(const u32x4*)(P + (size_t)(row0 + ai * 128 + m * 16) * PP + PC_G + 2048 + col0 + bj * 128);
            asm volatile("" ::: "memory");
#pragma unroll
            for (int m = 0; m < 4; ++m)
#pragma unroll
                for (int bj = 0; bj < 2; ++bj) {
                    bf16_t* zp = P + (size_t)(row0 + ai * 128 + m * 16) * PP + PC_G + col0 + bj * 128;
                    const u32x4 g = gm[m][bj];
                    const f32x4 a0 = acc[ai][bj][m][0], a1 = acc[ai][bj][m][1];
                    u32x4 w; w.x = cvt_pk_bf16(bflo(g.x) * a0[0], bfhi(g.x) * a0[1]); w.y = cvt_pk_bf16(bflo(g.y) * a0[2], bfhi(g.y) * a0[3]);
                    w.z = cvt_pk_bf16(bflo(g.z) * a1[0], bfhi(g.z) * a1[1]); w.w = cvt_pk_bf16(bflo(g.w) * a1[2], bfhi(g.w) * a1[3]);
                    *(u32x4*)zp = w;
                }
            asm volatile("" ::: "memory");
        }
    }
};

struct Args {
    const float* x; const float* c; const int* pos; const float* w_ada; const float* b_ada; const float* norm1_g;
    const float* f1_in; const float* f1_out; const float* norm2_g; const float* w_in; const float* conv_w; const float* conv_b;
    const float* b_ig; const float* b_fg; const float* sinks; const float* mnorm_g; const float* w_att; const float* w_ml;
    const float* w_out; const float* norm3_g; const float* f2_in; const float* f2_out; const float* final_g;
    float* out; unsigned char* ws; int ph_lo, ph_hi;
};

template <int KIND> __device__ __forceinline__ int srccol(int n) {
    if (KIND == 0) return n;
    if (KIND == 1) { const int pn = n >> 8, bj = (n >> 7) & 1, i = n & 127; return bj * DFF + pn * 128 + i; }
    if (n < PC_V) { const int d = n & 63; if (d < 16) { const int g = d >> 2; const int dd = (g == 1) ? d + 4 : (g == 2) ? d - 4 : d; return (n & ~63) + dd; } return n; }
    if (n < PC_MO) return n;
    return n + 8;
}
template <int KIND> __device__ __forceinline__ void transpose_item(const float* W, int K, int N, bf16_t* WT, int ldw, LAS float* scr, int item, int lane, int nblk) {
    const int kb = item / nblk, nb = item % nblk, k0 = 64 * kb, n0 = 32 * nb;
    const int sc = srccol<KIND>(n0 + (lane & 31));
#pragma unroll 8
    for (int i = 0; i < 32; ++i) { const int kk = 2 * i + (lane >> 5); scr[kk * 33 + (lane & 31)] = W[(size_t)(k0 + kk) * N + sc]; }
    asm volatile("s_waitcnt lgkmcnt(0)" ::: "memory");
    const int c = lane & 7;
#pragma unroll
    for (int j = 0; j < 4; ++j) { const int n = (lane >> 3) + 8 * j; const LAS float* s = scr + (8 * c) * 33 + n;
        u32x4 o; o.x = cvt_pk_bf16(s[0 * 33], s[1 * 33]); o.y = cvt_pk_bf16(s[2 * 33], s[3 * 33]); o.z = cvt_pk_bf16(s[4 * 33], s[5 * 33]); o.w = cvt_pk_bf16(s[6 * 33], s[7 * 33]);
        *(u32x4*)(WT + (size_t)(n0 + n) * ldw + k0 + 8 * c) = o; }
    asm volatile("s_waitcnt lgkmcnt(0)" ::: "memory");
}
template <int KIND> __device__ __forceinline__ void transpose_all(const float* W, int K, int N, int Nout, bf16_t* WT, int ldw, LAS float* scr, int gw, int ngw, int lane) {
    const int nblk = Nout / 32, items = (K / 64) * nblk;
    for (int it = gw; it < items; it += ngw) transpose_item<KIND>(W, K, N, WT, ldw, scr, it, lane, nblk);
}

template <bool GATES> __device__ __forceinline__ void norm_phase(const float* hin, const float* g, const float* mod, int sh_off, int sc_off, bf16_t* uout,
                                                                 float* gif, const float* w_in, LAS unsigned char* lds, int tid, int wave, int lane) {
    LAS float* wgT = (LAS float*)lds;
    if (GATES) {
        for (int idx = tid; idx < 2048 * 8; idx += 512) { const int k = idx >> 3, j = idx & 7; wgT[j * 2048 + k] = w_in[(size_t)k * PROJ_OUT + 3328 + j]; }
        __syncthreads();
    }
    const int gw = blockIdx.x * 8 + wave, ngw = gridDim.x * 8;
    for (int rowa = gw; rowa < M_; rowa += 2 * ngw) {
        f32x4 v[2][8]; float rs[2];
#pragma unroll
        for (int q = 0; q < 2; ++q) {
            const int row = min(rowa + q * ngw, M_ - 1);
            const f32x4* xr = (const f32x4*)(hin + (size_t)row * D_) + lane;
#pragma unroll
            for (int j = 0; j < 8; ++j) v[q][j] = xr[64 * j];
        }
#pragma unroll
        for (int q = 0; q < 2; ++q) {
            float ss = 0.f;
#pragma unroll
            for (int j = 0; j < 8; ++j) ss += (v[q][j][0] * v[q][j][0] + v[q][j][1] * v[q][j][1]) + (v[q][j][2] * v[q][j][2] + v[q][j][3] * v[q][j][3]);
            rs[q] = 1.0f / sqrtf(wave_sum(ss) * (1.0f / D_) + EPS);
        }
#pragma unroll
        for (int q = 0; q < 2; ++q) {
            const int row = rowa + q * ngw;
            if (row < M_) {
                const int b = row >> 13;
                const float rstd = rs[q];
                float ga[8];
#pragma unroll
                for (int i = 0; i < 8; ++i) ga[i] = 0.f;
#pragma unroll
                for (int j = 0; j < 8; ++j) {
                    const int col = 256 * j + 4 * lane;
                    const f32x4 g4 = *(const f32x4*)(g + col), sc4 = *(const f32x4*)(mod + (size_t)b * NMOD + sc_off + col), sh4 = *(const f32x4*)(mod + (size_t)b * NMOD + sh_off + col);
                    const f32x4 y = (v[q][j] * rstd) * g4 * (sc4 + 1.0f) + sh4;
                    u32x2 w; w.x = cvt_pk_bf16(y[0], y[1]); w.y = cvt_pk_bf16(y[2], y[3]);
                    *(u32x2*)(uout + (size_t)row * D_ + col) = w;
                    if (GATES) {
#pragma unroll
                        for (int i = 0; i < 8; ++i) { const f32x4 w4 = *(const LAS f32x4*)(wgT + i * 2048 + col); ga[i] += (y[0] * w4[0] + y[1] * w4[1]) + (y[2] * w4[2] + y[3] * w4[3]); }
                    }
                }
                if (GATES) {
#pragma unroll
                    for (int i = 0; i < 8; ++i) ga[i] = wave_sum(ga[i]);
                    if (lane == 0) { *(f32x4*)(gif + (size_t)row * 8) = (f32x4){ga[0], ga[1], ga[2], ga[3]}; *(f32x4*)(gif + (size_t)row * 8 + 4) = (f32x4){ga[4], ga[5], ga[6], ga[7]}; }
                }
            }
        }
    }
    if (GATES) __syncthreads();
}

__device__ __forceinline__ void attn_item(int item, bf16_t* P, const float* sinks, LAS unsigned char* lds, int tid, int wave, int lane) {
    const int kvh = item & 1, nb = (item >> 1) & 63, b = item >> 7;
    const int r0 = b * T_ + nb * 128;
    LAS bf16_t* Ksh = (LAS bf16_t*)lds;
    LAS bf16_t* VT = (LAS bf16_t*)(lds + 36864);
    {
        u32x4 kva[4], vva[4];
#pragma unroll
        for (int i = 0; i < 4; ++i) {
            const int chunk = tid + 512 * i, key = chunk >> 3, c8 = chunk & 7;
            const bool valid = (nb > 0) || (key >= 128);
            kva[i] = (u32x4){0u, 0u, 0u, 0u}; vva[i] = (u32x4){0u, 0u, 0u, 0u};
            if (valid) { const bf16_t* rp = P + (size_t)(r0 - 128 + key) * PP; kva[i] = *(const u32x4*)(rp + PC_K + kvh * 64 + c8 * 8); vva[i] = *(const u32x4*)(rp + PC_V + kvh * 64 + c8 * 8); }
        }
        asm volatile("" ::: "memory");
#pragma unroll
        for (int i = 0; i < 4; ++i) {
            const int chunk = tid + 512 * i, key = chunk >> 3, c8 = chunk & 7;
            const u32x4 kv = kva[i], vv = vva[i];
            *(LAS u32x4*)(Ksh + key * 72 + c8 * 8) = kv;
            const int pos = (key & ~31) + kperm32(key & 31);
            LAS bf16_t* vp = VT + (c8 * 8) * 264 + pos;
            vp[0 * 264] = (bf16_t)(vv.x & 0xffff); vp[1 * 264] = (bf16_t)(vv.x >> 16); vp[2 * 264] = (bf16_t)(vv.y & 0xffff); vp[3 * 264] = (bf16_t)(vv.y >> 16);
            vp[4 * 264] = (bf16_t)(vv.z & 0xffff); vp[5 * 264] = (bf16_t)(vv.z >> 16); vp[6 * 264] = (bf16_t)(vv.w & 0xffff); vp[7 * 264] = (bf16_t)(vv.w >> 16);
        }
    }
    const int h = kvh * 8 + wave, fr = lane & 15, fq = lane >> 4;
    const float sink = sinks[h];
    bf16x8 nq0, nq1;
    { const bf16_t* qp0 = P + (size_t)(r0 + fr) * PP + h * 64 + 8 * fq; nq0 = *(const bf16x8*)qp0; nq1 = *(const bf16x8*)(qp0 + 32); }
    __syncthreads();
    for (int qg = 0; qg < 8; ++qg) {
        const int qrow = r0 + qg * 16 + fr;
        bf16_t* qp = P + (size_t)qrow * PP + h * 64;
        const bf16x8 bq0 = nq0, bq1 = nq1;
        { const bf16_t* qpn = qp + (size_t)(qg < 7 ? 16 : 0) * PP + 8 * fq; nq0 = *(const bf16x8*)qpn; nq1 = *(const bf16x8*)(qpn + 32); }
        const int t0e = qg & ~1;
        f32x4 s[10];
#pragma unroll
        for (int tt = 0; tt < 10; ++tt) {
            const int t = min(t0e + tt, 15);
            const LAS bf16_t* kp = Ksh + (t * 16 + fr) * 72 + 8 * fq;
            const bf16x8 a0 = *(const LAS bf16x8*)kp, a1 = *(const LAS bf16x8*)(kp + 32);
            f32x4 z = {0.f, 0.f, 0.f, 0.f};
            z = __builtin_amdgcn_mfma_f32_16x16x32_bf16(a0, bq0, z, 0, 0, 0);
            s[tt] = __builtin_amdgcn_mfma_f32_16x16x32_bf16(a1, bq1, z, 0, 0, 0);
        }
        const int qi = 128 + qg * 16 + fr;
        float mx = -1e30f;
#pragma unroll
        for (int tt = 0; tt < 10; ++tt)
#pragma unroll
            for (int r = 0; r < 4; ++r) {
                const int kj = (t0e + tt) * 16 + 4 * fq + r;
                const bool ok = (kj <= qi) && (kj > qi - 128) && ((nb > 0) || (kj >= 128));
                const float sv = ok ? s[tt][r] * 0.125f : -1e30f;
                s[tt][r] = sv; mx = fmaxf(mx, sv);
            }
        mx = fmaxf(mx, __shfl_xor(mx, 16)); mx = fmaxf(mx, __shfl_xor(mx, 32)); mx = fmaxf(mx, sink);
        float sum = 0.f;
#pragma unroll
        for (int tt = 0; tt < 10; ++tt)
#pragma unroll
            for (int r = 0; r < 4; ++r) { const float p = __expf(s[tt][r] - mx); s[tt][r] = p; sum += p; }
        sum += __shfl_xor(sum, 16); sum += __shfl_xor(sum, 32);
        const float inv = 1.0f / (sum + __expf(sink - mx));
        bf16x8 bp[5];
#pragma unroll
        for (int g = 0; g < 5; ++g) bp[g] = pack8(s[2 * g], s[2 * g + 1]);
#pragma unroll
        for (int dt = 0; dt < 4; ++dt) {
            f32x4 o = {0.f, 0.f, 0.f, 0.f};
#pragma unroll
            for (int g = 0; g < 5; ++g) {
                const int grp = min((t0e >> 1) + g, 7);
                const bf16x8 a = *(const LAS bf16x8*)(VT + (dt * 16 + fr) * 264 + grp * 32 + 8 * fq);
                o = __builtin_amdgcn_mfma_f32_16x16x32_bf16(a, bp[g], o, 0, 0, 0);
            }
            u32x2 w; w.x = cvt_pk_bf16(o[0] * inv, o[1] * inv); w.y = cvt_pk_bf16(o[2] * inv, o[3] * inv);
            *(u32x2*)(qp + dt * 16 + 4 * fq) = w;
        }
    }
    __syncthreads();
}

__device__ __forceinline__ void m1_pair(int pr, const bf16_t* P, bf16_t* QK, const float* gif, const float* conv_w, const float* conv_b, const float* b_ig, const float* b_fg,
                                        float* Cbuf, float* scal, LAS unsigned char* lds, int tid, int wave, int lane) {
    const int half = wave >> 2, w4 = wave & 3, item = 2 * pr + half, htid = tid & 255;
    const int c = item & 127, h = (item >> 7) & 3, b = item >> 9;
    const int r0 = b * T_ + c * 64;
    LAS bf16_t* VT = (LAS bf16_t*)(lds + half * 58368);
    LAS bf16_t* KT = (LAS bf16_t*)(lds + half * 58368 + 39168);
    LAS float* wl = (LAS float*)(lds + half * 58368 + 57600);
    if (w4 == 0) {
        const int row = r0 + lane;
        const float fpre = gif[(size_t)row * 8 + 4 + h] + b_fg[h], ipre = gif[(size_t)row * 8 + h] + b_ig[h];
        float bc = log_sigmoid(fpre);
#pragma unroll
        for (int o = 1; o < 64; o <<= 1) { const float t = __shfl_up(bc, o); if (lane >= o) bc += t; }
        const float blast = __shfl(bc, 63);
        const float gg = blast - bc + ipre;
        const float gmax = wave_max(gg);
        wl[lane] = expf(gg - gmax);
        if (lane == 0) { scal[item * 4 + 0] = gmax; scal[item * 4 + 1] = blast; }
    }
    for (int idx = htid; idx < 16 * 72; idx += 256) VT[256 * 72 + idx] = (idx < 64) ? (bf16_t)0x3F80 : (bf16_t)0;
    const int ch8 = htid & 31, tg = htid >> 5, qk = ch8 >> 4, j0 = (ch8 & 15) * 8;
    const int chan = qk * 512 + h * 128 + j0;
    float y[8][8];
    {
        u32x4 xr[11];
#pragma unroll
        for (int i = 0; i < 11; ++i) {
            const int ts = c * 64 + tg * 8 - 3 + i;
            xr[i] = (u32x4){0u, 0u, 0u, 0u};
            if (ts >= 0) xr[i] = *(const u32x4*)(P + (size_t)(b * T_ + ts) * PP + PC_MQK + chan);
        }
        f32x4 wv[4][2];
#pragma unroll
        for (int kk = 0; kk < 4; ++kk) { wv[kk][0] = *(const f32x4*)(conv_w + kk * 1024 + chan); wv[kk][1] = *(const f32x4*)(conv_w + kk * 1024 + chan + 4); }
        const f32x4 cb0 = *(const f32x4*)(conv_b + chan), cb1 = *(const f32x4*)(conv_b + chan + 4);
        const float ksc = qk ? 0.08838834764831845f : 1.0f;
#pragma unroll
        for (int j = 0; j < 8; ++j) {
            float a[8] = {cb0[0], cb0[1], cb0[2], cb0[3], cb1[0], cb1[1], cb1[2], cb1[3]};
#pragma unroll
            for (int kk = 0; kk < 4; ++kk) {
                const u32x4 x8 = xr[j + kk];
                a[0] += wv[kk][0][0] * bflo(x8.x); a[1] += wv[kk][0][1] * bfhi(x8.x); a[2] += wv[kk][0][2] * bflo(x8.y); a[3] += wv[kk][0][3] * bfhi(x8.y);
                a[4] += wv[kk][1][0] * bflo(x8.z); a[5] += wv[kk][1][1] * bfhi(x8.z); a[6] += wv[kk][1][2] * bflo(x8.w); a[7] += wv[kk][1][3] * bfhi(x8.w);
            }
#pragma unroll
            for (int e = 0; e < 8; ++e) y[j][e] = a[e] * sigm(a[e]) * ksc;
            u32x4 w; w.x = cvt_pk_bf16(y[j][0], y[j][1]); w.y = cvt_pk_bf16(y[j][2], y[j][3]); w.z = cvt_pk_bf16(y[j][4], y[j][5]); w.w = cvt_pk_bf16(y[j][6], y[j][7]);
            *(u32x4*)(QK + (size_t)(r0 + tg * 8 + j) * 1024 + chan) = w;
        }
    }
    {
        u32x4 vva[8];
#pragma unroll
        for (int i = 0; i < 8; ++i) { const int task = htid + 256 * i, tl = task & 63, ce = task >> 6; vva[i] = *(const u32x4*)(P + (size_t)(r0 + tl) * PP + PC_MV + h * 256 + ce * 8); }
        asm volatile("" ::: "memory");
#pragma unroll
        for (int i = 0; i < 8; ++i) {
            const int task = htid + 256 * i, tl = task & 63, ce = task >> 6;
            const u32x4 vv = vva[i];
            LAS bf16_t* vp = VT + (ce * 8) * 72 + tl;
            vp[0 * 72] = (bf16_t)(vv.x & 0xffff); vp[1 * 72] = (bf16_t)(vv.x >> 16); vp[2 * 72] = (bf16_t)(vv.y & 0xffff); vp[3 * 72] = (bf16_t)(vv.y >> 16);
            vp[4 * 72] = (bf16_t)(vv.z & 0xffff); vp[5 * 72] = (bf16_t)(vv.z >> 16); vp[6 * 72] = (bf16_t)(vv.w & 0xffff); vp[7 * 72] = (bf16_t)(vv.w >> 16);
        }
    }
    __syncthreads();
    if (qk) {
#pragma unroll
        for (int j = 0; j < 8; ++j) {
            const int tl = tg * 8 + j; const float wt = wl[tl];
#pragma unroll
            for (int e = 0; e < 8; ++e) KT[(j0 + e) * 72 + tl] = f2bf(y[j][e] * wt);
        }
    }
    __syncthreads();
    const int fr = lane & 15, fq = lane >> 4;
    float* Cit = Cbuf + (size_t)item * 257 * 128;
#pragma unroll
    for (int et4 = 0; et4 < 4; ++et4) {
        const int et = 4 * w4 + et4;
        const bf16x8 v0 = *(const LAS bf16x8*)(VT + (et * 16 + fr) * 72 + 8 * fq), v1 = *(const LAS bf16x8*)(VT + (et * 16 + fr) * 72 + 32 + 8 * fq);
#pragma unroll
        for (int dt = 0; dt < 8; ++dt) {
            const bf16x8 k0 = *(const LAS bf16x8*)(KT + (dt * 16 + fr) * 72 + 8 * fq), k1 = *(const LAS bf16x8*)(KT + (dt * 16 + fr) * 72 + 32 + 8 * fq);
            f32x4 z = {0.f, 0.f, 0.f, 0.f};
            z = __builtin_amdgcn_mfma_f32_16x16x32_bf16(k0, v0, z, 0, 0, 0);
            z = __builtin_amdgcn_mfma_f32_16x16x32_bf16(k1, v1, z, 0, 0, 0);
            *(f32x4*)(Cit + (size_t)(et * 16 + fr) * 128 + dt * 16 + 4 * fq) = z;
        }
    }
    if (w4 == 0) {
        const bf16x8 v0 = *(const LAS bf16x8*)(VT + (256 + fr) * 72 + 8 * fq), v1 = *(const LAS bf16x8*)(VT + (256 + fr) * 72 + 32 + 8 * fq);
#pragma unroll
        for (int dt = 0; dt < 8; ++dt) {
            const bf16x8 k0 = *(const LAS bf16x8*)(KT + (dt * 16 + fr) * 72 + 8 * fq), k1 = *(const LAS bf16x8*)(KT + (dt * 16 + fr) * 72 + 32 + 8 * fq);
            f32x4 z = {0.f, 0.f, 0.f, 0.f};
            z = __builtin_amdgcn_mfma_f32_16x16x32_bf16(k0, v0, z, 0, 0, 0);
            z = __builtin_amdgcn_mfma_f32_16x16x32_bf16(k1, v1, z, 0, 0, 0);
            if (fr == 0) *(f32x4*)(Cit + (size_t)256 * 128 + dt * 16 + 4 * fq) = z;
        }
    }
    __syncthreads();
}

__device__ __forceinline__ void m2_scan(const float* Cbuf, bf16_t* Cin, float* scal, int gtid, int gthreads) {
    constexpr int PER_BH = 256 * 64, TOTAL = 8 * PER_BH;
    constexpr size_t CSTRIDE = (size_t)257 * 128;
    for (int w = gtid; w < TOTAL; w += gthreads) {
        const int bh = w / PER_BH, rem = w % PER_BH, e = rem >> 6, d2 = (rem & 63) * 2;
        const size_t off = ((size_t)bh * 128 * 257 + e) * 128 + d2;
        const float* ptr = Cbuf + off; bf16_t* optr = Cin + off;
        const bool lead = (rem == 0), has_n = (e == 0);
        const size_t noff = (size_t)256 * 128;
        f32x2 C = {0.f, 0.f}, Nn = {0.f, 0.f}; float m = -1e30f;
        for (int c0 = 0; c0 < 128; c0 += 8) {
            f32x2 cl[8], nl[8]; float gm[8], bl[8];
#pragma unroll
            for (int u = 0; u < 8; ++u) { cl[u] = *(const f32x2*)(ptr + (size_t)(c0 + u) * CSTRIDE); gm[u] = scal[(bh * 128 + c0 + u) * 4]; bl[u] = scal[(bh * 128 + c0 + u) * 4 + 1]; nl[u] = (f32x2){0.f, 0.f}; }
            if (has_n) {
#pragma unroll
                for (int u = 0; u < 8; ++u) nl[u] = *(const f32x2*)(ptr + noff + (size_t)(c0 + u) * CSTRIDE);
            }
#pragma unroll
            for (int u = 0; u < 8; ++u) {
                *(unsigned*)(optr + (size_t)(c0 + u) * CSTRIDE) = cvt_pk_bf16(C[0], C[1]);
                if (has_n) *(unsigned*)(optr + noff + (size_t)(c0 + u) * CSTRIDE) = cvt_pk_bf16(Nn[0], Nn[1]);
                if (lead) scal[(bh * 128 + c0 + u) * 4 + 2] = m;
                const float mn = fmaxf(bl[u] + m, gm[u]);
                const float a = expf(bl[u] + m - mn), sc = expf(gm[u] - mn);
                C = C * a + cl[u] * sc; Nn = Nn * a + nl[u] * sc; m = mn;
            }
        }
    }
}

__device__ __forceinline__ void m3_pair(int pr, bf16_t* P, const bf16_t* QK, const float* gif, const float* b_ig, const float* b_fg, const bf16_t* Cbuf, const float* scal,
                                        const float* norm_g, LAS unsigned char* lds, int tid, int wave, int lane) {
    const int half = wave >> 2, tt = wave & 3, item = 2 * pr + half;
    const int c = item & 127, h = (item >> 7) & 3, b = item >> 9;
    const int r0 = b * T_ + c * 64;
    LAS bf16_t* VT = (LAS bf16_t*)(lds + half * 40960);
    LAS float* tb = (LAS float*)(lds + half * 40960 + 36864);
    if (tt == 0) {
        const int row = r0 + lane;
        const float fpre = gif[(size_t)row * 8 + 4 + h] + b_fg[h], ipre = gif[(size_t)row * 8 + h] + b_ig[h];
        float bc = log_sigmoid(fpre);
#pragma unroll
        for (int o = 1; o < 64; o <<= 1) { const float t = __shfl_up(bc, o); if (lane >= o) bc += t; }
        const float gs = ipre - bc;
        float mxs = gs;
#pragma unroll
        for (int o = 1; o < 64; o <<= 1) { const float t = __shfl_up(mxs, o); if (lane >= o) mxs = fmaxf(mxs, t); }
        const float m_in = scal[item * 4 + 2];
        const float alog = bc + m_in;
        const float mt = fmaxf(alog, bc + mxs);
        tb[lane] = bc; tb[64 + lane] = gs; tb[128 + lane] = mt; tb[192 + lane] = expf(alog - mt);
    }
    const int htid = tid & 255;
    {
        u32x4 vva[8];
#pragma unroll
        for (int i = 0; i < 8; ++i) { const int task = htid + 256 * i, tl = task & 63, ce = task >> 6; vva[i] = *(const u32x4*)(P + (size_t)(r0 + tl) * PP + PC_MV + h * 256 + ce * 8); }
        asm volatile("" ::: "memory");
#pragma unroll
        for (int i = 0; i < 8; ++i) {
            const int task = htid + 256 * i, tl = task & 63, ce = task >> 6;
            const u32x4 vv = vva[i];
            const int pos = (tl & 32) + kperm32(tl & 31);
            LAS bf16_t* vp = VT + (ce * 8) * 72 + pos;
            vp[0 * 72] = (bf16_t)(vv.x & 0xffff); vp[1 * 72] = (bf16_t)(vv.x >> 16); vp[2 * 72] = (bf16_t)(vv.y & 0xffff); vp[3 * 72] = (bf16_t)(vv.y >> 16);
            vp[4 * 72] = (bf16_t)(vv.z & 0xffff); vp[5 * 72] = (bf16_t)(vv.z >> 16); vp[6 * 72] = (bf16_t)(vv.w & 0xffff); vp[7 * 72] = (bf16_t)(vv.w >> 16);
        }
    }
    const int fr = lane & 15, fq = lane >> 4;
    const int t = tt * 16 + fr;
    const bf16_t* qp = QK + (size_t)(r0 + t) * 1024 + h * 128 + 8 * fq;
    bf16x8 bq[4];
#pragma unroll
    for (int ks = 0; ks < 4; ++ks) bq[ks] = *(const bf16x8*)(qp + ks * 32);
    const bf16_t* Cin = Cbuf + (size_t)item * 257 * 128;
    bf16x8 kfr[4][4], nfr[4];
#pragma unroll
    for (int st = 0; st < 4; ++st)
#pragma unroll
        for (int ks = 0; ks < 4; ++ks) kfr[st][ks] = *(const bf16x8*)(QK + (size_t)(r0 + st * 16 + fr) * 1024 + 512 + h * 128 + 8 * fq + ks * 32);
#pragma unroll
    for (int ks = 0; ks < 4; ++ks) nfr[ks] = *(const bf16x8*)(Cin + (size_t)256 * 128 + 8 * fq + ks * 32);
    bf16_t* prow = P + (size_t)(r0 + t) * PP;
    u32x2 moa[16];
#pragma unroll
    for (int et = 0; et < 16; ++et) moa[et] = *(const u32x2*)(prow + PC_MO + h * 256 + et * 16 + 4 * fq);
    __syncthreads();
    f32x4 sacc[4];
#pragma unroll
    for (int st = 0; st < 4; ++st) {
        f32x4 z = {0.f, 0.f, 0.f, 0.f};
#pragma unroll
        for (int ks = 0; ks < 4; ++ks) z = __builtin_amdgcn_mfma_f32_16x16x32_bf16(kfr[st][ks], bq[ks], z, 0, 0, 0);
        sacc[st] = z;
    }
    const float bc_t = tb[t], mt_t = tb[128 + t], inter_t = tb[192 + t];
    float dsum = 0.f;
#pragma unroll
    for (int st = 0; st < 4; ++st)
#pragma unroll
        for (int r = 0; r < 4; ++r) {
            const int sidx = st * 16 + 4 * fq + r;
            const float wgt = (sidx <= t) ? __expf(bc_t + tb[64 + sidx] - mt_t) : 0.f;
            const float qk = sacc[st][r] * wgt; sacc[st][r] = qk; dsum += qk;
        }
    dsum += __shfl_xor(dsum, 16); dsum += __shfl_xor(dsum, 32);
    bf16x8 bp[2];
    bp[0] = pack8(sacc[0], sacc[1]); bp[1] = pack8(sacc[2], sacc[3]);
    float qn;
    {
        f32x4 z = {0.f, 0.f, 0.f, 0.f};
#pragma unroll
        for (int ks = 0; ks < 4; ++ks) z = __builtin_amdgcn_mfma_f32_16x16x32_bf16(nfr[ks], bq[ks], z, 0, 0, 0);
        qn = z[0];
    }
    const float den = inter_t * qn + dsum;
    const float inv = 1.0f / fmaxf(fabsf(den), expf(-mt_t));
    f32x4 acc[16];
    float ss = 0.f;
#pragma unroll
    for (int eb = 0; eb < 4; ++eb) {
        bf16x8 cf[4][4];
#pragma unroll
        for (int i = 0; i < 4; ++i)
#pragma unroll
            for (int ks = 0; ks < 4; ++ks) cf[i][ks] = *(const bf16x8*)(Cin + (size_t)((eb * 4 + i) * 16 + fr) * 128 + 8 * fq + ks * 32);
        asm volatile("" ::: "memory");
#pragma unroll
        for (int i = 0; i < 4; ++i) {
            const int et = eb * 4 + i;
            f32x4 z = {0.f, 0.f, 0.f, 0.f};
#pragma unroll
            for (int ks = 0; ks < 4; ++ks) z = __builtin_amdgcn_mfma_f32_16x16x32_bf16(cf[i][ks], bq[ks], z, 0, 0, 0);
            z = z * inter_t;
#pragma unroll
            for (int g = 0; g < 2; ++g) z = __builtin_amdgcn_mfma_f32_16x16x32_bf16(*(const LAS bf16x8*)(VT + (et * 16 + fr) * 72 + g * 32 + 8 * fq), bp[g], z, 0, 0, 0);
            z = z * inv;
            ss += (z[0] * z[0] + z[1] * z[1]) + (z[2] * z[2] + z[3] * z[3]);
            acc[et] = z;
        }
    }
    ss += __shfl_xor(ss, 16); ss += __shfl_xor(ss, 32);
    const float rstd = 1.0f / sqrtf(ss * (1.0f / 256.0f) + EPS);
#pragma unroll
    for (int et = 0; et < 16; ++et) {
        const int e0 = h * 256 + et * 16 + 4 * fq;
        const f32x4 gn = *(const f32x4*)(norm_g + e0);
        const u32x2 mo = moa[et];
        const f32x4 o = acc[et] * rstd * gn;
        u32x2 w; w.x = cvt_pk_bf16(o[0] * bflo(mo.x), o[1] * bfhi(mo.x)); w.y = cvt_pk_bf16(o[2] * bflo(mo.y), o[3] * bfhi(mo.y));
        *(u32x2*)(prow + PC_MV + e0) = w;
    }
    __syncthreads();
}

#define XB_TMO      128
#define XB_XCNT(j)  (256  + 64 * (j))
#define XB_XSUB(j)  (1280 + 64 * (j))
#define XB_XGEN(j)  (2304 + 64 * (j))
#define XB_TOP      3328
#define XB_TOPGEN   3392
#define XCD_BAR_WORDS 3456
#define XB_SPIN_CAP (1u << 20)
__device__ __forceinline__ unsigned xb_ld(unsigned* p)              { return __hip_atomic_load(p, __ATOMIC_RELAXED, __HIP_MEMORY_SCOPE_AGENT); }
__device__ __forceinline__ unsigned xb_add(unsigned* p, unsigned v) { return __hip_atomic_fetch_add(p, v, __ATOMIC_RELAXED, __HIP_MEMORY_SCOPE_AGENT); }
__device__ __forceinline__ unsigned xb_xcc_id() { return (unsigned)__builtin_amdgcn_s_getreg((3 << 11) | 20) & 0xFu; }
#define XB_SPIN(cond, bar) do { unsigned _sp = 0; while (cond) { __builtin_amdgcn_s_sleep(1); \
    if ((++_sp & 255u) == 0u) { if (xb_ld(&(bar)[XB_TMO])) break; if (_sp > XB_SPIN_CAP) { atomicAdd(&(bar)[XB_TMO], 1u); break; } } } } while (0)
struct XcdBarrier { unsigned* bar; unsigned x; volatile LAS unsigned* st; };
__device__ __forceinline__ XcdBarrier xcd_barrier_post(unsigned* bar, volatile LAS unsigned* st) {
    XcdBarrier b; b.bar = bar; b.x = xb_xcc_id(); b.st = st;
    if (threadIdx.x == 0) (void)xb_add(&bar[XB_XCNT(b.x)], 1u);
    return b;
}
__device__ __forceinline__ void xcd_barrier_complete(unsigned* bar, unsigned x, unsigned& nloc, unsigned& nx) {
    const unsigned G = gridDim.x * gridDim.y * gridDim.z;
    unsigned sum, cnt, mine, sp = 0u;
    for (;;) {
        sum = 0u; cnt = 0u; mine = 0u;
#pragma unroll
        for (unsigned j = 0; j < 16; ++j) { const unsigned c = xb_ld(&bar[XB_XCNT(j)]); sum += c; cnt += (c > 0u) ? 1u : 0u; mine = (j == x) ? c : mine; }
        if (sum == G) break;
        __builtin_amdgcn_s_sleep(1);
        if ((++sp & 255u) == 0u) { if (xb_ld(&bar[XB_TMO])) break; if (sp > XB_SPIN_CAP) { atomicAdd(&bar[XB_TMO], 1u); break; } }
    }
    nloc = mine > 0u ? mine : 1u; nx = cnt > 0u ? cnt : 1u;
}
__device__ __forceinline__ void xcd_barrier(const XcdBarrier& b) {
    asm volatile("s_waitcnt vmcnt(0)" ::: "memory");
    __syncthreads();
    if (threadIdx.x == 0) {
        unsigned* bar = b.bar;
        __builtin_amdgcn_s_waitcnt(0);
        unsigned nloc = b.st[0], nx = b.st[1];
        if (nloc == 0u) { xcd_barrier_complete(bar, b.x, nloc, nx); b.st[0] = nloc; b.st[1] = nx; }
        const unsigned old = xb_add(&bar[XB_XSUB(b.x)], 1u);
        const unsigned gen = old / nloc;
        if (old + 1u == (gen + 1u) * nloc) {
            __builtin_amdgcn_fence(__ATOMIC_RELEASE, "agent");
            asm volatile("s_waitcnt vmcnt(0)" ::: "memory");
            const unsigned og = xb_add(&bar[XB_TOP], 1u);
            const unsigned tg = og / nx;
            if (og + 1u == (tg + 1u) * nx) xb_add(&bar[XB_TOPGEN], 1u);
            else XB_SPIN(xb_ld(&bar[XB_TOPGEN]) == tg, bar);
            __builtin_amdgcn_fence(__ATOMIC_ACQUIRE, "agent");
            xb_add(&bar[XB_XGEN(b.x)], 1u);
            asm volatile("s_waitcnt vmcnt(0)" ::: "memory");
        } else {
            XB_SPIN(xb_ld(&bar[XB_XGEN(b.x)]) == gen, bar);
            __builtin_amdgcn_fence(__ATOMIC_ACQUIRE, "agent");
            asm volatile("s_waitcnt vmcnt(0)" ::: "memory");
        }
    }
    __syncthreads();
}

constexpr int N_PHASES = 15;
__global__ void __launch_bounds__(512, 2) fwd_kernel(Args a) {
    extern __shared__ __attribute__((aligned(16))) unsigned char lds_raw[];
    LAS unsigned char* lds = (LAS unsigned char*)lds_raw;
    const int tid = threadIdx.x, lane = tid & 63, wave = __builtin_amdgcn_readfirstlane(tid >> 6);
    const int G = gridDim.x;
    unsigned char* ws = a.ws;
    float* mod = (float*)(ws + WS_MOD); float* rope = (float*)(ws + WS_ROPE); float* gif = (float*)(ws + WS_GIF); float* scal = (float*)(ws + WS_SCAL);
    bf16_t* WinT = (bf16_t*)(ws + WS_WIN); bf16_t* WattT = (bf16_t*)(ws + WS_WATT); bf16_t* WmlT = (bf16_t*)(ws + WS_WML); bf16_t* WoutT = (bf16_t*)(ws + WS_WOUT);
    bf16_t* U = (bf16_t*)(ws + WS_U); bf16_t* QK = U;
    bf16_t* WfinT = (bf16_t*)(ws + WS_WFIN); bf16_t* WfoutT = (bf16_t*)(ws + WS_WFOUT); bf16_t* ACT = (bf16_t*)(ws + WS_ACT);
    bf16_t* P = (bf16_t*)(ws + WS_P); float* Cbuf = (float*)(ws + WS_CBUF); bf16_t* CinB = (bf16_t*)(ws + WS_CIN);
    bf16_t* WfinT2 = (bf16_t*)(ws + WS_CBUF); bf16_t* WfoutT2 = (bf16_t*)(ws + WS_CBUF + 44 * MiB);
    float* H = a.out;
    const int lo = a.ph_lo, hi = a.ph_hi;
    const int gw = blockIdx.x * 8 + wave, ngw = G * 8;
#define IN(k) (lo <= (k) && (k) < hi)
#if MK_MULTI
#define SEAM(k) do {} while (0)
#else
#define SEAM(k) do { if (IN(k) && IN((k) + 1)) { xcd_barrier(xbar); if (PROBE && blockIdx.x == 0 && tid == 0) tsb[(k) + 1] = __builtin_amdgcn_s_memrealtime(); } } while (0)
    unsigned long long* tsb = (unsigned long long*)(ws + WS_TS);
    volatile LAS unsigned* xst = (volatile LAS unsigned*)(lds + 131072);
    if (tid == 0) { xst[0] = 0u; xst[1] = 0u; }
    if (blockIdx.x == 0) for (int i = tid; i < XCD_BAR_WORDS; i += 512) __hip_atomic_store((unsigned*)(ws + WS_BAR) + i, 0u, __ATOMIC_RELAXED, __HIP_MEMORY_SCOPE_AGENT);
    if (blockIdx.x == 1) for (int i = tid; i < 2 * 64 * 64; i += 512) __hip_atomic_store((unsigned*)(ws + WS_CNT) + i, 0u, __ATOMIC_RELAXED, __HIP_MEMORY_SCOPE_AGENT);
    for (int i = blockIdx.x * 512 + tid; i < 2 * NMOD; i += G * 512) __hip_atomic_store((unsigned*)mod + i, 0u, __ATOMIC_RELAXED, __HIP_MEMORY_SCOPE_AGENT);
    __threadfence();
    cg::this_grid().sync();
    const XcdBarrier xbar = xcd_barrier_post((unsigned*)(ws + WS_BAR), xst);
    if (PROBE && blockIdx.x == 0 && tid == 0) tsb[0] = __builtin_amdgcn_s_memrealtime();
#endif
    const bool fuse_final = (G == 256) && !MK_MULTI && lo == 0 && hi == N_PHASES;
    if (IN(0)) {
        LAS float* scr = (LAS float*)(lds + wave * 16384);
        transpose_all<1>(a.f1_in, D_, 2 * DFF, 2 * DFF, WfinT, D_, scr, gw, ngw, lane);
        transpose_all<0>(a.f1_out, DFF, D_, D_, WfoutT, DFF, scr, gw, ngw, lane);
        transpose_all<2>(a.w_in, D_, PROJ_OUT, PP, WinT, D_, scr, gw, ngw, lane);
        transpose_all<0>(a.w_att, 1024, D_, D_, WattT, 2048, scr, gw, ngw, lane);
        transpose_all<0>(a.w_ml, 1024, D_, D_, WattT + 1024, 2048, scr, gw, ngw, lane);
        transpose_all<0>(a.w_out, D_, D_, D_, WoutT, D_, scr, gw, ngw, lane);
        for (int it = gw; it < 72 * 32; it += ngw) {
            const int cgp = it % 72, kc = it / 72, col = cgp * 256 + 4 * lane;
            f32x4 s0 = {0.f, 0.f, 0.f, 0.f}, s1 = {0.f, 0.f, 0.f, 0.f};
#pragma unroll 8
            for (int kk = 0; kk < 64; ++kk) {
                const int k = kc * 64 + kk;
                const float c0 = a.c[k], c1 = a.c[D_ + k];
                const float e0 = c0 * sigm(c0), e1 = c1 * sigm(c1);
                const f32x4 w4 = *(const f32x4*)(a.w_ada + (size_t)k * NMOD + col);
                s0 += w4 * e0; s1 += w4 * e1;
            }
            if (kc == 0) { const f32x4 bb = *(const f32x4*)(a.b_ada + col); s0 += bb; s1 += bb; }
#pragma unroll
            for (int e = 0; e < 4; ++e) { atomicAdd(mod + col + e, s0[e]); atomicAdd(mod + NMOD + col + e, s1[e]); }
        }
        for (int i = blockIdx.x * 512 + tid; i < M_ * 8; i += G * 512) {
            const int row = i >> 3, j = i & 7;
            const float invf = (j == 0) ? 1.0f : (j == 1) ? 0.19392274f : (j == 2) ? 0.03760603f : (j == 3) ? 0.0072926646f : (j == 4) ? 0.0014142136f : (j == 5) ? 0.0002742482f : (j == 6) ? 5.3182957e-05f : 1.0313385e-05f;
            const float ang = (float)a.pos[row] * invf;
            double f = (double)ang * 0.15915494309189535; f -= rint(f);
            rope[(size_t)row * 16 + j] = __builtin_amdgcn_cosf((float)f);
            rope[(size_t)row * 16 + 8 + j] = __builtin_amdgcn_sinf((float)f);
        }
        __syncthreads();
    }
    SEAM(0);
    if (IN(1)) norm_phase<false>(a.x, a.norm1_g, mod, 0, 2048, U, nullptr, nullptr, lds, tid, wave, lane);
    SEAM(1);
    if (IN(2)) { pg8::Gemm g = pg8::mk_gemm(U, WfinT, M_, 2 * DFF, D_, D_); pg8::StaticOrder S; S.init(M_, 2 * DFF, G, (int)blockIdx.x); EpiSwiglu E{ACT}; pg8::gemm_phase(lds, g, S, E); }
    SEAM(2);
    if (IN(3)) { pg8::Gemm g = pg8::mk_gemm_tiledA(ACT, WfoutT, M_, D_, DFF); pg8::StaticOrder S; S.init(M_, D_, G, (int)blockIdx.x, 4); EpiResid E{a.x, H, mod + 4096, 0.5f}; pg8::gemm_phase(lds, g, S, E); }
    SEAM(3);
    if (IN(4)) norm_phase<true>(H, a.norm2_g, mod, 6144, 8192, U, gif, a.w_in, lds, tid, wave, lane);
    SEAM(4);
    if (IN(5)) { pg8::Gemm g = pg8::mk_gemm(U, WinT, M_, PP, D_, D_); pg8::StaticOrder S; S.init(M_, PP, G, (int)blockIdx.x); EpiProj E{P, rope}; pg8::gemm_phase(lds, g, S, E); }
    SEAM(5);
    if (IN(6)) {
        for (int it = blockIdx.x; it < 256; it += G) attn_item(it, P, a.sinks, lds, tid, wave, lane);
        for (int pr = blockIdx.x; pr < 512; pr += G) m1_pair(pr, P, QK, gif, a.conv_w, a.conv_b, a.b_ig, a.b_fg, Cbuf, scal, lds, tid, wave, lane);
    }
    SEAM(6);
    if (IN(7)) m2_scan(Cbuf, CinB, scal, blockIdx.x * 512 + tid, G * 512);
    SEAM(7);
    if (IN(8)) {
        LAS float* scr = (LAS float*)(lds + wave * 16384);
        const bool tfirst = (blockIdx.x & 1) != 0;
        if (tfirst) {
            transpose_all<1>(a.f2_in, D_, 2 * DFF, 2 * DFF, WfinT2, D_, scr, gw, ngw, lane);
            transpose_all<0>(a.f2_out, DFF, D_, D_, WfoutT2, DFF, scr, gw, ngw, lane);
            __syncthreads();
        }
        for (int pr = blockIdx.x; pr < 512; pr += G) m3_pair(pr, P, QK, gif, a.b_ig, a.b_fg, CinB, scal, a.mnorm_g, lds, tid, wave, lane);
        if (!tfirst) {
            transpose_all<1>(a.f2_in, D_, 2 * DFF, 2 * DFF, WfinT2, D_, scr, gw, ngw, lane);
            transpose_all<0>(a.f2_out, DFF, D_, D_, WfoutT2, DFF, scr, gw, ngw, lane);
        }
    }
    SEAM(8);
    if (IN(9)) {
        pg8::Gemm g = pg8::mk_gemm(P + PC_Q, WattT, M_, D_, D_, PP); g.ksplit = 16; g.ajump = (size_t)(PC_MV - PC_Q - 1024) * 2;
        pg8::StaticOrder S; S.init(M_, D_, G, (int)blockIdx.x, 4); EpiMerge E{P}; pg8::gemm_phase(lds, g, S, E);
    }
    SEAM(9);
    if (IN(10)) {
        pg8::Gemm g = pg8::mk_gemm(P + PC_G, WoutT, M_, D_, D_, PP); pg8::StaticOrder S; S.init(M_, D_, G, (int)blockIdx.x, 4);
        if (fuse_final) { EpiNormU E{H, H, mod + 10240, a.norm3_g, mod + 12288, mod + 14336, U, (float*)(ws + WS_XBUF2), (unsigned*)(ws + WS_CNT2), lds + 131072 + 64}; pg8::gemm_phase(lds, g, S, E); }
        else { EpiResid E{H, H, mod + 10240, 1.0f}; pg8::gemm_phase(lds, g, S, E); }
    }
    SEAM(10);
    if (!fuse_final) {
        if (IN(11)) norm_phase<false>(H, a.norm3_g, mod, 12288, 14336, U, nullptr, nullptr, lds, tid, wave, lane);
        SEAM(11);
    }
    if (IN(12)) { pg8::Gemm g = pg8::mk_gemm(U, WfinT2, M_, 2 * DFF, D_, D_); pg8::StaticOrder S; S.init(M_, 2 * DFF, G, (int)blockIdx.x); EpiSwiglu E{ACT}; pg8::gemm_phase(lds, g, S, E); }
    SEAM(12);
    if (IN(13)) {
        pg8::Gemm g = pg8::mk_gemm_tiledA(ACT, WfoutT2, M_, D_, DFF); pg8::StaticOrder S; S.init(M_, D_, G, (int)blockIdx.x, 4);
        if (fuse_final) { EpiFinal E{H, H, mod + 16384, a.final_g, (float*)(ws + WS_XBUF), (unsigned*)(ws + WS_CNT), lds + 131072 + 64}; pg8::gemm_phase(lds, g, S, E); }
        else { EpiResid E{H, H, mod + 16384, 0.5f}; pg8::gemm_phase(lds, g, S, E); }
    }
    if (!fuse_final) SEAM(13);
    if (IN(14) && !fuse_final) {
        for (int rowa = gw; rowa < M_; rowa += 2 * ngw) {
            f32x4 v[2][8]; float rs[2];
#pragma unroll
            for (int q = 0; q < 2; ++q) {
                const int row = min(rowa + q * ngw, M_ - 1);
                const f32x4* xr = (const f32x4*)(H + (size_t)row * D_) + lane;
#pragma unroll
                for (int j = 0; j < 8; ++j) v[q][j] = xr[64 * j];
            }
#pragma unroll
            for (int q = 0; q < 2; ++q) {
                float ss = 0.f;
#pragma unroll
                for (int j = 0; j < 8; ++j) ss += (v[q][j][0] * v[q][j][0] + v[q][j][1] * v[q][j][1]) + (v[q][j][2] * v[q][j][2] + v[q][j][3] * v[q][j][3]);
                rs[q] = 1.0f / sqrtf(wave_sum(ss) * (1.0f / D_) + EPS);
            }
#pragma unroll
            for (int q = 0; q < 2; ++q) {
                const int row = rowa + q * ngw;
                if (row < M_) {
                    f32x4* xr = (f32x4*)(H + (size_t)row * D_) + lane;
#pragma unroll
                    for (int j = 0; j < 8; ++j) { const f32x4 g4 = *(const f32x4*)(a.final_g + 256 * j + 4 * lane); xr[64 * j] = (v[q][j] * rs[q]) * g4; }
                }
            }
        }
    }
#if PROBE
    xcd_barrier(xbar);
    if (blockIdx.x == 0 && tid == 0) tsb[15] = __builtin_amdgcn_s_memrealtime();
    xcd_barrier(xbar);
    { const float tau = (float)(tsb[PROBE_B] - tsb[PROBE_A]) * 0.01f / PROBE_FULL_US; float pdelta = 0.01f * sqrtf(tau); if (lane & 1) pdelta = -pdelta;
      if (gw < 512) { f32x4* xr = (f32x4*)(H + (size_t)gw * D_) + lane;
#pragma unroll
        for (int j = 0; j < 8; ++j) xr[64 * j] = xr[64 * j] + pdelta; } }
#endif
#undef IN
#undef SEAM
}

extern "C" void kernel_launch(void* const* d_in, const int* in_sizes, int n_in, void* d_out, int out_size, void* d_ws, size_t ws_size, hipStream_t stream) {
    static int grid = 0;
    if (grid == 0) {
        if (n_in != 23 || out_size != M_ * D_ || ws_size < WS_NEED) { fprintf(stderr, "kernel_launch: unexpected shapes (n_in %d, out %d, ws %zu < %zu)\n", n_in, out_size, ws_size, (size_t)WS_END); grid = -1; return; }
        int dev = 0, cus = 0, per_cu = 0;
        (void)hipGetDevice(&dev);
        (void)hipDeviceGetAttribute(&cus, hipDeviceAttributeMultiprocessorCount, dev);
        (void)hipFuncSetAttribute((const void*)fwd_kernel, hipFuncAttributeMaxDynamicSharedMemorySize, LDS_BYTES);
        (void)hipOccupancyMaxActiveBlocksPerMultiprocessor(&per_cu, (const void*)fwd_kernel, 512, LDS_BYTES);
        if (per_cu < 1) per_cu = 1;
        (void)hipGetLastError();
        grid = cus * per_cu;
    }
    if (grid < 0) return;
#if MK_MULTI
    (void)hipMemsetAsync((char*)d_ws + WS_MOD, 0, CTL_ZERO_BYTES, stream);
#endif
    Args a{};
    a.x = (const float*)d_in[0]; a.c = (const float*)d_in[1]; a.pos = (const int*)d_in[2]; a.w_ada = (const float*)d_in[3]; a.b_ada = (const float*)d_in[4];
    a.norm1_g = (const float*)d_in[5]; a.f1_in = (const float*)d_in[6]; a.f1_out = (const float*)d_in[7]; a.norm2_g = (const float*)d_in[8]; a.w_in = (const float*)d_in[9];
    a.conv_w = (const float*)d_in[10]; a.conv_b = (const float*)d_in[11]; a.b_ig = (const float*)d_in[12]; a.b_fg = (const float*)d_in[13]; a.sinks = (const float*)d_in[14];
    a.mnorm_g = (const float*)d_in[15]; a.w_att = (const float*)d_in[16]; a.w_ml = (const float*)d_in[17]; a.w_out = (const float*)d_in[18]; a.norm3_g = (const float*)d_in[19];
    a.f2_in = (const float*)d_in[20]; a.f2_out = (const float*)d_in[21]; a.final_g = (const float*)d_in[22];
    a.out = (float*)d_out; a.ws = (unsigned char*)d_ws;
#if MK_MULTI
    for (int p = 0; p < N_PHASES; ++p) { a.ph_lo = p; a.ph_hi = p + 1; hipLaunchKernelGGL(fwd_kernel, dim3(grid), dim3(512), LDS_BYTES, stream, a); }
#else
    a.ph_lo = 0; a.ph_hi = N_PHASES;
    void* args[] = {&a};
    hipError_t e = hipLaunchCooperativeKernel((const void*)fwd_kernel, dim3(grid), dim3(512), args, LDS_BYTES, stream);
    if (e != hipSuccess) fprintf(stderr, "cooperative launch failed: %s (grid %d)\n", hipGetErrorString(e), grid);
#endif
}
```
